# Optimizing an MI355X kernel written in HIP

```python
import math
import jax, jax.numpy as jnp
from jax import lax
import numpy as np

D_MODEL = 1024
BATCH = 8
SEQ = 2048
DEPTH = 4

N_MEM = 256
HEAD_DIM = 64
RWKV_HEADS = 16
RWKV_DIM = RWKV_HEADS * HEAD_DIM
DECAY_LORA = 64
ICLR_LORA = 64
GATE_LORA = 128
RWKV_GN_EPS = 64e-5
WIN_Q_HEADS = 16
WIN_KV_HEADS = 4
WIN_GROUP = WIN_Q_HEADS // WIN_KV_HEADS
WINDOW = 128
BLOCK = 128
DIFF_HEADS = 8
DIFF_V_DIM = 2 * HEAD_DIM
MEM_HEADS = 4
MEM_WIDTH = MEM_HEADS * HEAD_DIM
NUM_BUCKETS = 32
MAX_DISTANCE = 128
N_EXPERTS = 16
CAPACITY_FACTOR = 2
D_EXPERT = 2 * D_MODEL
DN_ALPHA = (2 * DEPTH) ** 0.25
DN_BETA = (8 * DEPTH) ** -0.25
N_BRANCHES = 4

RWKV_COLS = 3 * RWKV_DIM + DECAY_LORA + ICLR_LORA + GATE_LORA
WIN_Q_COLS = WIN_Q_HEADS * HEAD_DIM
WIN_KV_COLS = WIN_KV_HEADS * HEAD_DIM
WIN_COLS = WIN_Q_COLS + 2 * WIN_KV_COLS
DIFF_QK_COLS = 2 * DIFF_HEADS * HEAD_DIM
DIFF_V_COLS = DIFF_HEADS * DIFF_V_DIM
DIFF_COLS = 2 * DIFF_QK_COLS + DIFF_V_COLS
GATE_COLS = N_BRANCHES * D_MODEL
IN_COLS = RWKV_COLS + WIN_COLS + DIFF_COLS + MEM_WIDTH + GATE_COLS
IN_SPLITS = (RWKV_COLS, RWKV_COLS + WIN_COLS, RWKV_COLS + WIN_COLS + DIFF_COLS,
             RWKV_COLS + WIN_COLS + DIFF_COLS + MEM_WIDTH)
RWKV_SPLITS = (RWKV_DIM, 2 * RWKV_DIM, 3 * RWKV_DIM, 3 * RWKV_DIM + DECAY_LORA,
               3 * RWKV_DIM + DECAY_LORA + ICLR_LORA)
BRANCH_ROWS = RWKV_DIM + WIN_Q_COLS + DIFF_V_COLS + MEM_WIDTH
BRANCH_SPLITS = (RWKV_DIM, RWKV_DIM + WIN_Q_COLS, RWKV_DIM + WIN_Q_COLS + DIFF_V_COLS)
NEG_INF = -1e30

kernel_name = 'hybrid_rwkv7_window_diffattn_ecmoe_encoder'


def layer_norm(x, g, b, eps=1e-5):
    xf = x.astype(jnp.float32)
    mu = xf.mean(-1, keepdims=True)
    var = jnp.square(xf - mu).mean(-1, keepdims=True)
    return ((xf - mu) * lax.rsqrt(var + eps) * g + b).astype(x.dtype)


def t5_bucket(rel):
    half = NUM_BUCKETS // 2
    exact = half // 2
    n = jnp.abs(rel)
    nf = jnp.maximum(n, 1).astype(jnp.float32)
    large = exact + (jnp.log(nf / exact) / math.log(MAX_DISTANCE / exact)
                     * (half - exact)).astype(jnp.int32)
    large = jnp.minimum(large, half - 1)
    return jnp.where(rel > 0, half, 0) + jnp.where(n < exact, n, large)


def centred_shift(p, mu):
    prev = jnp.pad(p[:, :-1], ((0, 0), (1, 0), (0, 0)))
    nxt = jnp.pad(p[:, 1:], ((0, 0), (0, 1), (0, 0)))
    return p + mu[0] * (prev - p) + mu[1] * (nxt - p)


def rwkv7_branch(p, mu, w0, w_up, a0, a_up, g_up, k_k, k_a, r_k, gn_g, gn_b):
    B, S, _ = p.shape
    H, N = RWKV_HEADS, HEAD_DIM
    f32 = jnp.float32
    p = centred_shift(p, mu)
    r, k, v, dw, da, dg = jnp.split(p, RWKV_SPLITS, axis=-1)
    w_logit = (w0[:, None, None, :] + jnp.einsum('bsr,zrc->zbsc', jnp.tanh(dw), w_up)).astype(f32)
    decay = jnp.exp(-jnp.exp(-jax.nn.softplus(-w_logit) - 0.5))
    a = jax.nn.sigmoid((a0[:, None, None, :] + jnp.einsum('bsr,zrc->zbsc', da, a_up)).astype(f32))
    g = jnp.einsum('bsr,rc->bsc', jax.nn.sigmoid(dg), g_up).astype(f32)
    kk = (k * k_k).astype(f32).reshape(B, S, H, N)
    kk = kk * lax.rsqrt(jnp.maximum(jnp.sum(kk * kk, -1, keepdims=True), 1e-12))
    kk = kk.reshape(B, S, RWKV_DIM)
    kd = k.astype(f32)[None] * (1.0 + (a - 1.0) * k_a.astype(f32))
    rf, vf = r.astype(f32), v.astype(f32)

    def both(z):
        return jnp.stack([z, z[:, ::-1]])

    def rev1(z):
        return jnp.stack([z[0], z[1, :, ::-1]])

    def to_t(z):
        return jnp.moveaxis(z.reshape(2, B, S, H, N), 2, 0)

    kk2 = both(kk)
    xs = (to_t(both(rf)), to_t(rev1(decay)), to_t(rev1(kd)), to_t(both(vf)),
          to_t(kk2), to_t(rev1(a) * kk2))

    def step(state, inp):
        r_t, w_t, k_t, v_t, kk_t, kka_t = inp
        sa = jnp.einsum('zbhvk,zbhk->zbhv', state, kk_t)
        state = (state * w_t[..., None, :] - sa[..., None] * kka_t[..., None, :]
                 + v_t[..., None] * k_t[..., None, :])
        return state, jnp.einsum('zbhvk,zbhk->zbhv', state, r_t)

    state0 = jnp.zeros((2, B, H, N, N), f32)
    _, ys = lax.scan(step, state0, xs)
    ys = jnp.moveaxis(ys, 0, 2)
    y = ys[0] + ys[1, :, ::-1]
    mu_y = y.mean(-1, keepdims=True)
    var_y = jnp.square(y - mu_y).mean(-1, keepdims=True)
    y = ((y - mu_y) * lax.rsqrt(var_y + RWKV_GN_EPS)).reshape(B, S, RWKV_DIM) * gn_g + gn_b
    r_h = rf.reshape(B, S, H, N)
    bonus = jnp.sum(r_h * (kd[0] + kd[1]).reshape(B, S, H, N) * r_k.astype(f32), -1, keepdims=True) \
        * vf.reshape(B, S, H, N)
    return ((y + bonus.reshape(B, S, RWKV_DIM)) * g).astype(p.dtype)


def window_branch(p, sink, rel_bias):
    B, S, _ = p.shape
    nb = S // BLOCK
    Hkv, G, dh = WIN_KV_HEADS, WIN_GROUP, HEAD_DIM
    q = p[..., :WIN_Q_COLS].reshape(B, nb, BLOCK, Hkv, G, dh)
    k = p[..., WIN_Q_COLS:WIN_Q_COLS + WIN_KV_COLS].reshape(B, S, Hkv, dh)
    v = p[..., WIN_Q_COLS + WIN_KV_COLS:].reshape(B, S, Hkv, dh)

    def band(z):
        zp = jnp.pad(z, ((0, 0), (BLOCK, BLOCK), (0, 0), (0, 0))).reshape(B, nb + 2, BLOCK, Hkv, dh)
        return jnp.concatenate([zp[:, :-2], zp[:, 1:-1], zp[:, 2:]], axis=2)

    kb, vb = band(k), band(v)
    s = jnp.einsum('bnqhgd,bnkhd->bnhgqk', q, kb).astype(jnp.float32) * (dh ** -0.5)
    qi = jnp.arange(BLOCK)[:, None]
    kj = jnp.arange(3 * BLOCK)[None, :]
    rel = kj - BLOCK - qi
    bias = rel_bias[t5_bucket(rel)][..., :WIN_Q_HEADS].astype(jnp.float32)
    bias = bias.transpose(2, 0, 1).reshape(Hkv, G, BLOCK, 3 * BLOCK)
    kpos = jnp.arange(nb)[:, None] * BLOCK + kj - BLOCK
    valid = (jnp.abs(rel) <= WINDOW)[None] & ((kpos >= 0) & (kpos < S))[:, None, :]
    s = jnp.where(valid[None, :, None, None], s + bias, NEG_INF)
    sink_b = sink.astype(jnp.float32).reshape(Hkv, G)[..., None, None]
    m = jnp.maximum(s.max(-1, keepdims=True), sink_b)
    e = jnp.exp(s - m)
    pr = (e / (e.sum(-1, keepdims=True) + jnp.exp(sink_b - m))).astype(v.dtype)
    o = jnp.einsum('bnhgqk,bnkhd->bnqhgd', pr, vb)
    return o.reshape(B, S, WIN_Q_COLS)


def diff_branch(p, lam, subln_g, rel_bias, lambda_init):
    B, S, _ = p.shape
    H, d = DIFF_HEADS, HEAD_DIM
    nb = S // BLOCK
    q = p[..., :DIFF_QK_COLS].reshape(B, S, H, 2, d)
    k = p[..., DIFF_QK_COLS:2 * DIFF_QK_COLS].reshape(B, S, H, 2, d)
    v = p[..., 2 * DIFF_QK_COLS:].reshape(B, S, H, DIFF_V_DIM)
    lamf = lam.astype(jnp.float32)
    lam_full = (jnp.exp(jnp.sum(lamf[0] * lamf[1])) - jnp.exp(jnp.sum(lamf[2] * lamf[3]))
                + lambda_init)
    bias_tab = rel_bias[:, WIN_Q_HEADS:].astype(jnp.float32)
    kpos = jnp.arange(S)
    qb = q.reshape(B, nb, BLOCK, H, 2, d).transpose(1, 0, 2, 3, 4, 5)

    def one_block(args):
        q_blk, i0 = args
        s = jnp.einsum('bqhcd,bkhcd->bhcqk', q_blk, k).astype(jnp.float32) * (d ** -0.5)
        rel = kpos[None, :] - (i0 + jnp.arange(BLOCK))[:, None]
        bias = bias_tab[t5_bucket(rel)].transpose(2, 0, 1)
        a = jax.nn.softmax(s + bias[None, :, None], axis=-1)
        attn = a[:, :, 0] - lam_full * a[:, :, 1]
        return jnp.einsum('bhqk,bkhe->bqhe', attn.astype(v.dtype), v)

    o = lax.map(one_block, (qb, jnp.arange(nb) * BLOCK))
    o = o.transpose(1, 0, 2, 3, 4).reshape(B, S, H, DIFF_V_DIM).astype(jnp.float32)
    o = o * lax.rsqrt(jnp.mean(o * o, -1, keepdims=True) + 1e-5) * subln_g * (1.0 - lambda_init)
    return o.reshape(B, S, DIFF_V_COLS).astype(p.dtype)


def memory_branch(q_cols, mem, w_kv):
    B, S, _ = q_cols.shape
    q = q_cols.reshape(B, S, MEM_HEADS, HEAD_DIM)
    kv = jnp.einsum('bmd,dc->bmc', mem, w_kv)
    k = kv[..., :MEM_WIDTH].reshape(B, N_MEM, MEM_HEADS, HEAD_DIM)
    v = kv[..., MEM_WIDTH:].reshape(B, N_MEM, MEM_HEADS, HEAD_DIM)
    s = jnp.einsum('bshd,bmhd->bhsm', q, k).astype(jnp.float32) * (HEAD_DIM ** -0.5)
    a = jax.nn.softmax(s, axis=-1).astype(v.dtype)
    return jnp.einsum('bhsm,bmhd->bshd', a, v).reshape(B, S, MEM_WIDTH)


def expert_choice_ffn(x, router, w_gate, w_up, w_down):
    B, S, D = x.shape
    cap = CAPACITY_FACTOR * S // N_EXPERTS
    aff = jax.nn.softmax(jnp.einsum('bsd,de->bse', x, router).astype(jnp.float32), axis=-1)
    gate, idx = lax.top_k(aff.transpose(0, 2, 1), cap)
    xe = jax.vmap(lambda xb, ib: xb[ib])(x, idx)
    h = jax.nn.silu(jnp.einsum('becd,edf->becf', xe, w_gate)) * jnp.einsum('becd,edf->becf', xe, w_up)
    ye = jnp.einsum('becf,efd->becd', h, w_down) * gate[..., None].astype(x.dtype)
    flat = (idx + jnp.arange(B)[:, None, None] * S).reshape(-1)
    y = jnp.zeros((B * S, D), x.dtype).at[flat].add(ye.reshape(-1, D))
    return y.reshape(B, S, D)


def setup_inputs(seed: int = 0) -> dict:
    key = jax.random.key(seed)
    ks = jax.random.split(key, 32)
    L, D = DEPTH, D_MODEL

    def nrm(k, shape, s):
        return jax.random.normal(k, shape, jnp.float32) * s

    return {
        'x': nrm(ks[0], (BATCH, SEQ, D), 1.0),
        'mem': nrm(ks[1], (BATCH, N_MEM, D), 1.0),
        'rel_bias': nrm(ks[2], (NUM_BUCKETS, WIN_Q_HEADS + DIFF_HEADS), 0.5),
        'w_in': nrm(ks[3], (L, D, IN_COLS), D ** -0.5),
        'rwkv_mu': jax.random.uniform(ks[4], (L, 2, RWKV_COLS), jnp.float32, 0.0, 0.5),
        'rwkv_w0': jax.random.uniform(ks[5], (L, 2, RWKV_DIM), jnp.float32, -6.0, 1.0),
        'rwkv_w_up': nrm(ks[6], (L, 2, DECAY_LORA, RWKV_DIM), 0.1),
        'rwkv_a0': nrm(ks[7], (L, 2, RWKV_DIM), 0.5),
        'rwkv_a_up': nrm(ks[8], (L, 2, ICLR_LORA, RWKV_DIM), ICLR_LORA ** -0.5),
        'rwkv_g_up': nrm(ks[9], (L, GATE_LORA, RWKV_DIM), GATE_LORA ** -0.5),
        'rwkv_k_k': 0.85 + nrm(ks[10], (L, RWKV_DIM), 0.05),
        'rwkv_k_a': 1.0 + nrm(ks[11], (L, RWKV_DIM), 0.05),
        'rwkv_r_k': nrm(ks[12], (L, RWKV_HEADS, HEAD_DIM), 0.1),
        'rwkv_gn_g': 1.0 + nrm(ks[13], (L, RWKV_DIM), 0.1),
        'rwkv_gn_b': nrm(ks[14], (L, RWKV_DIM), 0.01),
        'win_sink': nrm(ks[15], (L, WIN_Q_HEADS), 0.5),
        'diff_lambda': nrm(ks[16], (L, 4, HEAD_DIM), 0.1),
        'diff_subln_g': 1.0 + nrm(ks[17], (L, DIFF_V_DIM), 0.1),
        'mem_w_kv': nrm(ks[18], (L, D, 2 * MEM_WIDTH), D ** -0.5),
        'w_branch': nrm(ks[19], (L, BRANCH_ROWS, D), (RWKV_DIM ** -0.5) * DN_BETA),
        'w_out': nrm(ks[20], (L, D, D), (D ** -0.5) * DN_BETA),
        'ln1_g': 1.0 + nrm(ks[21], (L, D), 0.1),
        'ln1_b': nrm(ks[22], (L, D), 0.01),
        'router': nrm(ks[23], (L, D, N_EXPERTS), D ** -0.5),
        'exp_w_gate': nrm(ks[24], (L, N_EXPERTS, D, D_EXPERT), (D ** -0.5) * DN_BETA),
        'exp_w_up': nrm(ks[25], (L, N_EXPERTS, D, D_EXPERT), (D ** -0.5) * DN_BETA),
        'exp_w_down': nrm(ks[26], (L, N_EXPERTS, D_EXPERT, D), (D_EXPERT ** -0.5) * DN_BETA),
        'ln2_g': 1.0 + nrm(ks[27], (L, D), 0.1),
        'ln2_b': nrm(ks[28], (L, D), 0.01),
    }


def reference(x, mem, rel_bias, w_in, rwkv_mu, rwkv_w0, rwkv_w_up, rwkv_a0, rwkv_a_up,
              rwkv_g_up, rwkv_k_k, rwkv_k_a, rwkv_r_k, rwkv_gn_g, rwkv_gn_b, win_sink,
              diff_lambda, diff_subln_g, mem_w_kv, w_branch, w_out, ln1_g, ln1_b, router,
              exp_w_gate, exp_w_up, exp_w_down, ln2_g, ln2_b):
    B, S, D = x.shape
    for l in range(DEPTH):
        lambda_init = 0.8 - 0.6 * math.exp(-0.3 * l)
        p = jnp.einsum('bsd,dc->bsc', x, w_in[l])
        p_rwkv, p_win, p_diff, p_mem, p_gate = jnp.split(p, IN_SPLITS, axis=-1)
        y_rwkv = rwkv7_branch(p_rwkv, rwkv_mu[l], rwkv_w0[l], rwkv_w_up[l], rwkv_a0[l],
                              rwkv_a_up[l], rwkv_g_up[l], rwkv_k_k[l], rwkv_k_a[l],
                              rwkv_r_k[l], rwkv_gn_g[l], rwkv_gn_b[l])
        y_win = window_branch(p_win, win_sink[l], rel_bias)
        y_diff = diff_branch(p_diff, diff_lambda[l], diff_subln_g[l], rel_bias, lambda_init)
        y_mem = memory_branch(p_mem, mem, mem_w_kv[l])
        wb_rwkv, wb_win, wb_diff, wb_mem = jnp.split(w_branch[l], BRANCH_SPLITS, axis=0)
        gates = jax.nn.sigmoid(p_gate.reshape(B, S, N_BRANCHES, D))
        merged = (gates[:, :, 0] * (y_rwkv @ wb_rwkv) + gates[:, :, 1] * (y_win @ wb_win)
                  + gates[:, :, 2] * (y_diff @ wb_diff) + gates[:, :, 3] * (y_mem @ wb_mem))
        x = layer_norm(DN_ALPHA * x + merged @ w_out[l], ln1_g[l], ln1_b[l])
        ffn = expert_choice_ffn(x, router[l], exp_w_gate[l], exp_w_up[l], exp_w_down[l])
        x = layer_norm(DN_ALPHA * x + ffn, ln2_g[l], ln2_b[l])
    return x
```

```cpp
#include <hip/hip_runtime.h>
#include <stdint.h>
#include <stdio.h>

namespace pg8 {
#define PG8_LAS __attribute__((address_space(3)))
typedef unsigned short bf16_t;
typedef short bf16x8 __attribute__((ext_vector_type(8)));
typedef float f32x4 __attribute__((ext_vector_type(4)));
typedef unsigned u32x4 __attribute__((ext_vector_type(4)));
constexpr int BM = 256, BK = 64, HALF = 128, HTB = HALF * BK * 2  , STAGE_BYTES = 8 * HTB, NXCD = 8, WGM = 8;

__host__ __device__ __forceinline__ int lds_byte(int r, int c) { const int st = (r >> 4) * 2 + (c >> 5), rr = r & 15, cc = c & 31, ob = rr * 64 + cc * 2; return st * 1024 + (ob ^ (((ob >> 9) & 1) << 5)); }
__host__ __device__ __forceinline__ void stage_rc(int b, int& R, int& C) { const int st = b / 1024, sb = b % 1024, swz = sb ^ (((sb >> 9) & 1) << 5); R = (st >> 1) * 16 + swz / 64; C = (st & 1) * 32 + (swz % 64) / 2; }
__host__ __device__ __forceinline__ int perm32(int rho) { const int n = rho >> 4, i = rho & 15; return 8 * (i >> 2) + 4 * n + (i & 3); }

struct Unit { int pm, pn; };
struct Gemm { const bf16_t* A; const bf16_t* Bt; int M, N, K, lda, ldb; };
struct StaticOrder {
    int nM, nN, nwg, G, c;
    __host__ __device__ void init(int M, int N, int G_, int c_) { nM = M / BM; nN = N / BM; nwg = nM * nN; G = G_; c = c_; }
    __host__ __device__ bool next(int i, Unit& u) const {
        const long L = (long)i * G + c; if (L >= nwg) return false;
        int wgid = (int)L; { const int q = nwg / NXCD, r = nwg % NXCD, xcd = wgid % NXCD, off = wgid / NXCD; wgid = (xcd < r ? xcd * (q + 1) : r * (q + 1) + (xcd - r) * q) + off; }
        const int nig = WGM * nN, gid = wgid / nig, fm = gid * WGM, gsz = (nM - fm) < WGM ? (nM - fm) : WGM;
        u.pm = fm + ((wgid % nig) % gsz); u.pn = (wgid % nig) / gsz; return true;
    }
    __device__ __forceinline__ void a_ready(const Unit&) const {}
    __device__ __forceinline__ void done(const Unit&) const {}
};
__device__ __forceinline__ unsigned cvt_pk_bf16(float lo, float hi) { unsigned r; asm volatile("v_cvt_pk_bf16_f32 %0, %1, %2" : "=v"(r) : "v"(lo), "v"(hi)); return r; }
template <class Epi, class Sched, bool STAMP = false>
__device__ __forceinline__ void gemm_phase(PG8_LAS unsigned char* lds, const Gemm g, const Sched& S, const Epi& E, unsigned long long* stamps) {
    int tid_ = threadIdx.x; asm volatile("" : "+v"(tid_));
    const int tid = tid_, wid = __builtin_amdgcn_readfirstlane(tid >> 6), lane = tid & 63, wr = wid >> 2, wc = wid & 3, fr = lane & 15, fq = lane >> 4;
    const int K = g.K, nt = K / BK;
    int ts_lo = 0, ts_hi = 0, nts = 0; const unsigned long long rt_entry = STAMP ? (unsigned long long)wall_clock64() : 0ull;
#define PG8_STAMP() do { if (STAMP && wid == 0 && nts < 64) { const unsigned long long _c = (unsigned long long)clock64(); \
        ts_lo = (lane == nts) ? (int)(unsigned)_c : ts_lo; ts_hi = (lane == nts) ? (int)(unsigned)(_c >> 32) : ts_hi; ++nts; } } while (0)
    PG8_STAMP();
    unsigned voffA[2], voffB[2];
#pragma unroll
    for (int i = 0; i < 2; ++i) { int R, C; stage_rc(tid * 16 + i * 8192, R, C); const int Rb = Epi::PERM ? ((R & ~31) + perm32(R & 31)) : R;
        voffA[i] = (unsigned)(R * g.lda + C) * 2u; voffB[i] = (unsigned)(Rb * g.ldb + C) * 2u; }
    const size_t kstep = (size_t)(BK * 2);
    const size_t hstepA = (size_t)HALF * g.lda * 2, hstepB = (size_t)HALF * g.ldb * 2;
    const size_t tstepA = 2 * hstepA, tstepB = 2 * hstepB;
    const unsigned ldsw = (unsigned)wid * 1024u;
    const int aoff = lds_byte(wr * 64 + fr, fq * 8), boff = lds_byte(wc * 32 + fr, fq * 8);
#define PG8_SA(b, h) (((b) * 2 + (h)) * HTB)
#define PG8_SB(b, h) ((4 + (b) * 2 + (h)) * HTB)
#define PG8_STAGE(bufoff, gbase, voff) do { _Pragma("unroll") for (int _i = 0; _i < 2; ++_i) \
        __builtin_amdgcn_global_load_lds((const unsigned*)((const char*)(gbase) + (voff)[_i]), (PG8_LAS unsigned*)(lds + (bufoff) + ldsw + _i * 8192), 16, 0, 0); } while (0)
#define PG8_LDA(dst, b, h) do { _Pragma("unroll") for (int m = 0; m < 4; ++m) _Pragma("unroll") for (int k = 0; k < 2; ++k) dst[m][k] = *(const PG8_LAS bf16x8*)(lds + PG8_SA(b, h) + aoff + m * 2048 + k * 1024); } while (0)
#define PG8_LDB(dst, b, h) do { _Pragma("unroll") for (int n = 0; n < 2; ++n) _Pragma("unroll") for (int k = 0; k < 2; ++k) dst[n][k] = *(const PG8_LAS bf16x8*)(lds + PG8_SB(b, h) + boff + n * 2048 + k * 1024); } while (0)
#define PG8_MMA(ai, bj, At, Bt) do { __builtin_amdgcn_s_setprio(1); _Pragma("unroll") for (int m = 0; m < 4; ++m) _Pragma("unroll") for (int n = 0; n < 2; ++n) _Pragma("unroll") for (int k = 0; k < 2; ++k) \
        acc[ai][bj][m][n] = __builtin_amdgcn_mfma_f32_16x16x32_bf16(Bt[n][k], At[m][k], acc[ai][bj][m][n], 0, 0, 0); __builtin_amdgcn_s_setprio(0); } while (0)
#define PG8_WAIT_V(n) asm volatile("s_waitcnt vmcnt(" #n ")" ::: "memory")
#define PG8_WAIT_L(n) asm volatile("s_waitcnt lgkmcnt(" #n ")" ::: "memory")
#define PG8_BAR __builtin_amdgcn_s_barrier()
#define PG8_SCHED __builtin_amdgcn_sched_barrier(0)
    Unit cur, nxt; int ui = 0;
    if (!S.next(0, cur)) return;
    f32x4 acc[2][2][4][2];
#pragma unroll
    for (int a = 0; a < 2; ++a)
#pragma unroll
        for (int b = 0; b < 2; ++b)
#pragma unroll
            for (int m = 0; m < 4; ++m)
#pragma unroll
                for (int n = 0; n < 2; ++n) acc[a][b][m][n] = (f32x4){0.f, 0.f, 0.f, 0.f};
    bf16x8 At[4][2], B0[2][2], B1[2][2];
    const char* cA = (const char*)g.A + (size_t)cur.pm * tstepA; const char* cB = (const char*)g.Bt + (size_t)cur.pn * tstepB;
    S.a_ready(cur);
    PG8_STAGE(PG8_SB(0, 0), cB, voffB); PG8_STAGE(PG8_SA(0, 0), cA, voffA); PG8_STAGE(PG8_SB(0, 1), cB + hstepB, voffB); PG8_STAGE(PG8_SA(0, 1), cA + hstepA, voffA);
    if (wr == 1) PG8_BAR;
    PG8_WAIT_V(4); PG8_BAR;
    PG8_STAGE(PG8_SB(1, 0), cB + kstep, voffB); PG8_STAGE(PG8_SA(1, 0), cA + kstep, voffA); PG8_STAGE(PG8_SB(1, 1), cB + hstepB + kstep, voffB);
    PG8_WAIT_V(6); PG8_BAR;
    PG8_STAMP();
    for (;;) {
        const bool has_next = S.next(ui + 1, nxt);
        const char* nA = has_next ? (const char*)g.A + (size_t)nxt.pm * tstepA : cA; const char* nB = has_next ? (const char*)g.Bt + (size_t)nxt.pn * tstepB : cB;
        for (int t = 0; t < nt; t += 2) {
            const bool last = (t == nt - 2);
            const char* a1 = cA + (size_t)(t + 1) * kstep;
            const char* a2 = last ? nA : cA + (size_t)(t + 2) * kstep; const char* b2 = last ? nB : cB + (size_t)(t + 2) * kstep;
            const char* a3 = a2 + kstep; const char* b3 = b2 + kstep;
            if (last && has_next) S.a_ready(nxt);
            PG8_LDB(B0, 0, 0); PG8_SCHED; PG8_LDA(At, 0, 0); PG8_STAGE(PG8_SA(1, 1), a1 + hstepA, voffA);
            PG8_WAIT_L(8); PG8_BAR; PG8_WAIT_L(0); PG8_MMA(0, 0, At, B0); PG8_BAR; PG8_SCHED;
            PG8_LDB(B1, 0, 1); PG8_STAGE(PG8_SB(0, 0), b2, voffB);
            PG8_BAR; PG8_WAIT_L(0); PG8_MMA(0, 1, At, B1); PG8_BAR;
            PG8_LDA(At, 0, 1); PG8_STAGE(PG8_SA(0, 0), a2, voffA);
            PG8_BAR; PG8_WAIT_L(0); PG8_MMA(1, 0, At, B0); PG8_BAR; PG8_SCHED;
            PG8_STAGE(PG8_SB(0, 1), b2 + hstepB, voffB);
            PG8_WAIT_V(6); PG8_BAR; PG8_MMA(1, 1, At, B1); PG8_BAR;
            PG8_LDB(B0, 1, 0); PG8_SCHED; PG8_LDA(At, 1, 0); PG8_STAGE(PG8_SA(0, 1), a2 + hstepA, voffA);
            PG8_WAIT_L(8); PG8_BAR; PG8_WAIT_L(0); PG8_MMA(0, 0, At, B0); PG8_BAR; PG8_SCHED;
            PG8_LDB(B1, 1, 1); PG8_STAGE(PG8_SB(1, 0), b3, voffB);
            PG8_BAR; PG8_WAIT_L(0); PG8_MMA(0, 1, At, B1); PG8_BAR;
            PG8_LDA(At, 1, 1); PG8_STAGE(PG8_SA(1, 0), a3, voffA);
            PG8_BAR; PG8_WAIT_L(0); PG8_MMA(1, 0, At, B0); PG8_BAR; PG8_SCHED;
            PG8_STAGE(PG8_SB(1, 1), b3 + hstepB, voffB);
            PG8_WAIT_V(6); PG8_BAR; PG8_MMA(1, 1, At, B1); PG8_BAR;
        }
        PG8_STAMP();
        if constexpr (!Epi::AFTER_DRAIN) { E(acc, cur, wr, wc, fr, fq); S.done(cur); }
        PG8_STAMP();
        if (!has_next) break;
#pragma unroll
        for (int a = 0; a < 2; ++a)
#pragma unroll
            for (int b = 0; b < 2; ++b)
#pragma unroll
                for (int m = 0; m < 4; ++m)
#pragma unroll
                    for (int n = 0; n < 2; ++n) acc[a][b][m][n] = (f32x4){0.f, 0.f, 0.f, 0.f};
        cur = nxt; cA = nA; cB = nB; ++ui;
    }
    PG8_WAIT_V(0);
    if (wr == 0) PG8_BAR;
    PG8_BAR;
    if constexpr (Epi::AFTER_DRAIN) { E.fused(acc, cur, wr, wc, fr, fq, lds, wid, lane); S.done(cur); }
    PG8_STAMP();
    if (STAMP && wid == 0) { stamps[lane] = lane < nts ? (((unsigned long long)(unsigned)ts_hi << 32) | (unsigned)ts_lo) : 0ull;
        if (lane == 62) stamps[62] = rt_entry; if (lane == 63) stamps[63] = (unsigned long long)wall_clock64(); }
#undef PG8_STAMP
#undef PG8_SA
#undef PG8_SB
#undef PG8_STAGE
#undef PG8_LDA
#undef PG8_LDB
#undef PG8_MMA
#undef PG8_WAIT_V
#undef PG8_WAIT_L
#undef PG8_BAR
#undef PG8_SCHED
}
}

using pg8::bf16_t; using pg8::f32x4; using pg8::u32x4; using pg8::Unit; using pg8::Gemm; using pg8::cvt_pk_bf16;
typedef float f32x2 __attribute__((ext_vector_type(2)));
typedef unsigned u32x2 __attribute__((ext_vector_type(2)));
#define LAS __attribute__((address_space(3)))

constexpr int DM = 1024, NBATCH = 8, SEQ = 2048, NTOK = NBATCH * SEQ, DEPTH = 4, NMEM = 256, INC = 12288;
constexpr int C_R = 0, C_K = 1024, C_V = 2048, C_DW = 3072, C_WQ = 3328, C_WK = 4352, C_WV = 4608, C_DQ = 4864, C_DK = 5888, C_DV = 6912, C_MQ = 7936, C_GATE = 8192;
constexpr int RWC = 3328, LORA_N = 5120, BRK = 3328;
constexpr float DN_ALPHA = 1.6817928305074290f;
constexpr int NEXP = 16, CAP = 256, DEXP = 2048;

enum { I_X = 0, I_MEM, I_RELB, I_WIN, I_MU, I_W0, I_WUP, I_A0, I_AUP, I_GUP, I_KK, I_KA, I_RK, I_GNG, I_GNB, I_SINK, I_LAM, I_SUBLN, I_WKV, I_WBR, I_WOUT,
       I_LN1G, I_LN1B, I_ROUTER, I_EWG, I_EWU, I_EWD, I_LN2G, I_LN2B, N_IN };

constexpr size_t MiB = 1ull << 20;
constexpr size_t WS_CTL = 0;
constexpr size_t WS_WIN = 1 * MiB;
constexpr size_t WS_WBR = WS_WIN + 96 * MiB;
constexpr size_t WS_WOUT = WS_WBR + 26 * MiB;
constexpr size_t WS_WKV = WS_WOUT + 8 * MiB;
constexpr size_t WS_WGU = WS_WKV + 4 * MiB;
constexpr size_t WS_WDN = WS_WGU + 512 * MiB;
constexpr size_t WS_WLORA = WS_WDN + 256 * MiB;
constexpr size_t WS_XF = WS_WLORA + 10 * MiB;
constexpr size_t WS_XB = WS_XF + 64 * MiB;
constexpr size_t WS_MEMB = WS_XB + 32 * MiB;
constexpr size_t WS_KVMEM = WS_MEMB + 4 * MiB;
constexpr size_t WS_P = WS_KVMEM + 8 * MiB;
constexpr size_t WS_XE = WS_P, WS_H = WS_P + 64 * MiB, WS_YE = WS_P + 192 * MiB;
constexpr size_t WS_APR = WS_P + 384 * MiB;
constexpr size_t WS_LORA = WS_APR + 8 * MiB;
constexpr size_t WS_YDIR = WS_LORA + 160 * MiB;
constexpr size_t WS_BONUS = WS_YDIR + 128 * MiB;
constexpr size_t WS_YCAT = WS_BONUS + 2 * MiB;
constexpr size_t WS_MF = WS_YCAT + 104 * MiB;
constexpr size_t WS_PRELN = WS_MF + 64 * MiB;
constexpr size_t WS_DTMP = WS_MF;
constexpr size_t WS_MB = WS_PRELN + 64 * MiB;
constexpr size_t WS_AFF = WS_MB + 32 * MiB;
constexpr size_t WS_GROW = WS_AFF + 1 * MiB;
constexpr size_t WS_SLOT = WS_GROW + 1 * MiB;
constexpr size_t WS_END = WS_SLOT + 1 * MiB;

struct Params {
    const float* in[N_IN];
    float* out;
    unsigned char* ws;
    int ph_lo, ph_hi;
    int fused, pad0;
};

constexpr int LDS_BYTES = 132 * 1024;
constexpr int NTHR = 512;

__device__ __forceinline__ float bf2f(unsigned v) { return __uint_as_float(v << 16); }
__device__ __forceinline__ float bflo(unsigned v) { return __uint_as_float(v << 16); }
__device__ __forceinline__ float bfhi(unsigned v) { return __uint_as_float(v & 0xffff0000u); }
__device__ __forceinline__ unsigned short f2bf(float f) { unsigned u = __float_as_uint(f); u += 0x7FFFu + ((u >> 16) & 1u); return (unsigned short)(u >> 16); }
__device__ __forceinline__ int otid() { int t = threadIdx.x; asm volatile("" : "+v"(t)); return t; }
__device__ __forceinline__ float wave_sum(float v) {
#pragma unroll
    for (int o = 1; o < 64; o <<= 1) v += __shfl_xor(v, o);
    return v;
}
__device__ __forceinline__ float sigmoidf_(float x) { return __builtin_amdgcn_rcpf(1.0f + __expf(-x)); }
__device__ __forceinline__ int t5_bucket(int rel) {
    const int n = rel < 0 ? -rel : rel;
    int large = 2 + (31 - __clz(n * n));
    large = large > 15 ? 15 : large;
    return (rel > 0 ? 16 : 0) + (n < 8 ? n : large);
}

struct GroupedOrder {
    int nMe, nNe, upe, total, G, c;
    __device__ void init(int nMe_, int nNe_, int E, int G_, int c_) { nMe = nMe_; nNe = nNe_; upe = nMe_ * nNe_; total = upe * E; G = G_; c = c_; }
    __device__ bool next(int i, Unit& u) const {
        const int L = i * G + c; if (L >= total) return false;
        const int e = L / upe, rem = L % upe; u.pm = e * nMe + rem % nMe; u.pn = e * nNe + rem / nMe; return true;
    }
    __device__ __forceinline__ void a_ready(const Unit&) const {}
    __device__ __forceinline__ void done(const Unit&) const {}
};

struct EpiBf16Store {
    static constexpr bool PERM = true, AFTER_DRAIN = false;
    bf16_t* O; int ldc;
    __device__ __forceinline__ void operator()(const f32x4 (&acc)[2][2][4][2], const Unit& u, int wr, int wc, int fr, int fq) const {
        const int row0 = u.pm * 256 + wr * 64 + fr, col0 = u.pn * 256 + wc * 32 + 8 * fq;
#pragma unroll
        for (int ai = 0; ai < 2; ++ai)
#pragma unroll
            for (int m = 0; m < 4; ++m) { bf16_t* rowp = O + (size_t)(row0 + ai * 128 + m * 16) * ldc + col0;
#pragma unroll
                for (int bj = 0; bj < 2; ++bj) { const f32x4 v0 = acc[ai][bj][m][0], v1 = acc[ai][bj][m][1];
                    u32x4 w; w.x = cvt_pk_bf16(v0[0], v0[1]); w.y = cvt_pk_bf16(v0[2], v0[3]); w.z = cvt_pk_bf16(v1[0], v1[1]); w.w = cvt_pk_bf16(v1[2], v1[3]);
                    *(u32x4*)(rowp + bj * 128) = w; } asm volatile("" ::: "memory"); }
    }
};
struct EpiLora {
    static constexpr bool PERM = true, AFTER_DRAIN = false;
    bf16_t* O; const float* w0; const float* a0;
    __device__ __forceinline__ void operator()(const f32x4 (&acc)[2][2][4][2], const Unit& u, int wr, int wc, int fr, int fq) const {
        const int row0 = u.pm * 256 + wr * 64 + fr, col0 = u.pn * 256 + wc * 32 + 8 * fq;
        const int region = u.pn >> 3;
        f32x4 bv[2][2];
#pragma unroll
        for (int bj = 0; bj < 2; ++bj)
#pragma unroll
            for (int n = 0; n < 2; ++n) { const int c = col0 + bj * 128 + 4 * n;
                bv[bj][n] = region == 0 ? *(const f32x4*)(w0 + c) : (region == 1 ? *(const f32x4*)(a0 + (c - 2048)) : (f32x4){0.f, 0.f, 0.f, 0.f}); }
#pragma unroll
        for (int ai = 0; ai < 2; ++ai)
#pragma unroll
            for (int m = 0; m < 4; ++m) { bf16_t* rowp = O + (size_t)(row0 + ai * 128 + m * 16) * LORA_N + col0;
#pragma unroll
                for (int bj = 0; bj < 2; ++bj) { f32x4 v0 = acc[ai][bj][m][0] + bv[bj][0], v1 = acc[ai][bj][m][1] + bv[bj][1];
                    if (region < 2) {
                        const float sc = region == 0 ? -0.6065306597126334f : 1.0f;
#pragma unroll
                        for (int j = 0; j < 4; ++j) { v0[j] = sc * sigmoidf_(v0[j]); v1[j] = sc * sigmoidf_(v1[j]); }
                    }
                    u32x4 w; w.x = cvt_pk_bf16(v0[0], v0[1]); w.y = cvt_pk_bf16(v0[2], v0[3]); w.z = cvt_pk_bf16(v1[0], v1[1]); w.w = cvt_pk_bf16(v1[2], v1[3]);
                    *(u32x4*)(rowp + bj * 128) = w; } asm volatile("" ::: "memory"); }
    }
};
template <int MODE> struct EpiBranch {
    static constexpr bool PERM = true, AFTER_DRAIN = false;
    const bf16_t* gate;
    float* mf; bf16_t* mb;
    __device__ __forceinline__ void operator()(const f32x4 (&acc)[2][2][4][2], const Unit& u, int wr, int wc, int fr, int fq) const {
        const int row0 = u.pm * 256 + wr * 64 + fr, col0 = u.pn * 256 + wc * 32 + 8 * fq;
#pragma unroll
        for (int ai = 0; ai < 2; ++ai)
#pragma unroll
            for (int m = 0; m < 4; ++m) { const size_t row = (size_t)(row0 + ai * 128 + m * 16);
#pragma unroll
                for (int bj = 0; bj < 2; ++bj) { const int col = col0 + bj * 128;
                    const u32x4 gw = *(const u32x4*)(gate + row * INC + col);
                    f32x4 g0, g1;
                    g0[0] = sigmoidf_(bflo(gw.x)); g0[1] = sigmoidf_(bfhi(gw.x)); g0[2] = sigmoidf_(bflo(gw.y)); g0[3] = sigmoidf_(bfhi(gw.y));
                    g1[0] = sigmoidf_(bflo(gw.z)); g1[1] = sigmoidf_(bfhi(gw.z)); g1[2] = sigmoidf_(bflo(gw.w)); g1[3] = sigmoidf_(bfhi(gw.w));
                    f32x4 v0 = acc[ai][bj][m][0] * g0, v1 = acc[ai][bj][m][1] * g1;
                    float* mp = mf + row * DM + col;
                    if (MODE >= 1) { v0 += *(const f32x4*)mp; v1 += *(const f32x4*)(mp + 4); }
                    if (MODE <= 1) { *(f32x4*)mp = v0; *(f32x4*)(mp + 4) = v1; }
                    else { u32x4 w; w.x = cvt_pk_bf16(v0[0], v0[1]); w.y = cvt_pk_bf16(v0[2], v0[3]); w.z = cvt_pk_bf16(v1[0], v1[1]); w.w = cvt_pk_bf16(v1[2], v1[3]);
                        *(u32x4*)(mb + row * DM + col) = w; } } asm volatile("" ::: "memory"); }
    }
};
struct EpiResid {
    static constexpr bool PERM = true, AFTER_DRAIN = false;
    const float* xf; float* o;
    __device__ __forceinline__ void operator()(const f32x4 (&acc)[2][2][4][2], const Unit& u, int wr, int wc, int fr, int fq) const {
        const int row0 = u.pm * 256 + wr * 64 + fr, col0 = u.pn * 256 + wc * 32 + 8 * fq;
#pragma unroll
        for (int ai = 0; ai < 2; ++ai)
#pragma unroll
            for (int m = 0; m < 4; ++m) { const size_t off = (size_t)(row0 + ai * 128 + m * 16) * DM + col0;
#pragma unroll
                for (int bj = 0; bj < 2; ++bj) { const f32x4 x0 = *(const f32x4*)(xf + off + bj * 128), x1 = *(const f32x4*)(xf + off + bj * 128 + 4);
                    *(f32x4*)(o + off + bj * 128) = x0 * DN_ALPHA + acc[ai][bj][m][0]; *(f32x4*)(o + off + bj * 128 + 4) = x1 * DN_ALPHA + acc[ai][bj][m][1]; } asm volatile("" ::: "memory"); }
    }
};
struct EpiSwiGLU {
    static constexpr bool PERM = true, AFTER_DRAIN = false;
    bf16_t* H;
    __device__ __forceinline__ void operator()(const f32x4 (&acc)[2][2][4][2], const Unit& u, int wr, int wc, int fr, int fq) const {
        const int row0 = u.pm * 256 + wr * 64 + fr, col0 = (u.pn & 15) * 128 + wc * 32 + 8 * fq;
#pragma unroll
        for (int ai = 0; ai < 2; ++ai)
#pragma unroll
            for (int m = 0; m < 4; ++m) { bf16_t* rowp = H + (size_t)(row0 + ai * 128 + m * 16) * DEXP + col0;
                f32x4 v[2];
#pragma unroll
                for (int n = 0; n < 2; ++n)
#pragma unroll
                    for (int j = 0; j < 4; ++j) { const float g = acc[ai][0][m][n][j], up = acc[ai][1][m][n][j]; v[n][j] = g * sigmoidf_(g) * up; }
                u32x4 w; w.x = cvt_pk_bf16(v[0][0], v[0][1]); w.y = cvt_pk_bf16(v[0][2], v[0][3]); w.z = cvt_pk_bf16(v[1][0], v[1][1]); w.w = cvt_pk_bf16(v[1][2], v[1][3]);
                *(u32x4*)rowp = w; asm volatile("" ::: "memory"); }
    }
};
struct EpiDown {
    static constexpr bool PERM = true, AFTER_DRAIN = false;
    bf16_t* Y; const float* grow;
    __device__ __forceinline__ void operator()(const f32x4 (&acc)[2][2][4][2], const Unit& u, int wr, int wc, int fr, int fq) const {
        const int row0 = u.pm * 256 + wr * 64 + fr, col0 = (u.pn & 3) * 256 + wc * 32 + 8 * fq;
#pragma unroll
        for (int ai = 0; ai < 2; ++ai)
#pragma unroll
            for (int m = 0; m < 4; ++m) { const int row = row0 + ai * 128 + m * 16; const float g = grow[row]; bf16_t* rowp = Y + (size_t)row * DM + col0;
#pragma unroll
                for (int bj = 0; bj < 2; ++bj) { const f32x4 v0 = acc[ai][bj][m][0] * g, v1 = acc[ai][bj][m][1] * g;
                    u32x4 w; w.x = cvt_pk_bf16(v0[0], v0[1]); w.y = cvt_pk_bf16(v0[2], v0[3]); w.z = cvt_pk_bf16(v1[0], v1[1]); w.w = cvt_pk_bf16(v1[2], v1[3]);
                    *(u32x4*)(rowp + bj * 128) = w; } asm volatile("" ::: "memory"); }
    }
};

__device__ __forceinline__ void tconv(const float* __restrict__ src, int nb, int K, int N, bf16_t* __restrict__ dst, size_t dst_bs, int ldd, int blk, int bstride, int boff, float* tile) {
    const int tid = otid(), ntn = N >> 8, tpb = (K >> 6) * ntn, nt = nb * tpb;
    for (int t = blockIdx.x; t < nt; t += gridDim.x) {
        const int bi = t / tpb, tr = t % tpb, k0 = (tr / ntn) * 64, n0 = (tr % ntn) * 256;
        const float* sb = src + (size_t)bi * K * N;
        f32x4 v[8];
#pragma unroll
        for (int i = 0; i < 8; ++i) { const int kk = i * 8 + (tid >> 6), nn = (tid & 63) * 4; v[i] = *(const f32x4*)(sb + (size_t)(k0 + kk) * N + n0 + nn); }
#pragma unroll
        for (int i = 0; i < 8; ++i) { const int kk = i * 8 + (tid >> 6), nn = (tid & 63) * 4; float* tp = tile + kk * 257 + nn; tp[0] = v[i][0]; tp[1] = v[i][1]; tp[2] = v[i][2]; tp[3] = v[i][3]; }
        __syncthreads();
        bf16_t* db = dst + (size_t)bi * dst_bs;
#pragma unroll
        for (int j = 0; j < 4; ++j) { const int q = tid + 512 * j, n = q >> 3, kc = q & 7; const float* s = tile + (kc * 8) * 257 + n;
            u32x4 o; o.x = cvt_pk_bf16(s[0], s[257]); o.y = cvt_pk_bf16(s[2 * 257], s[3 * 257]); o.z = cvt_pk_bf16(s[4 * 257], s[5 * 257]); o.w = cvt_pk_bf16(s[6 * 257], s[7 * 257]);
            const int gn = n0 + n, drow = (gn / blk) * bstride + boff + (gn % blk);
            *(u32x4*)(db + (size_t)drow * ldd + k0 + kc * 8) = o; }
        __syncthreads();
    }
}

__device__ __forceinline__ void phase_convert(const Params& P, float* ldsf) {
    unsigned char* ws = P.ws;
    const int NOBLK = 1 << 30;
    tconv(P.in[I_WIN], DEPTH, DM, INC, (bf16_t*)(ws + WS_WIN), (size_t)INC * DM, DM, NOBLK, 0, 0, ldsf);
    tconv(P.in[I_WBR], DEPTH, BRK, DM, (bf16_t*)(ws + WS_WBR), (size_t)DM * BRK, BRK, NOBLK, 0, 0, ldsf);
    tconv(P.in[I_WOUT], DEPTH, DM, DM, (bf16_t*)(ws + WS_WOUT), (size_t)DM * DM, DM, NOBLK, 0, 0, ldsf);
    tconv(P.in[I_WKV], DEPTH, DM, 512, (bf16_t*)(ws + WS_WKV), (size_t)512 * DM, DM, NOBLK, 0, 0, ldsf);
    tconv(P.in[I_EWG], DEPTH * NEXP, DM, DEXP, (bf16_t*)(ws + WS_WGU), (size_t)4096 * DM, DM, 128, 256, 0, ldsf);
    tconv(P.in[I_EWU], DEPTH * NEXP, DM, DEXP, (bf16_t*)(ws + WS_WGU), (size_t)4096 * DM, DM, 128, 256, 128, ldsf);
    tconv(P.in[I_EWD], DEPTH * NEXP, DEXP, DM, (bf16_t*)(ws + WS_WDN), (size_t)DM * DEXP, DEXP, NOBLK, 0, 0, ldsf);
    const size_t gtid = (size_t)blockIdx.x * NTHR + otid(), gsz = (size_t)gridDim.x * NTHR;
    { const f32x4* x4 = (const f32x4*)P.in[I_X]; f32x4* xf4 = (f32x4*)(ws + WS_XF); u32x2* xb2 = (u32x2*)(ws + WS_XB);
      for (size_t i = gtid; i < (size_t)NTOK * DM / 4; i += gsz) { const f32x4 v = x4[i]; xf4[i] = v; u32x2 w; w.x = cvt_pk_bf16(v[0], v[1]); w.y = cvt_pk_bf16(v[2], v[3]); xb2[i] = w; } }
    { const f32x4* m4 = (const f32x4*)P.in[I_MEM]; u32x2* mb2 = (u32x2*)(ws + WS_MEMB);
      for (size_t i = gtid; i < (size_t)NBATCH * NMEM * DM / 4; i += gsz) { const f32x4 v = m4[i]; u32x2 w; w.x = cvt_pk_bf16(v[0], v[1]); w.y = cvt_pk_bf16(v[2], v[3]); mb2[i] = w; } }
    { bf16_t* wl = (bf16_t*)(ws + WS_WLORA); const float* wup = P.in[I_WUP]; const float* aup = P.in[I_AUP]; const float* gup = P.in[I_GUP];
      for (size_t i = gtid; i < (size_t)DEPTH * LORA_N * 256; i += gsz) {
          const int n = (int)(i % LORA_N), k = (int)((i / LORA_N) % 256), l = (int)(i / ((size_t)LORA_N * 256));
          float v = 0.f;
          if (n < 2048) { if (k < 64) v = wup[((size_t)(l * 2 + (n >> 10)) * 64 + k) * 1024 + (n & 1023)]; }
          else if (n < 4096) { if (k >= 64 && k < 128) v = aup[((size_t)(l * 2 + ((n - 2048) >> 10)) * 64 + (k - 64)) * 1024 + (n & 1023)]; }
          else { if (k >= 128) v = gup[((size_t)l * 128 + (k - 128)) * 1024 + (n - 4096)]; }
          wl[((size_t)l * LORA_N + n) * 256 + k] = f2bf(v); } }
}

__device__ __forceinline__ void phase_prepass(const Params& P, int l) {
    const bf16_t* p = (const bf16_t*)(P.ws + WS_P); bf16_t* ap = (bf16_t*)(P.ws + WS_APR);
    const float* mu = P.in[I_MU] + (size_t)l * 2 * RWC;
    const size_t gtid = (size_t)blockIdx.x * NTHR + otid(), gsz = (size_t)gridDim.x * NTHR;
    for (size_t i = gtid; i < (size_t)NTOK * 256; i += gsz) {
        const int j = (int)(i & 255), tok = (int)(i >> 8), s = tok & (SEQ - 1), col = C_DW + j;
        const float x = bf2f(p[(size_t)tok * INC + col]);
        const float xp = s > 0 ? bf2f(p[(size_t)(tok - 1) * INC + col]) : 0.f, xn = s < SEQ - 1 ? bf2f(p[(size_t)(tok + 1) * INC + col]) : 0.f;
        float v = x + mu[col] * (xp - x) + mu[RWC + col] * (xn - x);
        if (j < 64) v = tanhf(v); else if (j >= 128) v = sigmoidf_(v);
        ap[i] = f2bf(v);
    }
}

__device__ __forceinline__ void phase_scan(const Params& P, int l, float* ldsf) {
    const bf16_t* p = (const bf16_t*)(P.ws + WS_P); const bf16_t* lora = (const bf16_t*)(P.ws + WS_LORA);
    float* ydir = (float*)(P.ws + WS_YDIR); float* bonus = (float*)(P.ws + WS_BONUS);
    float* buf = ldsf; float* ybuf = ldsf + 32 * 384;
    const int tid = otid(), lane = tid & 63, wid = tid >> 6;
    for (int u = blockIdx.x; u < 256; u += gridDim.x) {
        const int z = u & 1, h = (u >> 1) & 15, b = u >> 5;
        const int ch = lane, c = h * 64 + ch;
        const float* mu = P.in[I_MU] + (size_t)l * 2 * RWC;
        const float mu0r = mu[C_R + c], mu1r = mu[RWC + C_R + c], mu0k = mu[C_K + c], mu1k = mu[RWC + C_K + c], mu0v = mu[C_V + c], mu1v = mu[RWC + C_V + c];
        const float k_k = P.in[I_KK][l * 1024 + c], k_a = P.in[I_KA][l * 1024 + c], r_k = P.in[I_RK][l * 1024 + c];
        float S[8];
#pragma unroll
        for (int j = 0; j < 8; ++j) S[j] = 0.f;
        const int vrow = wid * 8 + (lane >> 3), kg = lane & 7;
        float rw[6][3]; float lw[4][2];
#define SCAN_LOAD(n) do { const int i0_ = (n) * 32 + wid * 4; \
        _Pragma("unroll") for (int rr = 0; rr < 6; ++rr) { const int i_ = i0_ - 1 + rr; const int t_ = z ? (SEQ - 1) - i_ : i_; const bool ok_ = (t_ >= 0) && (t_ < SEQ); const bf16_t* pr_ = p + (size_t)(b * SEQ + (ok_ ? t_ : 0)) * INC + c; \
            rw[rr][0] = ok_ ? bf2f(pr_[C_R]) : 0.f; rw[rr][1] = ok_ ? bf2f(pr_[C_K]) : 0.f; rw[rr][2] = ok_ ? bf2f(pr_[C_V]) : 0.f; } \
        _Pragma("unroll") for (int j = 0; j < 4; ++j) { const int i_ = i0_ + j; const int t_ = z ? (SEQ - 1) - i_ : i_; const bf16_t* lr_ = lora + (size_t)(b * SEQ + t_) * LORA_N + z * 1024 + c; lw[j][0] = bf2f(lr_[0]); lw[j][1] = bf2f(lr_[2048]); } } while (0)
        SCAN_LOAD(0);
        for (int n = 0; n < SEQ / 32; ++n) {
            { const int i0 = n * 32 + wid * 4;
#pragma unroll
              for (int j = 0; j < 4; ++j) {
                  const int il = wid * 4 + j, i = i0 + j, tok = b * SEQ + (z ? (SEQ - 1) - i : i);
                  const float rp = z ? rw[j + 2][0] : rw[j][0], rn = z ? rw[j][0] : rw[j + 2][0], rc = rw[j + 1][0];
                  const float kp = z ? rw[j + 2][1] : rw[j][1], kn = z ? rw[j][1] : rw[j + 2][1], kc = rw[j + 1][1];
                  const float vp = z ? rw[j + 2][2] : rw[j][2], vn = z ? rw[j][2] : rw[j + 2][2], vc = rw[j + 1][2];
                  const float r_ = rc + mu0r * (rp - rc) + mu1r * (rn - rc);
                  const float k_ = kc + mu0k * (kp - kc) + mu1k * (kn - kc);
                  const float v_ = vc + mu0v * (vp - vc) + mu1v * (vn - vc);
                  const float kkraw = k_ * k_k; const float ss = wave_sum(kkraw * kkraw);
                  const float kk = kkraw * rsqrtf(fmaxf(ss, 1e-12f));
                  const float a = lw[j][1], w = __expf(lw[j][0]);
                  const float kd = k_ * (1.0f + (a - 1.0f) * k_a);
                  const float bon = wave_sum(r_ * kd * r_k);
                  if (lane == 0) bonus[((size_t)z * NTOK + tok) * 16 + h] = bon;
                  float* bp = buf + il * 384 + ch;
                  bp[0] = w; bp[64] = a * kk; bp[128] = kd; bp[192] = kk; bp[256] = r_; bp[320] = v_;
              } }
            if (n > 0) { const int il = tid >> 4, v4 = (tid & 15) * 4; const int i = (n - 1) * 32 + il; const int t = z ? (SEQ - 1) - i : i;
                *(f32x4*)(ydir + ((size_t)z * NTOK + b * SEQ + t) * DM + h * 64 + v4) = *(const f32x4*)(ybuf + il * 64 + v4); }
            __syncthreads();
            if (n + 1 < SEQ / 32) SCAN_LOAD(n + 1);
            for (int il = 0; il < 32; ++il) {
                const float* bp = buf + il * 384 + kg * 8;
                const f32x4 w0 = *(const f32x4*)(bp), w1 = *(const f32x4*)(bp + 4);
                const f32x4 a0 = *(const f32x4*)(bp + 64), a1 = *(const f32x4*)(bp + 68);
                const f32x4 d0 = *(const f32x4*)(bp + 128), d1 = *(const f32x4*)(bp + 132);
                const f32x4 k0 = *(const f32x4*)(bp + 192), k1 = *(const f32x4*)(bp + 196);
                const f32x4 r0 = *(const f32x4*)(bp + 256), r1 = *(const f32x4*)(bp + 260);
                const float vv = buf[il * 384 + 320 + vrow];
                float sa = 0.f;
#pragma unroll
                for (int j = 0; j < 4; ++j) { sa += S[j] * k0[j]; sa += S[4 + j] * k1[j]; }
                sa += __shfl_xor(sa, 1); sa += __shfl_xor(sa, 2); sa += __shfl_xor(sa, 4);
                float y = 0.f;
#pragma unroll
                for (int j = 0; j < 4; ++j) {
                    S[j] = S[j] * w0[j] + (vv * d0[j] - sa * a0[j]); y += S[j] * r0[j];
                    S[4 + j] = S[4 + j] * w1[j] + (vv * d1[j] - sa * a1[j]); y += S[4 + j] * r1[j];
                }
                y += __shfl_xor(y, 1); y += __shfl_xor(y, 2); y += __shfl_xor(y, 4);
                if (kg == 0) ybuf[il * 64 + vrow] = y;
            }
            __syncthreads();
        }
        { const int il = tid >> 4, v4 = (tid & 15) * 4; const int i = (SEQ / 32 - 1) * 32 + il; const int t = z ? (SEQ - 1) - i : i;
          *(f32x4*)(ydir + ((size_t)z * NTOK + b * SEQ + t) * DM + h * 64 + v4) = *(const f32x4*)(ybuf + il * 64 + v4); }
        __syncthreads();
#undef SCAN_LOAD
    }
}

template <int MODE>
__device__ __forceinline__ void naive_attn_wave(const Params& P, int l, int unit, const float* biasT  ) {
    const bf16_t* p = (const bf16_t*)(P.ws + WS_P);
    const int lane = otid() & 63;
    const int qg = unit & 255, tok = qg * 64 + lane, b = qg >> 5, s0 = (qg & 31) * 64, qi = s0 + lane;
    const bf16_t* qp; const bf16_t* kb; const bf16_t* vb; size_t ldk; int jlo, jhi, hb = 0;
    float m, lsum;
    int h = 0, cc = 0, half = 0, hd = 0, head = 0;
    if (MODE == 0) { head = unit >> 8; const int kvh = head >> 2;
        qp = p + (size_t)tok * INC + C_WQ + head * 64; kb = p + (size_t)(b * SEQ) * INC + C_WK + kvh * 64; vb = p + (size_t)(b * SEQ) * INC + C_WV + kvh * 64; ldk = INC;
        jlo = s0 - 128 < 0 ? 0 : s0 - 128; jhi = s0 + 63 + 128 > SEQ - 1 ? SEQ - 1 : s0 + 63 + 128; hb = head;
        m = P.in[I_SINK][l * 16 + head]; lsum = 1.0f;
    } else if (MODE == 1) { const int vh = (unit >> 8) & 15; h = vh >> 1; cc = vh & 1; half = unit >> 12;
        qp = p + (size_t)tok * INC + C_DQ + h * 128 + cc * 64; kb = p + (size_t)(b * SEQ) * INC + C_DK + h * 128 + cc * 64; vb = p + (size_t)(b * SEQ) * INC + C_DV + h * 128 + half * 64; ldk = INC;
        jlo = 0; jhi = SEQ - 1; hb = 16 + h; m = -INFINITY; lsum = 0.f;
    } else { hd = unit >> 8; const bf16_t* kv = (const bf16_t*)(P.ws + WS_KVMEM);
        qp = p + (size_t)tok * INC + C_MQ + hd * 64; kb = kv + (size_t)(b * NMEM) * 2048 + l * 512 + hd * 64; vb = kb + 256; ldk = 2048;
        jlo = 0; jhi = NMEM - 1; m = -INFINITY; lsum = 0.f;
    }
    float q[64], o[64];
#pragma unroll
    for (int c8 = 0; c8 < 8; ++c8) { const u32x4 w = *(const u32x4*)(qp + c8 * 8);
        q[c8 * 8 + 0] = bflo(w.x) * 0.125f; q[c8 * 8 + 1] = bfhi(w.x) * 0.125f; q[c8 * 8 + 2] = bflo(w.y) * 0.125f; q[c8 * 8 + 3] = bfhi(w.y) * 0.125f;
        q[c8 * 8 + 4] = bflo(w.z) * 0.125f; q[c8 * 8 + 5] = bfhi(w.z) * 0.125f; q[c8 * 8 + 6] = bflo(w.w) * 0.125f; q[c8 * 8 + 7] = bfhi(w.w) * 0.125f; }
#pragma unroll
    for (int d = 0; d < 64; ++d) o[d] = 0.f;
    for (int j = jlo; j <= jhi; ++j) {
        const u32x4* kp = (const u32x4*)(kb + (size_t)j * ldk);
        float s = 0.f;
#pragma unroll
        for (int c8 = 0; c8 < 8; ++c8) { const u32x4 w = kp[c8];
            s += q[c8 * 8 + 0] * bflo(w.x); s += q[c8 * 8 + 1] * bfhi(w.x); s += q[c8 * 8 + 2] * bflo(w.y); s += q[c8 * 8 + 3] * bfhi(w.y);
            s += q[c8 * 8 + 4] * bflo(w.z); s += q[c8 * 8 + 5] * bfhi(w.z); s += q[c8 * 8 + 6] * bflo(w.w); s += q[c8 * 8 + 7] * bfhi(w.w); }
        if (MODE <= 1) { const int rel = j - qi; s += biasT[t5_bucket(rel) * 24 + hb];
            if (MODE == 0) { const int ar = rel < 0 ? -rel : rel; if (ar > 128) s = -INFINITY; } }
        const float mn = fmaxf(m, s), corr = __expf(m - mn), pe = __expf(s - mn);
        lsum = lsum * corr + pe; m = mn;
        const u32x4* vp = (const u32x4*)(vb + (size_t)j * ldk);
#pragma unroll
        for (int c8 = 0; c8 < 8; ++c8) { const u32x4 w = vp[c8];
            o[c8 * 8 + 0] = o[c8 * 8 + 0] * corr + pe * bflo(w.x); o[c8 * 8 + 1] = o[c8 * 8 + 1] * corr + pe * bfhi(w.x);
            o[c8 * 8 + 2] = o[c8 * 8 + 2] * corr + pe * bflo(w.y); o[c8 * 8 + 3] = o[c8 * 8 + 3] * corr + pe * bfhi(w.y);
            o[c8 * 8 + 4] = o[c8 * 8 + 4] * corr + pe * bflo(w.z); o[c8 * 8 + 5] = o[c8 * 8 + 5] * corr + pe * bfhi(w.z);
            o[c8 * 8 + 6] = o[c8 * 8 + 6] * corr + pe * bflo(w.w); o[c8 * 8 + 7] = o[c8 * 8 + 7] * corr + pe * bfhi(w.w); }
    }
    const float inv = 1.0f / lsum;
    if (MODE == 1) { float* dp = (float*)(P.ws + WS_DTMP) + (((size_t)tok * 8 + h) * 2 + cc) * 128 + half * 64;
#pragma unroll
        for (int d4 = 0; d4 < 16; ++d4) { f32x4 v; v[0] = o[d4 * 4] * inv; v[1] = o[d4 * 4 + 1] * inv; v[2] = o[d4 * 4 + 2] * inv; v[3] = o[d4 * 4 + 3] * inv; *(f32x4*)(dp + d4 * 4) = v; }
    } else { bf16_t* yp = (bf16_t*)(P.ws + WS_YCAT) + (size_t)tok * BRK + (MODE == 0 ? 1024 + head * 64 : 3072 + hd * 64);
#pragma unroll
        for (int c8 = 0; c8 < 8; ++c8) { u32x4 w; w.x = cvt_pk_bf16(o[c8 * 8] * inv, o[c8 * 8 + 1] * inv); w.y = cvt_pk_bf16(o[c8 * 8 + 2] * inv, o[c8 * 8 + 3] * inv);
            w.z = cvt_pk_bf16(o[c8 * 8 + 4] * inv, o[c8 * 8 + 5] * inv); w.w = cvt_pk_bf16(o[c8 * 8 + 6] * inv, o[c8 * 8 + 7] * inv); *(u32x4*)(yp + c8 * 8) = w; }
    }
}
__device__ __forceinline__ void phase_attn_naive(const Params& P, int l, float* ldsf) {
    const int tid = otid(), wid = __builtin_amdgcn_readfirstlane(tid >> 6);
    for (int i = tid; i < 32 * 24; i += NTHR) ldsf[i] = P.in[I_RELB][i];
    __syncthreads();
    for (int u = blockIdx.x * 8 + wid; u < 8192; u += gridDim.x * 8) naive_attn_wave<1>(P, l, u, ldsf);
    for (int u = blockIdx.x * 8 + wid; u < 4096; u += gridDim.x * 8) naive_attn_wave<0>(P, l, u, ldsf);
    for (int u = blockIdx.x * 8 + wid; u < 1024; u += gridDim.x * 8) naive_attn_wave<2>(P, l, u, ldsf);
    __syncthreads();
}

__device__ __forceinline__ void phase_post(const Params& P, int l) {
    const bf16_t* p = (const bf16_t*)(P.ws + WS_P); const bf16_t* lora = (const bf16_t*)(P.ws + WS_LORA);
    const float* ydir = (const float*)(P.ws + WS_YDIR); const float* bonus = (const float*)(P.ws + WS_BONUS);
    bf16_t* ycat = (bf16_t*)(P.ws + WS_YCAT);
    const int tid = otid(), lane = tid & 63, wid = tid >> 6;
    const float* mu = P.in[I_MU] + (size_t)l * 2 * RWC;
    for (int u = blockIdx.x * 8 + wid; u < NTOK * 16; u += gridDim.x * 8) {
        const int tok = u >> 4, h = u & 15, c = h * 64 + lane, s = tok & (SEQ - 1);
        const float y = ydir[(size_t)tok * DM + c] + ydir[((size_t)NTOK + tok) * DM + c];
        const float mean = wave_sum(y) * (1.0f / 64.0f); const float dy = y - mean; const float var = wave_sum(dy * dy) * (1.0f / 64.0f);
        const float yn = dy * rsqrtf(var + 64e-5f) * P.in[I_GNG][l * 1024 + c] + P.in[I_GNB][l * 1024 + c];
        const float v = bf2f(p[(size_t)tok * INC + C_V + c]);
        const float vp = s > 0 ? bf2f(p[(size_t)(tok - 1) * INC + C_V + c]) : 0.f, vn = s < SEQ - 1 ? bf2f(p[(size_t)(tok + 1) * INC + C_V + c]) : 0.f;
        const float vs = v + mu[C_V + c] * (vp - v) + mu[RWC + C_V + c] * (vn - v);
        const float bon = bonus[(size_t)tok * 16 + h] + bonus[((size_t)NTOK + tok) * 16 + h];
        const float g = bf2f(lora[(size_t)tok * LORA_N + 4096 + c]);
        ycat[(size_t)tok * BRK + c] = f2bf((yn + bon * vs) * g);
    }
    const float* lam = P.in[I_LAM] + l * 256;
    const float l1 = wave_sum(lam[lane] * lam[64 + lane]), l2 = wave_sum(lam[128 + lane] * lam[192 + lane]);
    const float lambda_init = 0.8f - 0.6f * expf(-0.3f * (float)l);
    const float lam_full = expf(l1) - expf(l2) + lambda_init;
    const float* dt = (const float*)(P.ws + WS_DTMP);
    const float sg0 = P.in[I_SUBLN][l * 128 + lane * 2] * (1.0f - lambda_init), sg1 = P.in[I_SUBLN][l * 128 + lane * 2 + 1] * (1.0f - lambda_init);
    for (int u = blockIdx.x * 8 + wid; u < NTOK * 8; u += gridDim.x * 8) {
        const int tok = u >> 3, h = u & 7;
        const f32x2 a = *(const f32x2*)(dt + ((size_t)u * 2 + 0) * 128 + lane * 2), bq = *(const f32x2*)(dt + ((size_t)u * 2 + 1) * 128 + lane * 2);
        const float o0 = a[0] - lam_full * bq[0], o1 = a[1] - lam_full * bq[1];
        const float ms = wave_sum(o0 * o0 + o1 * o1) * (1.0f / 128.0f); const float rs = rsqrtf(ms + 1e-5f);
        *(unsigned*)(ycat + (size_t)tok * BRK + 2048 + h * 128 + lane * 2) = cvt_pk_bf16(o0 * rs * sg0, o1 * rs * sg1);
    }
}

__device__ __forceinline__ void phase_ln1(const Params& P, int l, float* ldsf) {
    const float* pre = (const float*)(P.ws + WS_PRELN); float* xf = (float*)(P.ws + WS_XF); bf16_t* xb = (bf16_t*)(P.ws + WS_XB); float* aff = (float*)(P.ws + WS_AFF);
    const float* g = P.in[I_LN1G] + l * DM; const float* bt = P.in[I_LN1B] + l * DM; const float* router = P.in[I_ROUTER] + (size_t)l * DM * 16;
    const int tid = otid(), lane = tid & 63, wid = tid >> 6;
    for (int i = tid; i < DM * 16 / 4; i += NTHR) ((f32x4*)ldsf)[i] = ((const f32x4*)router)[i];
    __syncthreads();
    f32x4 gv[4], bv[4];
#pragma unroll
    for (int i = 0; i < 4; ++i) { gv[i] = *(const f32x4*)(g + lane * 4 + 256 * i); bv[i] = *(const f32x4*)(bt + lane * 4 + 256 * i); }
    for (int row = blockIdx.x * 8 + wid; row < NTOK; row += gridDim.x * 8) {
        f32x4 v[4]; float s = 0.f;
#pragma unroll
        for (int i = 0; i < 4; ++i) { v[i] = *(const f32x4*)(pre + (size_t)row * DM + lane * 4 + 256 * i); s += (v[i][0] + v[i][1]) + (v[i][2] + v[i][3]); }
        const float mean = wave_sum(s) * (1.0f / DM); float s2 = 0.f;
#pragma unroll
        for (int i = 0; i < 4; ++i) { v[i] = v[i] - mean; s2 += (v[i][0] * v[i][0] + v[i][1] * v[i][1]) + (v[i][2] * v[i][2] + v[i][3] * v[i][3]); }
        const float rstd = rsqrtf(wave_sum(s2) * (1.0f / DM) + 1e-5f);
        float lg[16];
#pragma unroll
        for (int e = 0; e < 16; ++e) lg[e] = 0.f;
#pragma unroll
        for (int i = 0; i < 4; ++i) { v[i] = v[i] * rstd * gv[i] + bv[i];
            *(f32x4*)(xf + (size_t)row * DM + lane * 4 + 256 * i) = v[i];
            u32x2 w; w.x = cvt_pk_bf16(v[i][0], v[i][1]); w.y = cvt_pk_bf16(v[i][2], v[i][3]); *(u32x2*)(xb + (size_t)row * DM + lane * 4 + 256 * i) = w;
#pragma unroll
            for (int j = 0; j < 4; ++j) { const float* rp = ldsf + (lane * 4 + 256 * i + j) * 16;
#pragma unroll
                for (int e4 = 0; e4 < 4; ++e4) { const f32x4 r = *(const f32x4*)(rp + e4 * 4); lg[e4 * 4] += v[i][j] * r[0]; lg[e4 * 4 + 1] += v[i][j] * r[1]; lg[e4 * 4 + 2] += v[i][j] * r[2]; lg[e4 * 4 + 3] += v[i][j] * r[3]; } } }
        float mx = -INFINITY;
#pragma unroll
        for (int e = 0; e < 16; ++e) { lg[e] = wave_sum(lg[e]); mx = fmaxf(mx, lg[e]); }
        float se = 0.f, mine = 0.f;
#pragma unroll
        for (int e = 0; e < 16; ++e) { const float ex = expf(lg[e] - mx); se += ex; if (lane == e) mine = ex; }
        if (lane < 16) aff[(size_t)row * 16 + lane] = mine / se;
    }
    __syncthreads();
}
__device__ __forceinline__ void phase_ln2(const Params& P, int l) {
    float* xf = (float*)(P.ws + WS_XF); bf16_t* xb = (bf16_t*)(P.ws + WS_XB); const bf16_t* ye = (const bf16_t*)(P.ws + WS_YE); const int* slot_of = (const int*)(P.ws + WS_SLOT);
    const float* g = P.in[I_LN2G] + l * DM; const float* bt = P.in[I_LN2B] + l * DM;
    float* dst = (l == DEPTH - 1) ? P.out : xf;
    const int tid = otid(), lane = tid & 63, wid = tid >> 6;
    f32x4 gv[4], bv[4];
#pragma unroll
    for (int i = 0; i < 4; ++i) { gv[i] = *(const f32x4*)(g + lane * 4 + 256 * i); bv[i] = *(const f32x4*)(bt + lane * 4 + 256 * i); }
    for (int row = blockIdx.x * 8 + wid; row < NTOK; row += gridDim.x * 8) {
        const int b = row >> 11;
        f32x4 v[4];
#pragma unroll
        for (int i = 0; i < 4; ++i) v[i] = *(const f32x4*)(xf + (size_t)row * DM + lane * 4 + 256 * i) * DN_ALPHA;
        const int sl = lane < 16 ? slot_of[(size_t)row * 16 + lane] : -1;
        for (int e = 0; e < 16; ++e) { const int s = __shfl(sl, e);
            if (s >= 0) { const bf16_t* yr = ye + ((size_t)(e * 8 + b) * 256 + s) * DM + lane * 4;
#pragma unroll
                for (int i = 0; i < 4; ++i) { const u32x2 w = *(const u32x2*)(yr + 256 * i); v[i][0] += bflo(w.x); v[i][1] += bfhi(w.x); v[i][2] += bflo(w.y); v[i][3] += bfhi(w.y); } } }
        float s = 0.f;
#pragma unroll
        for (int i = 0; i < 4; ++i) s += (v[i][0] + v[i][1]) + (v[i][2] + v[i][3]);
        const float mean = wave_sum(s) * (1.0f / DM); float s2 = 0.f;
#pragma unroll
        for (int i = 0; i < 4; ++i) { v[i] = v[i] - mean; s2 += (v[i][0] * v[i][0] + v[i][1] * v[i][1]) + (v[i][2] * v[i][2] + v[i][3] * v[i][3]); }
        const float rstd = rsqrtf(wave_sum(s2) * (1.0f / DM) + 1e-5f);
#pragma unroll
        for (int i = 0; i < 4; ++i) { v[i] = v[i] * rstd * gv[i] + bv[i];
            *(f32x4*)(dst + (size_t)row * DM + lane * 4 + 256 * i) = v[i];
            u32x2 w; w.x = cvt_pk_bf16(v[i][0], v[i][1]); w.y = cvt_pk_bf16(v[i][2], v[i][3]); *(u32x2*)(xb + (size_t)row * DM + lane * 4 + 256 * i) = w; }
    }
}

__device__ __forceinline__ void phase_topk(const Params& P, unsigned long long* keys  ) {
    const float* aff = (const float*)(P.ws + WS_AFF); float* grow = (float*)(P.ws + WS_GROW); int* slot_of = (int*)(P.ws + WS_SLOT);
    const bf16_t* xb = (const bf16_t*)(P.ws + WS_XB); bf16_t* xe = (bf16_t*)(P.ws + WS_XE);
    const int tid = otid();
    for (int u = blockIdx.x; u < NBATCH * NEXP; u += gridDim.x) {
        const int b = u >> 4, e = u & 15;
#pragma unroll
        for (int j = 0; j < 4; ++j) { const int i = tid + 512 * j; const float v = aff[((size_t)b * SEQ + i) * 16 + e];
            keys[i] = ((unsigned long long)__float_as_uint(v) << 32) | (unsigned long long)(0xFFFFFFFFu - (unsigned)i); }
        __syncthreads();
        for (int k = 2; k <= SEQ; k <<= 1)
            for (int j = k >> 1; j > 0; j >>= 1) {
#pragma unroll
                for (int t2 = 0; t2 < 2; ++t2) { const int t = tid + 512 * t2; const int i = ((t & ~(j - 1)) << 1) | (t & (j - 1)), ixj = i | j;
                    const unsigned long long a = keys[i], c = keys[ixj]; const bool desc = (i & k) == 0;
                    if (desc ? (a < c) : (a > c)) { keys[i] = c; keys[ixj] = a; } }
                __syncthreads();
            }
#pragma unroll
        for (int j = 0; j < 4; ++j) { const int r = tid + 512 * j; const unsigned long long kk = keys[r]; const int tl = (int)(0xFFFFFFFFu - (unsigned)(kk & 0xFFFFFFFFull));
            slot_of[((size_t)b * SEQ + tl) * 16 + e] = r < CAP ? r : -1;
            if (r < CAP) grow[(e * 8 + b) * CAP + r] = __uint_as_float((unsigned)(kk >> 32)); }
        for (int q = tid; q < CAP * 128; q += NTHR) { const int r = q >> 7, ch = q & 127; const int tl = (int)(0xFFFFFFFFu - (unsigned)(keys[r] & 0xFFFFFFFFull));
            *(u32x4*)(xe + ((size_t)(e * 8 + b) * CAP + r) * DM + ch * 8) = *(const u32x4*)(xb + ((size_t)b * SEQ + tl) * DM + ch * 8); }
        __syncthreads();
    }
}
#define XB_TMO      128
#define XB_XCNT(j)  (256  + 64 * (j))
#define XB_XSUB(j)  (1280 + 64 * (j))
#define XB_XGEN(j)  (2304 + 64 * (j))
#define XB_TOP      3328
#define XB_TOPGEN   3392
#define XCD_BAR_WORDS 3456
#define XB_SPIN_CAP (1u << 18)

__device__ __forceinline__ unsigned xb_ld(unsigned* p)              { return __hip_atomic_load(p, __ATOMIC_RELAXED, __HIP_MEMORY_SCOPE_AGENT); }
__device__ __forceinline__ unsigned xb_add(unsigned* p, unsigned v) { return __hip_atomic_fetch_add(p, v, __ATOMIC_RELAXED, __HIP_MEMORY_SCOPE_AGENT); }
__device__ __forceinline__ unsigned xb_xcc_id() { return (unsigned)__builtin_amdgcn_s_getreg((3 << 11) | 20) & 0xFu; }
#define XB_SPIN(cond, bar) do { unsigned _sp = 0; while (cond) { __builtin_amdgcn_s_sleep(1); \
    if ((++_sp & 255u) == 0u) { if (xb_ld(&(bar)[XB_TMO])) break; if (_sp > XB_SPIN_CAP) { atomicAdd(&(bar)[XB_TMO], 1u); break; } } } } while (0)

struct XcdBarrier {
    unsigned* bar; unsigned x;
    volatile LAS unsigned* st;
};

__device__ __forceinline__ XcdBarrier xcd_barrier_post(unsigned* bar, volatile LAS unsigned* st) {
    XcdBarrier b; b.bar = bar; b.x = xb_xcc_id(); b.st = st;
    if (threadIdx.x == 0) (void)xb_add(&bar[XB_XCNT(b.x)], 1u);
    return b;
}
__device__ __forceinline__ void xcd_barrier_complete(unsigned* bar, unsigned x, unsigned& nloc, unsigned& nx) {
    const unsigned G = gridDim.x * gridDim.y * gridDim.z;
    unsigned sum, cnt, mine, sp = 0u;
    for (;;) {
        sum = 0u; cnt = 0u; mine = 0u;
#pragma unroll
        for (unsigned j = 0; j < 16; ++j) { const unsigned c = xb_ld(&bar[XB_XCNT(j)]); sum += c; cnt += (c > 0u) ? 1u : 0u; mine = (j == x) ? c : mine; }
        if (sum == G) break;
        __builtin_amdgcn_s_sleep(1);
        if ((++sp & 255u) == 0u) { if (xb_ld(&bar[XB_TMO])) break; if (sp > XB_SPIN_CAP) { atomicAdd(&bar[XB_TMO], 1u); break; } }
    }
    nloc = mine > 0u ? mine : 1u; nx = cnt > 0u ? cnt : 1u;
}

__device__ __forceinline__ void xcd_barrier(const XcdBarrier& b) {
    asm volatile("s_waitcnt vmcnt(0)" ::: "memory");
    __syncthreads();
    if (threadIdx.x == 0) {
        unsigned* bar = b.bar;
        __builtin_amdgcn_s_waitcnt(0);
        unsigned nloc = b.st[0], nx = b.st[1];
        if (nloc == 0u) { xcd_barrier_complete(bar, b.x, nloc, nx); b.st[0] = nloc; b.st[1] = nx; }
        const unsigned old = xb_add(&bar[XB_XSUB(b.x)], 1u);
        const unsigned gen = old / nloc;
        if (old + 1u == (gen + 1u) * nloc) {
            __builtin_amdgcn_fence(__ATOMIC_RELEASE, "agent");
            asm volatile("s_waitcnt vmcnt(0)" ::: "memory");
            const unsigned og = xb_add(&bar[XB_TOP], 1u);
            const unsigned tg = og / nx;
            if (og + 1u == (tg + 1u) * nx) xb_add(&bar[XB_TOPGEN], 1u);
            else XB_SPIN(xb_ld(&bar[XB_TOPGEN]) == tg, bar);
            __builtin_amdgcn_fence(__ATOMIC_ACQUIRE, "agent");
            xb_add(&bar[XB_XGEN(b.x)], 1u);
            asm volatile("s_waitcnt vmcnt(0)" ::: "memory");
        } else {
            XB_SPIN(xb_ld(&bar[XB_XGEN(b.x)]) == gen, bar);
            __builtin_amdgcn_fence(__ATOMIC_ACQUIRE, "agent");
            asm volatile("s_waitcnt vmcnt(0)" ::: "memory");
        }
    }
    __syncthreads();
}


template <class Epi, class Sched>
__device__ __forceinline__ void run_gemm(LAS unsigned char* lds, const bf16_t* A, int lda, const bf16_t* Bt, int ldb, int M, int N, int K, const Sched& S, const Epi& E) {
    asm volatile("" : "+s"(K));
    Gemm g; g.A = A; g.Bt = Bt; g.M = M; g.N = N; g.K = K; g.lda = lda; g.ldb = ldb;
    pg8::gemm_phase<Epi, Sched, false>(lds, g, S, E, nullptr);
}

#ifndef EN_MASK
#define EN_MASK 0xFFFFFFFFu
#endif
#define EN_PH(k) ((EN_MASK >> (k)) & 1u)
constexpr int NPH_PRO = 2, NPH_LAYER = 12, NPH_TOTAL = NPH_PRO + DEPTH * NPH_LAYER;

__global__ void __launch_bounds__(512, 2) mega(Params P) {
    extern __shared__ __attribute__((aligned(16))) unsigned char shm[];
    float* ldsf = (float*)shm;
    LAS unsigned char* ldsl = (LAS unsigned char*)shm;
    unsigned char* ws = P.ws;
    const int G = gridDim.x, c = blockIdx.x;
    XcdBarrier bar;
    if (P.fused) {
        volatile LAS unsigned* st = (volatile LAS unsigned*)(ldsl + LDS_BYTES - 16);
        if (threadIdx.x == 0) { st[0] = 0u; st[1] = 0u; st[2] = 0u; st[3] = 0u; }
        __syncthreads();
        bar = xcd_barrier_post((unsigned*)(ws + WS_CTL), st);
    }
    int ph = 0;
#define PH_BEGIN if (ph >= P.ph_lo && ph < P.ph_hi) {
#define PH_END_  if (P.fused) xcd_barrier(bar); else __syncthreads(); } ++ph;

    PH_BEGIN
#if EN_PH(0)
phase_convert(P, ldsf);
#endif
 PH_END_
    PH_BEGIN
#if EN_PH(1)
{ pg8::StaticOrder S; S.init(NBATCH * NMEM, DEPTH * 512, G, c); EpiBf16Store E; E.O = (bf16_t*)(ws + WS_KVMEM); E.ldc = DEPTH * 512;
        run_gemm(ldsl, (const bf16_t*)(ws + WS_MEMB), DM, (const bf16_t*)(ws + WS_WKV), DM, NBATCH * NMEM, DEPTH * 512, DM, S, E); }
#endif
 PH_END_

    for (int l = 0; l < DEPTH; ++l) {
        PH_BEGIN
#if EN_PH(2)
{ pg8::StaticOrder S; S.init(NTOK, INC, G, c); EpiBf16Store E; E.O = (bf16_t*)(ws + WS_P); E.ldc = INC;
            run_gemm(ldsl, (const bf16_t*)(ws + WS_XB), DM, (const bf16_t*)(ws + WS_WIN) + (size_t)l * INC * DM, DM, NTOK, INC, DM, S, E); }
#endif
 PH_END_
        PH_BEGIN
#if EN_PH(3)
phase_prepass(P, l);
#endif
 PH_END_
        PH_BEGIN
#if EN_PH(4)
{ pg8::StaticOrder S; S.init(NTOK, LORA_N, G, c); EpiLora E; E.O = (bf16_t*)(ws + WS_LORA); E.w0 = P.in[I_W0] + l * 2048; E.a0 = P.in[I_A0] + l * 2048;
            run_gemm(ldsl, (const bf16_t*)(ws + WS_APR), 256, (const bf16_t*)(ws + WS_WLORA) + (size_t)l * LORA_N * 256, 256, NTOK, LORA_N, 256, S, E); }
#endif
 PH_END_
        PH_BEGIN
#if EN_PH(5)
phase_scan(P, l, ldsf); phase_attn_naive(P, l, ldsf);
#endif
 PH_END_
        PH_BEGIN
#if EN_PH(6)
phase_post(P, l);
#endif
 PH_END_
        PH_BEGIN
#if EN_PH(7)
{ pg8::StaticOrder S; S.init(NTOK, DM, G, c);
            const bf16_t* ycat = (const bf16_t*)(ws + WS_YCAT); const bf16_t* wbr = (const bf16_t*)(ws + WS_WBR) + (size_t)l * DM * BRK; const bf16_t* gate = (const bf16_t*)(ws + WS_P) + C_GATE;
            { EpiBranch<0> E; E.gate = gate; E.mf = (float*)(ws + WS_MF); E.mb = (bf16_t*)(ws + WS_MB); run_gemm(ldsl, ycat, BRK, wbr, BRK, NTOK, DM, 1024, S, E); }
            { EpiBranch<1> E; E.gate = gate + 1024; E.mf = (float*)(ws + WS_MF); E.mb = (bf16_t*)(ws + WS_MB); run_gemm(ldsl, ycat + 1024, BRK, wbr + 1024, BRK, NTOK, DM, 1024, S, E); }
            { EpiBranch<1> E; E.gate = gate + 2048; E.mf = (float*)(ws + WS_MF); E.mb = (bf16_t*)(ws + WS_MB); run_gemm(ldsl, ycat + 2048, BRK, wbr + 2048, BRK, NTOK, DM, 1024, S, E); }
            { EpiBranch<2> E; E.gate = gate + 3072; E.mf = (float*)(ws + WS_MF); E.mb = (bf16_t*)(ws + WS_MB); run_gemm(ldsl, ycat + 3072, BRK, wbr + 3072, BRK, NTOK, DM, 256, S, E); } }
#endif
 PH_END_
        PH_BEGIN
#if EN_PH(8)
{ pg8::StaticOrder S; S.init(NTOK, DM, G, c); EpiResid E; E.xf = (const float*)(ws + WS_XF); E.o = (float*)(ws + WS_PRELN);
            run_gemm(ldsl, (const bf16_t*)(ws + WS_MB), DM, (const bf16_t*)(ws + WS_WOUT) + (size_t)l * DM * DM, DM, NTOK, DM, DM, S, E); }
#endif
 PH_END_
        PH_BEGIN
#if EN_PH(9)
phase_ln1(P, l, ldsf);
#endif
 PH_END_
        PH_BEGIN
#if EN_PH(10)
phase_topk(P, (unsigned long long*)shm);
#endif
 PH_END_
        PH_BEGIN
#if EN_PH(11)
{ GroupedOrder S; S.init(8, 16, NEXP, G, c); EpiSwiGLU E; E.H = (bf16_t*)(ws + WS_H);
            run_gemm(ldsl, (const bf16_t*)(ws + WS_XE), DM, (const bf16_t*)(ws + WS_WGU) + (size_t)l * NEXP * 4096 * DM, DM, NEXP * 2048, NEXP * 4096, DM, S, E); }
#endif
 PH_END_
        PH_BEGIN
#if EN_PH(12)
{ GroupedOrder S; S.init(8, 4, NEXP, G, c); EpiDown E; E.Y = (bf16_t*)(ws + WS_YE); E.grow = (const float*)(ws + WS_GROW);
            run_gemm(ldsl, (const bf16_t*)(ws + WS_H), DEXP, (const bf16_t*)(ws + WS_WDN) + (size_t)l * NEXP * DM * DEXP, DEXP, NEXP * 2048, NEXP * DM, DEXP, S, E); }
#endif
 PH_END_
        PH_BEGIN
#if EN_PH(13)
phase_ln2(P, l);
#endif
 PH_END_
    }
#undef PH_BEGIN
#undef PH_END_
}

#ifndef MK_FUSED
#define MK_FUSED 0
#endif

extern "C" void kernel_launch(void* const* d_in, const int* in_sizes, int n_in, void* d_out, int out_size, void* d_ws, size_t ws_size, hipStream_t stream) {
    static int grid = 0;
    if (grid == 0) {
        if (n_in != N_IN || ws_size < WS_END) { fprintf(stderr, "kernel_launch: unexpected n_in %d or ws_size %zu (< %zu)\n", n_in, ws_size, (size_t)WS_END); grid = -1; return; }
        int dev = 0, cus = 0;
        if (hipGetDevice(&dev) != hipSuccess || hipDeviceGetAttribute(&cus, hipDeviceAttributeMultiprocessorCount, dev) != hipSuccess) { grid = -1; return; }
        if (hipFuncSetAttribute((const void*)mega, hipFuncAttributeMaxDynamicSharedMemorySize, LDS_BYTES) != hipSuccess) { fprintf(stderr, "kernel_launch: hipFuncSetAttribute failed\n"); grid = -1; return; }
        grid = cus > 0 ? cus : 256;
    }
    if (grid < 0) return;
    Params P{};
    for (int i = 0; i < N_IN; ++i) P.in[i] = (const float*)d_in[i];
    P.out = (float*)d_out; P.ws = (unsigned char*)d_ws; P.pad0 = 0;
#if MK_FUSED
    (void)hipMemsetAsync((char*)d_ws + WS_CTL, 0, XCD_BAR_WORDS * sizeof(unsigned), stream);
    P.ph_lo = 0; P.ph_hi = NPH_TOTAL; P.fused = 1;
    hipLaunchKernelGGL(mega, dim3(grid), dim3(NTHR), LDS_BYTES, stream, P);
#else
    for (int ph = 0; ph < NPH_TOTAL; ++ph) {
        P.ph_lo = ph; P.ph_hi = ph + 1; P.fused = 0;
        hipLaunchKernelGGL(mega, dim3(grid), dim3(NTHR), LDS_BYTES, stream, P);
    }
#endif
}
```

```cpp
#include <hip/hip_runtime.h>
#include <stdint.h>
#include <stdio.h>

namespace pg8 {
#define PG8_LAS __attribute__((address_space(3)))
typedef unsigned short bf16_t;
typedef short bf16x8 __attribute__((ext_vector_type(8)));
typedef float f32x4 __attribute__((ext_vector_type(4)));
typedef unsigned u32x4 __attribute__((ext_vector_type(4)));
constexpr int BM = 256, BK = 64, HALF = 128, HTB = HALF * BK * 2  , STAGE_BYTES = 8 * HTB, NXCD = 8, WGM = 8;

__host__ __device__ __forceinline__ int lds_byte(int r, int c) { const int st = (r >> 4) * 2 + (c >> 5), rr = r & 15, cc = c & 31, ob = rr * 64 + cc * 2; return st * 1024 + (ob ^ (((ob >> 9) & 1) << 5)); }
__host__ __device__ __forceinline__ void stage_rc(int b, int& R, int& C) { const int st = b / 1024, sb = b % 1024, swz = sb ^ (((sb >> 9) & 1) << 5); R = (st >> 1) * 16 + swz / 64; C = (st & 1) * 32 + (swz % 64) / 2; }
__host__ __device__ __forceinline__ int perm32(int rho) { const int n = rho >> 4, i = rho & 15; return 8 * (i >> 2) + 4 * n + (i & 3); }

struct Unit { int pm, pn; };
struct Gemm { const bf16_t* A; const bf16_t* Bt; int M, N, K, lda, ldb, wv, sa, sb, pshift, pmask, koff, alt_from, nt_alt; };
struct StaticOrder {
    int nM, nN, nwg, G, c;
    __host__ __device__ void init(int M, int N, int G_, int c_) { nM = M / BM; nN = N / BM; nwg = nM * nN; G = G_; c = c_; }
    __host__ __device__ bool next(int i, Unit& u) const {
        const long L = (long)i * G + c; if (L >= nwg) return false;
        int wgid = (int)L; { const int q = nwg / NXCD, r = nwg % NXCD, xcd = wgid % NXCD, off = wgid / NXCD; wgid = (xcd < r ? xcd * (q + 1) : r * (q + 1) + (xcd - r) * q) + off; }
        const int nig = WGM * nN, gid = wgid / nig, fm = gid * WGM, gsz = (nM - fm) < WGM ? (nM - fm) : WGM;
        u.pm = fm + ((wgid % nig) % gsz); u.pn = (wgid % nig) / gsz; return true;
    }
    __device__ __forceinline__ void a_ready(const Unit&) const {}
    __device__ __forceinline__ void done(const Unit&) const {}
};
__device__ __forceinline__ unsigned cvt_pk_bf16(float lo, float hi) { unsigned r; asm volatile("v_cvt_pk_bf16_f32 %0, %1, %2" : "=v"(r) : "v"(lo), "v"(hi)); return r; }
template <class Epi, class Sched, bool STAMP = false>
__device__ __forceinline__ void gemm_phase(PG8_LAS unsigned char* lds, const Gemm g, const Sched& S, const Epi& E, unsigned long long* stamps) {
    unsigned z_ = 0u; asm volatile("" : "+v"(z_)); int tid_ = g.wv * 64 + (int)__builtin_amdgcn_mbcnt_hi(~0u, __builtin_amdgcn_mbcnt_lo(~0u, z_)); asm volatile("" : "+v"(tid_));
    const int tid = tid_, wid = __builtin_amdgcn_readfirstlane(tid >> 6), lane = tid & 63, wr = wid >> 2, wc = wid & 3, fr = lane & 15, fq = lane >> 4;
    const int K = g.K, nt = K / BK;
    int ts_lo = 0, ts_hi = 0, nts = 0; const unsigned long long rt_entry = STAMP ? (unsigned long long)wall_clock64() : 0ull;
#define PG8_STAMP() do { if (STAMP && wid == 0 && nts < 64) { const unsigned long long _c = (unsigned long long)clock64(); \
        ts_lo = (lane == nts) ? (int)(unsigned)_c : ts_lo; ts_hi = (lane == nts) ? (int)(unsigned)(_c >> 32) : ts_hi; ++nts; } } while (0)
    PG8_STAMP();
    unsigned voffA[2], voffB[2];
#pragma unroll
    for (int i = 0; i < 2; ++i) { int R, C; stage_rc(tid * 16 + i * 8192, R, C); const int Rb = Epi::PERM ? ((R & ~31) + perm32(R & 31)) : R;
        voffA[i] = (unsigned)(R * g.lda + C) * 2u; voffB[i] = (unsigned)(Rb * g.ldb + C) * 2u; }
    const size_t kstep = (size_t)(BK * 2);
    const size_t hstepA = (size_t)HALF * g.lda * 2, hstepB = (size_t)HALF * g.ldb * 2;
    const size_t tstepA = 2 * hstepA, tstepB = 2 * hstepB;
    const unsigned ldsw = (unsigned)wid * 1024u;
    const int aoff = lds_byte(wr * 64 + fr, fq * 8), boff = lds_byte(wc * 32 + fr, fq * 8);
#define PG8_SA(b, h) (((b) * 2 + (h)) * HTB)
#define PG8_SB(b, h) ((4 + (b) * 2 + (h)) * HTB)
#define PG8_STAGE(bufoff, gbase, voff) do { _Pragma("unroll") for (int _i = 0; _i < 2; ++_i) \
        __builtin_amdgcn_global_load_lds((const unsigned*)((const char*)(gbase) + (voff)[_i]), (PG8_LAS unsigned*)(lds + (bufoff) + ldsw + _i * 8192), 16, 0, 0); } while (0)
#define PG8_LDA(dst, b, h) do { _Pragma("unroll") for (int m = 0; m < 4; ++m) _Pragma("unroll") for (int k = 0; k < 2; ++k) dst[m][k] = *(const PG8_LAS bf16x8*)(lds + PG8_SA(b, h) + aoff + m * 2048 + k * 1024); } while (0)
#define PG8_LDB(dst, b, h) do { _Pragma("unroll") for (int n = 0; n < 2; ++n) _Pragma("unroll") for (int k = 0; k < 2; ++k) dst[n][k] = *(const PG8_LAS bf16x8*)(lds + PG8_SB(b, h) + boff + n * 2048 + k * 1024); } while (0)
#define PG8_MMA(ai, bj, At, Bt) do { __builtin_amdgcn_s_setprio(1); _Pragma("unroll") for (int m = 0; m < 4; ++m) _Pragma("unroll") for (int n = 0; n < 2; ++n) _Pragma("unroll") for (int k = 0; k < 2; ++k) \
        acc[ai][bj][m][n] = __builtin_amdgcn_mfma_f32_16x16x32_bf16(Bt[n][k], At[m][k], acc[ai][bj][m][n], 0, 0, 0); __builtin_amdgcn_s_setprio(0); } while (0)
#define PG8_WAIT_V(n) asm volatile("s_waitcnt vmcnt(" #n ")" ::: "memory")
#define PG8_WAIT_L(n) asm volatile("s_waitcnt lgkmcnt(" #n ")" ::: "memory")
#define PG8_BAR __builtin_amdgcn_s_barrier()
#define PG8_SCHED __builtin_amdgcn_sched_barrier(0)
    Unit cur, nxt; int ui = 0;
    if (!S.next(0, cur)) return;
    f32x4 acc[2][2][4][2];
#pragma unroll
    for (int a = 0; a < 2; ++a)
#pragma unroll
        for (int b = 0; b < 2; ++b)
#pragma unroll
            for (int m = 0; m < 4; ++m)
#pragma unroll
                for (int n = 0; n < 2; ++n) acc[a][b][m][n] = (f32x4){0.f, 0.f, 0.f, 0.f};
    bf16x8 At[4][2], B0[2][2], B1[2][2];
    const char* cA = (const char*)g.A + (size_t)cur.pm * tstepA + (size_t)(cur.pn >> g.pshift) * g.koff; const char* cB = (const char*)g.Bt + (size_t)(cur.pn & g.pmask) * tstepB + (size_t)(cur.pn >> g.pshift) * g.koff;
    S.a_ready(cur);
    PG8_STAGE(PG8_SB(0, 0), cB, voffB); PG8_STAGE(PG8_SA(0, 0), cA, voffA); PG8_STAGE(PG8_SB(0, 1), cB + hstepB, voffB); PG8_STAGE(PG8_SA(0, 1), cA + hstepA, voffA);
    if (wr == 1) PG8_BAR;
    PG8_WAIT_V(4); PG8_BAR;
    PG8_STAGE(PG8_SB(1, 0), cB + kstep, voffB); PG8_STAGE(PG8_SA(1, 0), cA + kstep, voffA); PG8_STAGE(PG8_SB(1, 1), cB + hstepB + kstep, voffB);
    PG8_WAIT_V(6); PG8_BAR;
    PG8_STAMP();
    for (;;) {
        const bool has_next = S.next(ui + 1, nxt);
        const char* nA = has_next ? (const char*)g.A + (size_t)nxt.pm * tstepA + (size_t)(nxt.pn >> g.pshift) * g.koff : cA; const char* nB = has_next ? (const char*)g.Bt + (size_t)(nxt.pn & g.pmask) * tstepB + (size_t)(nxt.pn >> g.pshift) * g.koff : cB;
        const int ntu = ((cur.pn >> g.pshift) >= g.alt_from) ? g.nt_alt : nt;
        for (int t = 0; t < ntu; t += 2) {
            const bool last = (t == ntu - 2);
            const char* a1 = cA + (size_t)(t + 1) * kstep;
            const char* a2 = last ? nA : cA + (size_t)(t + 2) * kstep; const char* b2 = last ? nB : cB + (size_t)(t + 2) * kstep;
            const char* a3 = a2 + kstep; const char* b3 = b2 + kstep;
            if (last && has_next) S.a_ready(nxt);
            PG8_LDB(B0, 0, 0); PG8_SCHED; PG8_LDA(At, 0, 0); PG8_STAGE(PG8_SA(1, 1), a1 + hstepA, voffA);
            PG8_WAIT_L(8); PG8_BAR; PG8_WAIT_L(0); PG8_MMA(0, 0, At, B0); PG8_BAR; PG8_SCHED;
            PG8_LDB(B1, 0, 1); PG8_STAGE(PG8_SB(0, 0), b2, voffB);
            PG8_BAR; PG8_WAIT_L(0); PG8_MMA(0, 1, At, B1); PG8_BAR;
            PG8_LDA(At, 0, 1); PG8_STAGE(PG8_SA(0, 0), a2, voffA);
            PG8_BAR; PG8_WAIT_L(0); PG8_MMA(1, 0, At, B0); PG8_BAR; PG8_SCHED;
            PG8_STAGE(PG8_SB(0, 1), b2 + hstepB, voffB);
            PG8_WAIT_V(6); PG8_BAR; PG8_MMA(1, 1, At, B1); PG8_BAR;
            PG8_LDB(B0, 1, 0); PG8_SCHED; PG8_LDA(At, 1, 0); PG8_STAGE(PG8_SA(0, 1), a2 + hstepA, voffA);
            PG8_WAIT_L(8); PG8_BAR; PG8_WAIT_L(0); PG8_MMA(0, 0, At, B0); PG8_BAR; PG8_SCHED;
            PG8_LDB(B1, 1, 1); PG8_STAGE(PG8_SB(1, 0), b3, voffB);
            PG8_BAR; PG8_WAIT_L(0); PG8_MMA(0, 1, At, B1); PG8_BAR;
            PG8_LDA(At, 1, 1); PG8_STAGE(PG8_SA(1, 0), a3, voffA);
            PG8_BAR; PG8_WAIT_L(0); PG8_MMA(1, 0, At, B0); PG8_BAR; PG8_SCHED;
            PG8_STAGE(PG8_SB(1, 1), b3 + hstepB, voffB);
            PG8_WAIT_V(6); PG8_BAR; PG8_MMA(1, 1, At, B1); PG8_BAR;
        }
        PG8_STAMP();
        if constexpr (!Epi::AFTER_DRAIN) { E(acc, cur, wr, wc, fr, fq); S.done(cur); }
        PG8_STAMP();
        if (!has_next) break;
#pragma unroll
        for (int a = 0; a < 2; ++a)
#pragma unroll
            for (int b = 0; b < 2; ++b)
#pragma unroll
                for (int m = 0; m < 4; ++m)
#pragma unroll
                    for (int n = 0; n < 2; ++n) acc[a][b][m][n] = (f32x4){0.f, 0.f, 0.f, 0.f};
        cur = nxt; cA = nA; cB = nB; ++ui;
    }
    PG8_WAIT_V(0);
    if (wr == 0) PG8_BAR;
    PG8_BAR;
    if constexpr (Epi::AFTER_DRAIN) { E.fused(acc, cur, wr, wc, fr, fq, lds, wid, lane); S.done(cur); }
    PG8_STAMP();
    if (STAMP && wid == 0) { stamps[lane] = lane < nts ? (((unsigned long long)(unsigned)ts_hi << 32) | (unsigned)ts_lo) : 0ull;
        if (lane == 62) stamps[62] = rt_entry; if (lane == 63) stamps[63] = (unsigned long long)wall_clock64(); }
#undef PG8_STAMP
#undef PG8_SA
#undef PG8_SB
#undef PG8_STAGE
#undef PG8_LDA
#undef PG8_LDB
#undef PG8_MMA
#undef PG8_WAIT_V
#undef PG8_WAIT_L
#undef PG8_BAR
#undef PG8_SCHED
}

typedef short bf16x16 __attribute__((ext_vector_type(16)));
typedef int v8i __attribute__((ext_vector_type(8)));
template <class Epi, class Sched, bool STAMP = false>
__device__ __forceinline__ void gemm_phase_f8(PG8_LAS unsigned char* lds, const Gemm g, const Sched& S, const Epi& E, unsigned long long* stamps) {
    unsigned z_ = 0u; asm volatile("" : "+v"(z_)); int tid_ = g.wv * 64 + (int)__builtin_amdgcn_mbcnt_hi(~0u, __builtin_amdgcn_mbcnt_lo(~0u, z_)); asm volatile("" : "+v"(tid_));
    const int tid = tid_, wid = __builtin_amdgcn_readfirstlane(tid >> 6), lane = tid & 63, wr = wid >> 2, wc = wid & 3, fr = lane & 15, fq = lane >> 4;
    const int K = g.K, nt = K / 128;
    int ts_lo = 0, ts_hi = 0, nts = 0; const unsigned long long rt_entry = STAMP ? (unsigned long long)wall_clock64() : 0ull;
#define PG8_STAMP() do { if (STAMP && wid == 0 && nts < 64) { const unsigned long long _c = (unsigned long long)clock64(); \
        ts_lo = (lane == nts) ? (int)(unsigned)_c : ts_lo; ts_hi = (lane == nts) ? (int)(unsigned)(_c >> 32) : ts_hi; ++nts; } } while (0)
    PG8_STAMP();
    unsigned voffA[2], voffB[2];
#pragma unroll
    for (int i = 0; i < 2; ++i) { int R, C; stage_rc(tid * 16 + i * 8192, R, C); const int Rb = Epi::PERM ? ((R & ~31) + perm32(R & 31)) : R;
        voffA[i] = (unsigned)(R * g.lda) + (unsigned)C * 2u; voffB[i] = (unsigned)(Rb * g.ldb) + (unsigned)C * 2u; }
    const size_t kstep = (size_t)(BK * 2);
    const size_t hstepA = (size_t)HALF * g.lda, hstepB = (size_t)HALF * g.ldb;
    const size_t tstepA = 2 * hstepA, tstepB = 2 * hstepB;
    const unsigned ldsw = (unsigned)wid * 1024u;
    const int aoff = lds_byte(wr * 64 + fr, fq * 8), boff = lds_byte(wc * 32 + fr, fq * 8);
#define PG8_SA(b, h) (((b) * 2 + (h)) * HTB)
#define PG8_SB(b, h) ((4 + (b) * 2 + (h)) * HTB)
#define PG8_STAGE(bufoff, gbase, voff) do { _Pragma("unroll") for (int _i = 0; _i < 2; ++_i) \
        __builtin_amdgcn_global_load_lds((const unsigned*)((const char*)(gbase) + (voff)[_i]), (PG8_LAS unsigned*)(lds + (bufoff) + ldsw + _i * 8192), 16, 0, 0); } while (0)
#define PG8_LDA(dst, b, h) do { _Pragma("unroll") for (int m = 0; m < 4; ++m) { const bf16x8 lo_ = *(const PG8_LAS bf16x8*)(lds + PG8_SA(b, h) + aoff + m * 2048), hi_ = *(const PG8_LAS bf16x8*)(lds + PG8_SA(b, h) + aoff + m * 2048 + 1024); \
        dst[m] = __builtin_shufflevector(lo_, hi_, 0, 1, 2, 3, 4, 5, 6, 7, 8, 9, 10, 11, 12, 13, 14, 15); } } while (0)
#define PG8_LDB(dst, b, h) do { _Pragma("unroll") for (int n = 0; n < 2; ++n) { const bf16x8 lo_ = *(const PG8_LAS bf16x8*)(lds + PG8_SB(b, h) + boff + n * 2048), hi_ = *(const PG8_LAS bf16x8*)(lds + PG8_SB(b, h) + boff + n * 2048 + 1024); \
        dst[n] = __builtin_shufflevector(lo_, hi_, 0, 1, 2, 3, 4, 5, 6, 7, 8, 9, 10, 11, 12, 13, 14, 15); } } while (0)
#define PG8_MMA(ai, bj, At, Bt) do { __builtin_amdgcn_s_setprio(1); _Pragma("unroll") for (int m = 0; m < 4; ++m) _Pragma("unroll") for (int n = 0; n < 2; ++n) \
        asm volatile("v_mfma_scale_f32_16x16x128_f8f6f4 %0, %1, %2, %0, %3, %4 op_sel_hi:[0,0,0]" : "+v"(acc[ai][bj][m][n]) : "v"(__builtin_bit_cast(v8i, Bt[n])), "v"(__builtin_bit_cast(v8i, At[m])), "v"(sbv), "v"(sav)); \
        __builtin_amdgcn_s_setprio(0); } while (0)
#define PG8_WAIT_V(n) asm volatile("s_waitcnt vmcnt(" #n ")" ::: "memory")
#define PG8_WAIT_L(n) asm volatile("s_waitcnt lgkmcnt(" #n ")" ::: "memory")
#define PG8_BAR __builtin_amdgcn_s_barrier()
#define PG8_SCHED __builtin_amdgcn_sched_barrier(0)
    Unit cur, nxt; int ui = 0;
    if (!S.next(0, cur)) return;
    f32x4 acc[2][2][4][2];
#pragma unroll
    for (int a = 0; a < 2; ++a)
#pragma unroll
        for (int b = 0; b < 2; ++b)
#pragma unroll
            for (int m = 0; m < 4; ++m)
#pragma unroll
                for (int n = 0; n < 2; ++n) acc[a][b][m][n] = (f32x4){0.f, 0.f, 0.f, 0.f};
    bf16x16 At[4], B0[2], B1[2];
    int sav = g.sa, sbv = g.sb;
    const char* cA = (const char*)g.A + (size_t)cur.pm * tstepA + (size_t)(cur.pn >> g.pshift) * g.koff; const char* cB = (const char*)g.Bt + (size_t)(cur.pn & g.pmask) * tstepB + (size_t)(cur.pn >> g.pshift) * g.koff;
    S.a_ready(cur);
    PG8_STAGE(PG8_SB(0, 0), cB, voffB); PG8_STAGE(PG8_SA(0, 0), cA, voffA); PG8_STAGE(PG8_SB(0, 1), cB + hstepB, voffB); PG8_STAGE(PG8_SA(0, 1), cA + hstepA, voffA);
    if (wr == 1) PG8_BAR;
    PG8_WAIT_V(4); PG8_BAR;
    PG8_STAGE(PG8_SB(1, 0), cB + kstep, voffB); PG8_STAGE(PG8_SA(1, 0), cA + kstep, voffA); PG8_STAGE(PG8_SB(1, 1), cB + hstepB + kstep, voffB);
    PG8_WAIT_V(6); PG8_BAR;
    PG8_STAMP();
    for (;;) {
        const bool has_next = S.next(ui + 1, nxt);
        const char* nA = has_next ? (const char*)g.A + (size_t)nxt.pm * tstepA + (size_t)(nxt.pn >> g.pshift) * g.koff : cA; const char* nB = has_next ? (const char*)g.Bt + (size_t)(nxt.pn & g.pmask) * tstepB + (size_t)(nxt.pn >> g.pshift) * g.koff : cB;
        for (int t = 0; t < nt; t += 2) {
            const bool last = (t == nt - 2);
            const char* a1 = cA + (size_t)(t + 1) * kstep;
            const char* a2 = last ? nA : cA + (size_t)(t + 2) * kstep; const char* b2 = last ? nB : cB + (size_t)(t + 2) * kstep;
            const char* a3 = a2 + kstep; const char* b3 = b2 + kstep;
            if (last && has_next) S.a_ready(nxt);
            PG8_LDB(B0, 0, 0); PG8_SCHED; PG8_LDA(At, 0, 0); PG8_STAGE(PG8_SA(1, 1), a1 + hstepA, voffA);
            PG8_WAIT_L(8); PG8_BAR; PG8_WAIT_L(0); PG8_MMA(0, 0, At, B0); PG8_BAR; PG8_SCHED;
            PG8_LDB(B1, 0, 1); PG8_STAGE(PG8_SB(0, 0), b2, voffB);
            PG8_BAR; PG8_WAIT_L(0); PG8_MMA(0, 1, At, B1); PG8_BAR;
            PG8_LDA(At, 0, 1); PG8_STAGE(PG8_SA(0, 0), a2, voffA);
            PG8_BAR; PG8_WAIT_L(0); PG8_MMA(1, 0, At, B0); PG8_BAR; PG8_SCHED;
            PG8_STAGE(PG8_SB(0, 1), b2 + hstepB, voffB);
            PG8_WAIT_V(6); PG8_BAR; PG8_MMA(1, 1, At, B1); PG8_BAR;
            PG8_LDB(B0, 1, 0); PG8_SCHED; PG8_LDA(At, 1, 0); PG8_STAGE(PG8_SA(0, 1), a2 + hstepA, voffA);
            PG8_WAIT_L(8); PG8_BAR; PG8_WAIT_L(0); PG8_MMA(0, 0, At, B0); PG8_BAR; PG8_SCHED;
            PG8_LDB(B1, 1, 1); PG8_STAGE(PG8_SB(1, 0), b3, voffB);
            PG8_BAR; PG8_WAIT_L(0); PG8_MMA(0, 1, At, B1); PG8_BAR;
            PG8_LDA(At, 1, 1); PG8_STAGE(PG8_SA(1, 0), a3, voffA);
            PG8_BAR; PG8_WAIT_L(0); PG8_MMA(1, 0, At, B0); PG8_BAR; PG8_SCHED;
            PG8_STAGE(PG8_SB(1, 1), b3 + hstepB, voffB);
            PG8_WAIT_V(6); PG8_BAR; PG8_MMA(1, 1, At, B1); PG8_BAR;
        }
        asm volatile("s_nop 15\n\ts_nop 7" ::: "memory");
        PG8_STAMP();
        if constexpr (!Epi::AFTER_DRAIN) { E(acc, cur, wr, wc, fr, fq); S.done(cur); }
        PG8_STAMP();
        if (!has_next) break;
#pragma unroll
        for (int a = 0; a < 2; ++a)
#pragma unroll
            for (int b = 0; b < 2; ++b)
#pragma unroll
                for (int m = 0; m < 4; ++m)
#pragma unroll
                    for (int n = 0; n < 2; ++n) acc[a][b][m][n] = (f32x4){0.f, 0.f, 0.f, 0.f};
        cur = nxt; cA = nA; cB = nB; ++ui;
    }
    PG8_WAIT_V(0);
    if (wr == 0) PG8_BAR;
    PG8_BAR;
    if constexpr (Epi::AFTER_DRAIN) { E.fused(acc, cur, wr, wc, fr, fq, lds, wid, lane); S.done(cur); }
    PG8_STAMP();
    if (STAMP && wid == 0) { stamps[lane] = lane < nts ? (((unsigned long long)(unsigned)ts_hi << 32) | (unsigned)ts_lo) : 0ull;
        if (lane == 62) stamps[62] = rt_entry; if (lane == 63) stamps[63] = (unsigned long long)wall_clock64(); }
#undef PG8_STAMP
#undef PG8_SA
#undef PG8_SB
#undef PG8_STAGE
#undef PG8_LDA
#undef PG8_LDB
#undef PG8_MMA
#undef PG8_WAIT_V
#undef PG8_WAIT_L
#undef PG8_BAR
#undef PG8_SCHED
}
}

using pg8::bf16_t; using pg8::f32x4; using pg8::u32x4; using pg8::Unit; using pg8::Gemm; using pg8::cvt_pk_bf16;
typedef float f32x2 __attribute__((ext_vector_type(2)));
typedef unsigned u32x2 __attribute__((ext_vector_type(2)));
#define LAS __attribute__((address_space(3)))

constexpr int DM = 1024, NBATCH = 8, SEQ = 2048, NTOK = NBATCH * SEQ, DEPTH = 4, NMEM = 256, INC = 12288;
constexpr int C_R = 0, C_K = 1024, C_V = 2048, C_DW = 3072, C_WQ = 3328, C_WK = 4352, C_WV = 4608, C_DQ = 4864, C_DK = 5888, C_DV = 6912, C_MQ = 7936, C_GATE = 8192;
constexpr int RWC = 3328, LORA_N = 5120, BRK = 3328;
constexpr float DN_ALPHA = 1.6817928305074290f;
constexpr int NEXP = 16, CAP = 256, DEXP = 2048;

enum { I_X = 0, I_MEM, I_RELB, I_WIN, I_MU, I_W0, I_WUP, I_A0, I_AUP, I_GUP, I_KK, I_KA, I_RK, I_GNG, I_GNB, I_SINK, I_LAM, I_SUBLN, I_WKV, I_WBR, I_WOUT,
       I_LN1G, I_LN1B, I_ROUTER, I_EWG, I_EWU, I_EWD, I_LN2G, I_LN2B, N_IN };

constexpr size_t MiB = 1ull << 20;
constexpr size_t WS_CTL = 0;
constexpr size_t WS_WIN = 1 * MiB;
constexpr size_t WS_WBR = WS_WIN + 96 * MiB;
constexpr size_t WS_WOUT = WS_WBR + 26 * MiB;
constexpr size_t WS_WKV = WS_WOUT + 8 * MiB;
constexpr size_t WS_WGU = WS_WKV + 4 * MiB;
constexpr size_t WS_WDN = WS_WGU + 512 * MiB;
constexpr size_t WS_MBP = WS_WGU + 256 * MiB;
constexpr size_t WS_GATEP = WS_WDN + 128 * MiB;
constexpr size_t WS_WLORA = WS_WDN + 256 * MiB;
constexpr size_t WS_XF = WS_WLORA + 10 * MiB;
constexpr size_t WS_XB = WS_XF + 64 * MiB;
constexpr size_t WS_MEMB = WS_XB + 32 * MiB;
constexpr size_t WS_KVMEM = WS_MEMB + 4 * MiB;
constexpr size_t WS_P = WS_KVMEM + 8 * MiB;
constexpr size_t WS_XE = WS_P, WS_H = WS_P + 64 * MiB, WS_YE = WS_P + 192 * MiB;
constexpr size_t WS_APR = WS_P + 384 * MiB;
constexpr size_t WS_LORA = WS_APR + 8 * MiB;
constexpr size_t WS_YDIR = WS_LORA + 160 * MiB;
constexpr size_t WS_BONUS = WS_YDIR + 128 * MiB;
constexpr size_t WS_YCAT = WS_BONUS + 2 * MiB;
constexpr size_t WS_MF = WS_YCAT + 104 * MiB;
constexpr size_t WS_PRELN = WS_MF + 64 * MiB;
constexpr size_t WS_DTMP = WS_MF;
constexpr size_t WS_MB = WS_PRELN + 64 * MiB;
constexpr size_t WS_AFF = WS_MB + 32 * MiB;
constexpr size_t WS_GROW = WS_AFF + 1 * MiB;
constexpr size_t WS_SLOT = WS_GROW + 1 * MiB;
constexpr size_t WS_END = WS_SLOT + 1 * MiB;

struct Params {
    const float* in[N_IN];
    float* out;
    unsigned char* ws;
    int ph_lo, ph_hi;
    int fused, pad0;
};

#define CAS __attribute__((address_space(4)))
__device__ __forceinline__ const CAS unsigned char* karg_base() { const CAS unsigned char* q = (const CAS unsigned char*)__builtin_amdgcn_kernarg_segment_ptr(); asm volatile("" : "+s"(q)); return q; }
__device__ __forceinline__ const float* kin(int i) { return ((const float* const CAS*)karg_base())[i]; }
__device__ __forceinline__ float* kout() { return *(float* const CAS*)(karg_base() + N_IN * 8); }
__device__ __forceinline__ unsigned char* kws() { return *(unsigned char* const CAS*)(karg_base() + N_IN * 8 + 8); }
constexpr int LDS_BYTES = 145 * 1024;
constexpr int NTHR = 512;

__device__ __forceinline__ float bf2f(unsigned v) { return __uint_as_float(v << 16); }
__device__ __forceinline__ float bflo(unsigned v) { return __uint_as_float(v << 16); }
__device__ __forceinline__ float bfhi(unsigned v) { return __uint_as_float(v & 0xffff0000u); }
__device__ __forceinline__ unsigned short f2bf(float f) { unsigned u = __float_as_uint(f); u += 0x7FFFu + ((u >> 16) & 1u); return (unsigned short)(u >> 16); }
__device__ __forceinline__ int lane_id() { unsigned z = 0u; asm volatile("" : "+v"(z)); return (int)__builtin_amdgcn_mbcnt_hi(~0u, __builtin_amdgcn_mbcnt_lo(~0u, z)); }
__device__ __forceinline__ int otid(int wv) { int t = wv * 64 + lane_id(); asm volatile("" : "+v"(t)); return t; }
__device__ __forceinline__ float shfl_xor_o(float v, int mask) { const int lid = lane_id(); return __builtin_bit_cast(float, __builtin_amdgcn_ds_bpermute((lid ^ mask) << 2, __builtin_bit_cast(int, v))); }
__device__ __forceinline__ float wave_sum(float v) {
    const int lid = lane_id();
#pragma unroll
    for (int o = 1; o < 64; o <<= 1) v += __builtin_bit_cast(float, __builtin_amdgcn_ds_bpermute((lid ^ o) << 2, __builtin_bit_cast(int, v)));
    return v;
}
__device__ __forceinline__ float dpp_xor1(float v) { return __builtin_bit_cast(float, __builtin_amdgcn_update_dpp(0, __builtin_bit_cast(int, v), 0xB1, 0xF, 0xF, true)); }
__device__ __forceinline__ float dpp_xor2(float v) { return __builtin_bit_cast(float, __builtin_amdgcn_update_dpp(0, __builtin_bit_cast(int, v), 0x4E, 0xF, 0xF, true)); }
__device__ __forceinline__ float dpp_hmir(float v) { return __builtin_bit_cast(float, __builtin_amdgcn_update_dpp(0, __builtin_bit_cast(int, v), 0x141, 0xF, 0xF, true)); }
__device__ __forceinline__ float sum8(float v) { v += dpp_xor1(v); v += dpp_xor2(v); v += dpp_hmir(v); return v; }
__device__ __forceinline__ float dpp_mir(float v) { return __builtin_bit_cast(float, __builtin_amdgcn_update_dpp(0, __builtin_bit_cast(int, v), 0x140, 0xF, 0xF, true)); }
__device__ __forceinline__ float sum16(float v) { v = sum8(v); v += dpp_mir(v); return v; }
__device__ __forceinline__ float sigmoidf_(float x) { return __builtin_amdgcn_rcpf(1.0f + __expf(-x)); }
__device__ __forceinline__ int t5_bucket(int rel) {
    const int n = rel < 0 ? -rel : rel;
    int large = 2 + (31 - __clz(n * n));
    large = large > 15 ? 15 : large;
    return (rel > 0 ? 16 : 0) + (n < 8 ? n : large);
}

struct GroupedOrder {
    int nMe, nNe, upe, total, G, c;
    __device__ void init(int nMe_, int nNe_, int E, int G_, int c_) { nMe = nMe_; nNe = nNe_; upe = nMe_ * nNe_; total = upe * E; G = G_; c = c_; }
    __device__ bool next(int i, Unit& u) const {
        const int L = i * G + c; if (L >= total) return false;
        const int e = L / upe, rem = L % upe, x = rem & 7, j = rem >> 3;
        const int am = nMe >> 1, pm_e = (x & 1) * am + (j % am), pn_e = (x >> 1) * (nNe >> 2) + (j / am);
        u.pm = e * nMe + pm_e; u.pn = e * nNe + pn_e; return true;
    }
    __device__ __forceinline__ void a_ready(const Unit&) const {}
    __device__ __forceinline__ void done(const Unit&) const {}
};

__device__ __forceinline__ void st_block_bf16(LAS unsigned char* sw, int woff, int roff, const u32x4& X, const u32x4& Y, bf16_t* rowp, size_t ldc) {
    *(LAS u32x4*)(sw + woff) = X; *(LAS u32x4*)(sw + (woff ^ 64)) = Y;
    const u32x4 r0 = *(const LAS u32x4*)(sw + roff), r1 = *(const LAS u32x4*)(sw + roff + 1024);
    *(u32x4*)rowp = r0; *(u32x4*)(rowp + 8 * ldc) = r1;
}
#define ST_BLOCK_SETUP(st_) LAS unsigned char* sw = (st_) + (wr * 4 + wc) * 2048; const int woff = fr * 128 + ((fq ^ (fr & 7)) << 4), lane_ = fq * 16 + fr, rrow = lane_ >> 3, rp = lane_ & 7, roff = rrow * 128 + ((rp ^ (rrow & 7)) << 4)
struct EpiBf16Store {
    static constexpr bool PERM = true, AFTER_DRAIN = false;
    bf16_t* O; int ldc; LAS unsigned char* st;
    bf16_t* GP;
    __device__ __forceinline__ void operator()(const f32x4 (&acc)[2][2][4][2], const Unit& u, int wr, int wc, int fr, int fq) const {
        typedef float fv8_ __attribute__((ext_vector_type(8))); typedef __bf16 bfv8_ __attribute__((ext_vector_type(8)));
        if (GP != nullptr && u.pn >= 32) {
            u32x4* gp = (u32x4*)GP + ((size_t)((u.pm * 16 + (u.pn - 32)) * 8 + wr * 4 + wc) * 16) * 64 + fq * 16 + fr;
#pragma unroll
            for (int ai = 0; ai < 2; ++ai)
#pragma unroll
                for (int m = 0; m < 4; ++m)
#pragma unroll
                    for (int bj = 0; bj < 2; ++bj) { const f32x4 v0 = acc[ai][bj][m][0], v1 = acc[ai][bj][m][1];
                        const fv8_ x8 = {v0[0], v0[1], v0[2], v0[3], v1[0], v1[1], v1[2], v1[3]};
                        gp[((ai * 4 + m) * 2 + bj) * 64] = __builtin_bit_cast(u32x4, __builtin_convertvector(x8, bfv8_)); }
            return;
        }
        ST_BLOCK_SETUP(st);
        bf16_t* op = O + (size_t)(u.pm * 256 + wr * 64 + rrow) * ldc + u.pn * 256 + wc * 64 + rp * 8;
        u32x4 rr[2][4][2];
#pragma unroll
        for (int ai = 0; ai < 2; ++ai)
#pragma unroll
            for (int m = 0; m < 4; ++m) { u32x4 wq[2];
#pragma unroll
                for (int bj = 0; bj < 2; ++bj) { const f32x4 v0 = acc[ai][bj][m][0], v1 = acc[ai][bj][m][1];
                    const fv8_ x8 = {v0[0], v0[1], v0[2], v0[3], v1[0], v1[1], v1[2], v1[3]};
                    wq[bj] = __builtin_bit_cast(u32x4, __builtin_convertvector(x8, bfv8_)); }
                *(LAS u32x4*)(sw + woff) = wq[0]; *(LAS u32x4*)(sw + (woff ^ 64)) = wq[1];
                rr[ai][m][0] = *(const LAS u32x4*)(sw + roff); rr[ai][m][1] = *(const LAS u32x4*)(sw + roff + 1024); }
#pragma unroll
        for (int ai = 0; ai < 2; ++ai)
#pragma unroll
            for (int m = 0; m < 4; ++m) { bf16_t* rowp = op + (size_t)(ai * 128 + m * 16) * ldc; *(u32x4*)rowp = rr[ai][m][0]; *(u32x4*)(rowp + (size_t)8 * ldc) = rr[ai][m][1]; }
    }
};
struct EpiLora {
    static constexpr bool PERM = true, AFTER_DRAIN = false;
    bf16_t* O; const float* w0; const float* a0;
    __device__ __forceinline__ void operator()(const f32x4 (&acc)[2][2][4][2], const Unit& u, int wr, int wc, int fr, int fq) const {
        const int row0 = u.pm * 256 + wr * 64 + fr, col0 = u.pn * 256 + wc * 64 + 8 * fq;
        const int region = u.pn >> 3;
        f32x4 bv[2][2];
#pragma unroll
        for (int bj = 0; bj < 2; ++bj)
#pragma unroll
            for (int n = 0; n < 2; ++n) { const int c = col0 + bj * 32 + 4 * n;
                bv[bj][n] = region == 0 ? *(const f32x4*)(w0 + c) : (region == 1 ? *(const f32x4*)(a0 + (c - 2048)) : (f32x4){0.f, 0.f, 0.f, 0.f}); }
#pragma unroll
        for (int ai = 0; ai < 2; ++ai)
#pragma unroll
            for (int m = 0; m < 4; ++m) { bf16_t* rowp = O + (size_t)(row0 + ai * 128 + m * 16) * LORA_N + col0;
#pragma unroll
                for (int bj = 0; bj < 2; ++bj) { f32x4 v0 = acc[ai][bj][m][0] + bv[bj][0], v1 = acc[ai][bj][m][1] + bv[bj][1];
                    if (region < 2) {
                        const float sc = region == 0 ? -0.6065306597126334f : 1.0f;
#pragma unroll
                        for (int j = 0; j < 4; ++j) { v0[j] = sc * sigmoidf_(v0[j]); v1[j] = sc * sigmoidf_(v1[j]); }
                    }
                    u32x4 w; w.x = cvt_pk_bf16(v0[0], v0[1]); w.y = cvt_pk_bf16(v0[2], v0[3]); w.z = cvt_pk_bf16(v1[0], v1[1]); w.w = cvt_pk_bf16(v1[2], v1[3]);
                    *(u32x4*)(rowp + bj * 32) = w; } }
    }
};
struct BranchOrder {
    pg8::StaticOrder S0;
    __device__ __forceinline__ void init(int M, int N, int G_, int c_) { S0.init(M, N, G_, c_); }
    __device__ __forceinline__ bool next(int i, Unit& u) const { if (i >= 4) return false; Unit t; if (!S0.next(0, t)) return false; u.pm = t.pm; u.pn = i * 4 + t.pn; return true; }
    __device__ __forceinline__ void a_ready(const Unit&) const {}
    __device__ __forceinline__ void done(const Unit&) const {}
};
struct EpiBranchAll {
    static constexpr bool PERM = true, AFTER_DRAIN = false;
    const bf16_t* gateP;
    bf16_t* mbP; bf16_t* mb; LAS unsigned char* st;
    __device__ __forceinline__ void operator()(const f32x4 (&acc)[2][2][4][2], const Unit& u, int wr, int wc, int fr, int fq) const {
        const int wv8 = wr * 4 + wc, ln = fq * 16 + fr, br = u.pn >> 2, pn = u.pn & 3, MODE = br == 0 ? 0 : (br == 3 ? 2 : 1);
        const u32x4* gp = (const u32x4*)gateP + ((size_t)((u.pm * 16 + br * 4 + pn) * 8 + wv8) * 16) * 64 + ln;
        u32x4* mp = (u32x4*)mbP + ((size_t)((u.pm * 4 + pn) * 8 + wv8) * 16) * 64 + ln;
        u32x4 gw[2][4][2];
#pragma unroll
        for (int ai = 0; ai < 2; ++ai)
#pragma unroll
            for (int m = 0; m < 4; ++m)
#pragma unroll
                for (int bj = 0; bj < 2; ++bj) gw[ai][m][bj] = gp[((ai * 4 + m) * 2 + bj) * 64];
        asm volatile("" ::: "memory");
        f32x4 v[2][4][2][2];
#pragma unroll
        for (int ai = 0; ai < 2; ++ai)
#pragma unroll
            for (int m = 0; m < 4; ++m)
#pragma unroll
                for (int bj = 0; bj < 2; ++bj) { const u32x4 g = gw[ai][m][bj]; f32x4 g0, g1;
                    g0[0] = sigmoidf_(bflo(g.x)); g0[1] = sigmoidf_(bfhi(g.x)); g0[2] = sigmoidf_(bflo(g.y)); g0[3] = sigmoidf_(bfhi(g.y));
                    g1[0] = sigmoidf_(bflo(g.z)); g1[1] = sigmoidf_(bfhi(g.z)); g1[2] = sigmoidf_(bflo(g.w)); g1[3] = sigmoidf_(bfhi(g.w));
                    v[ai][m][bj][0] = acc[ai][bj][m][0] * g0; v[ai][m][bj][1] = acc[ai][bj][m][1] * g1; }
        if (MODE >= 1) {
#pragma unroll
            for (int ai = 0; ai < 2; ++ai)
#pragma unroll
                for (int m = 0; m < 4; ++m)
#pragma unroll
                    for (int bj = 0; bj < 2; ++bj) gw[ai][m][bj] = mp[((ai * 4 + m) * 2 + bj) * 64];
            asm volatile("" ::: "memory");
#pragma unroll
            for (int ai = 0; ai < 2; ++ai)
#pragma unroll
                for (int m = 0; m < 4; ++m)
#pragma unroll
                    for (int bj = 0; bj < 2; ++bj) { const u32x4 o = gw[ai][m][bj];
                        v[ai][m][bj][0][0] += bflo(o.x); v[ai][m][bj][0][1] += bfhi(o.x); v[ai][m][bj][0][2] += bflo(o.y); v[ai][m][bj][0][3] += bfhi(o.y);
                        v[ai][m][bj][1][0] += bflo(o.z); v[ai][m][bj][1][1] += bfhi(o.z); v[ai][m][bj][1][2] += bflo(o.w); v[ai][m][bj][1][3] += bfhi(o.w); }
        }
        if (MODE < 2) {
#pragma unroll
            for (int ai = 0; ai < 2; ++ai)
#pragma unroll
                for (int m = 0; m < 4; ++m)
#pragma unroll
                    for (int bj = 0; bj < 2; ++bj) { const f32x4 v0 = v[ai][m][bj][0], v1 = v[ai][m][bj][1];
                        u32x4 w; w.x = cvt_pk_bf16(v0[0], v0[1]); w.y = cvt_pk_bf16(v0[2], v0[3]); w.z = cvt_pk_bf16(v1[0], v1[1]); w.w = cvt_pk_bf16(v1[2], v1[3]);
                        mp[((ai * 4 + m) * 2 + bj) * 64] = w; }
        } else {
            ST_BLOCK_SETUP(st);
            bf16_t* op = mb + (size_t)(u.pm * 256 + wr * 64 + rrow) * DM + pn * 256 + wc * 64 + rp * 8;
#pragma unroll
            for (int ai = 0; ai < 2; ++ai)
#pragma unroll
                for (int m = 0; m < 4; ++m) { u32x4 wq[2];
#pragma unroll
                    for (int bj = 0; bj < 2; ++bj) { const f32x4 v0 = v[ai][m][bj][0], v1 = v[ai][m][bj][1];
                        wq[bj].x = cvt_pk_bf16(v0[0], v0[1]); wq[bj].y = cvt_pk_bf16(v0[2], v0[3]); wq[bj].z = cvt_pk_bf16(v1[0], v1[1]); wq[bj].w = cvt_pk_bf16(v1[2], v1[3]); }
                    st_block_bf16(sw, woff, roff, wq[0], wq[1], op + (size_t)(ai * 128 + m * 16) * DM, DM); }
        }
    }
};
struct EpiResid {
    static constexpr bool PERM = true, AFTER_DRAIN = false;
    const float* xf; float* o;
    __device__ __forceinline__ void operator()(const f32x4 (&acc)[2][2][4][2], const Unit& u, int wr, int wc, int fr, int fq) const {
        const int row0 = u.pm * 256 + wr * 64 + fr, col0 = u.pn * 256 + wc * 64 + 8 * fq;
#pragma unroll
        for (int ai = 0; ai < 2; ++ai) {
            f32x4 xv[4][2][2];
#pragma unroll
            for (int m = 0; m < 4; ++m)
#pragma unroll
                for (int bj = 0; bj < 2; ++bj) { const size_t off = (size_t)(row0 + ai * 128 + m * 16) * DM + col0 + bj * 32; xv[m][bj][0] = *(const f32x4*)(xf + off); xv[m][bj][1] = *(const f32x4*)(xf + off + 4); }
            asm volatile("" ::: "memory");
#pragma unroll
            for (int m = 0; m < 4; ++m)
#pragma unroll
                for (int bj = 0; bj < 2; ++bj) { const size_t off = (size_t)(row0 + ai * 128 + m * 16) * DM + col0 + bj * 32;
                    *(f32x4*)(o + off) = xv[m][bj][0] * DN_ALPHA + acc[ai][bj][m][0]; *(f32x4*)(o + off + 4) = xv[m][bj][1] * DN_ALPHA + acc[ai][bj][m][1]; }
            asm volatile("" ::: "memory");
        }
    }
};
constexpr float W8_SCALE = 64.0f, H8_SCALE = 16.0f;
constexpr int E8_ONE = 0x7F7F7F7F, E8_W = 0x79797979  , E8_H = 0x7B7B7B7B  ;
__device__ __forceinline__ unsigned pk_fp8x4(float a, float b, float c, float d) { int w = __builtin_amdgcn_cvt_pk_fp8_f32(a, b, 0, false); w = __builtin_amdgcn_cvt_pk_fp8_f32(c, d, w, true); return (unsigned)w; }
struct EpiSwiGLU {
    static constexpr bool PERM = true, AFTER_DRAIN = false;
    unsigned char* H;
    __device__ __forceinline__ void operator()(const f32x4 (&acc)[2][2][4][2], const Unit& u, int wr, int wc, int fr, int fq) const {
        const int row0 = u.pm * 256 + wr * 64 + fr, col0 = (u.pn & 15) * 128 + wc * 32 + 8 * fq;
#pragma unroll
        for (int ai = 0; ai < 2; ++ai)
#pragma unroll
            for (int m = 0; m < 4; ++m) { unsigned char* rowp = H + (size_t)(row0 + ai * 128 + m * 16) * DEXP + col0;
                f32x4 v[2];
#pragma unroll
                for (int n = 0; n < 2; ++n)
#pragma unroll
                    for (int j = 0; j < 4; ++j) { const float g = acc[ai][0][m][n][j], up = acc[ai][1][m][n][j]; v[n][j] = g * sigmoidf_(g) * up * H8_SCALE; }
                u32x2 w; w.x = pk_fp8x4(v[0][0], v[0][1], v[0][2], v[0][3]); w.y = pk_fp8x4(v[1][0], v[1][1], v[1][2], v[1][3]);
                *(u32x2*)rowp = w; }
    }
};
struct EpiDown {
    static constexpr bool PERM = true, AFTER_DRAIN = false;
    bf16_t* Y; const float* grow;
    __device__ __forceinline__ void operator()(const f32x4 (&acc)[2][2][4][2], const Unit& u, int wr, int wc, int fr, int fq) const {
        const int row0 = u.pm * 256 + wr * 64 + fr, col0 = (u.pn & 3) * 256 + wc * 64 + 8 * fq;
        float gr[2][4];
#pragma unroll
        for (int ai = 0; ai < 2; ++ai)
#pragma unroll
            for (int m = 0; m < 4; ++m) gr[ai][m] = grow[row0 + ai * 128 + m * 16];
#pragma unroll
        for (int ai = 0; ai < 2; ++ai)
#pragma unroll
            for (int m = 0; m < 4; ++m) { const int row = row0 + ai * 128 + m * 16; const float g = gr[ai][m]; bf16_t* rowp = Y + (size_t)row * DM + col0;
#pragma unroll
                for (int bj = 0; bj < 2; ++bj) { const f32x4 v0 = acc[ai][bj][m][0] * g, v1 = acc[ai][bj][m][1] * g;
                    u32x4 w; w.x = cvt_pk_bf16(v0[0], v0[1]); w.y = cvt_pk_bf16(v0[2], v0[3]); w.z = cvt_pk_bf16(v1[0], v1[1]); w.w = cvt_pk_bf16(v1[2], v1[3]);
                    *(u32x4*)(rowp + bj * 32) = w; } }
    }
};

__device__ __forceinline__ int wcont_row(int gn) { return (gn & ~255) | (((gn >> 5) & 1) << 7) | (((gn >> 6) & 3) << 5) | (gn & 31); }
__device__ __forceinline__ void tconv(const float* __restrict__ src, int nb, int K, int N, bf16_t* __restrict__ dst, size_t dst_bs, int ldd, int blk, int bstride, int boff, float* tile, int wv) {
    const int tid = otid(wv), ntn = N >> 8, tpb = (K >> 6) * ntn, nt = nb * tpb;
    f32x4 v[8];
#define TC_LOAD(t_) do { const int bi_ = (t_) / tpb, tr_ = (t_) % tpb, k0_ = (tr_ / ntn) * 64, n0_ = (tr_ % ntn) * 256; const float* sb_ = src + (size_t)bi_ * K * N; \
        _Pragma("unroll") for (int i = 0; i < 8; ++i) { const int kk = i * 8 + (tid >> 6), nn = (tid & 63) * 4; v[i] = *(const f32x4*)(sb_ + (size_t)(k0_ + kk) * N + n0_ + nn); } } while (0)
    int t = blockIdx.x;
    if (t < nt) TC_LOAD(t);
    for (; t < nt; t += gridDim.x) {
        const int bi = t / tpb, tr = t % tpb, k0 = (tr / ntn) * 64, n0 = (tr % ntn) * 256;
#pragma unroll
        for (int i = 0; i < 8; ++i) { const int kk = i * 8 + (tid >> 6), nn = (tid & 63) * 4; float* tp = tile + kk * 257 + nn; tp[0] = v[i][0]; tp[1] = v[i][1]; tp[2] = v[i][2]; tp[3] = v[i][3]; }
        __syncthreads();
        if (t + (int)gridDim.x < nt) TC_LOAD(t + (int)gridDim.x);
        bf16_t* db = dst + (size_t)bi * dst_bs;
#pragma unroll
        for (int j = 0; j < 4; ++j) { const int q = tid + 512 * j, n = q >> 3, kc = q & 7; const float* s = tile + (kc * 8) * 257 + n;
            u32x4 o; o.x = cvt_pk_bf16(s[0], s[257]); o.y = cvt_pk_bf16(s[2 * 257], s[3 * 257]); o.z = cvt_pk_bf16(s[4 * 257], s[5 * 257]); o.w = cvt_pk_bf16(s[6 * 257], s[7 * 257]);
            const int gn = n0 + n, drow = blk == (1 << 30) ? wcont_row(gn) : (gn / blk) * bstride + boff + (gn % blk);
            *(u32x4*)(db + (size_t)drow * ldd + k0 + kc * 8) = o; }
        __syncthreads();
    }
#undef TC_LOAD
}
__device__ __forceinline__ void tconv8(const float* __restrict__ src, int nb, int K, int N, unsigned char* __restrict__ dst, size_t dst_bs, int ldd, int blk, int bstride, int boff, float sc, float* tile, int wv) {
    const int tid = otid(wv), ntn = N >> 7, tpb = (K >> 7) * ntn, nt = nb * tpb;
    f32x4 v[8];
#define TC_LOAD(t_) do { const int bi_ = (t_) / tpb, tr_ = (t_) % tpb, k0_ = (tr_ / ntn) * 128, n0_ = (tr_ % ntn) * 128; const float* sb_ = src + (size_t)bi_ * K * N; \
        _Pragma("unroll") for (int i = 0; i < 8; ++i) { const int kk = i * 16 + (tid >> 5), nn = (tid & 31) * 4; v[i] = *(const f32x4*)(sb_ + (size_t)(k0_ + kk) * N + n0_ + nn); } } while (0)
    int t = blockIdx.x;
    if (t < nt) TC_LOAD(t);
    for (; t < nt; t += gridDim.x) {
        const int bi = t / tpb, tr = t % tpb, k0 = (tr / ntn) * 128, n0 = (tr % ntn) * 128;
#pragma unroll
        for (int i = 0; i < 8; ++i) { const int kk = i * 16 + (tid >> 5), nn = (tid & 31) * 4; float* tp = tile + kk * 129 + nn; tp[0] = v[i][0]; tp[1] = v[i][1]; tp[2] = v[i][2]; tp[3] = v[i][3]; }
        __syncthreads();
        if (t + (int)gridDim.x < nt) TC_LOAD(t + (int)gridDim.x);
        unsigned char* db = dst + (size_t)bi * dst_bs;
#pragma unroll
        for (int j = 0; j < 2; ++j) { const int q = tid + 512 * j, n = q >> 3, kc = q & 7; const float* s = tile + (kc * 16) * 129 + n;
            u32x4 o;
            o.x = pk_fp8x4(s[0] * sc, s[129] * sc, s[2 * 129] * sc, s[3 * 129] * sc); o.y = pk_fp8x4(s[4 * 129] * sc, s[5 * 129] * sc, s[6 * 129] * sc, s[7 * 129] * sc);
            o.z = pk_fp8x4(s[8 * 129] * sc, s[9 * 129] * sc, s[10 * 129] * sc, s[11 * 129] * sc); o.w = pk_fp8x4(s[12 * 129] * sc, s[13 * 129] * sc, s[14 * 129] * sc, s[15 * 129] * sc);
            const int gn = n0 + n, drow = blk == (1 << 30) ? wcont_row(gn) : (gn / blk) * bstride + boff + (gn % blk);
            *(u32x4*)(db + (size_t)drow * ldd + k0 + kc * 16) = o; }
        __syncthreads();
    }
#undef TC_LOAD
}

__device__ __forceinline__ void phase_convert(const Params& P, float* ldsf) {
    unsigned char* ws = kws();
    const int NOBLK = 1 << 30;
    tconv(kin(I_WIN), DEPTH, DM, INC, (bf16_t*)(ws + WS_WIN), (size_t)INC * DM, DM, NOBLK, 0, 0, ldsf, P.pad0);
    tconv(kin(I_WBR), DEPTH, BRK, DM, (bf16_t*)(ws + WS_WBR), (size_t)DM * BRK, BRK, NOBLK, 0, 0, ldsf, P.pad0);
    tconv(kin(I_WOUT), DEPTH, DM, DM, (bf16_t*)(ws + WS_WOUT), (size_t)DM * DM, DM, NOBLK, 0, 0, ldsf, P.pad0);
    tconv(kin(I_WKV), DEPTH, DM, 512, (bf16_t*)(ws + WS_WKV), (size_t)512 * DM, DM, NOBLK, 0, 0, ldsf, P.pad0);
    tconv8(kin(I_EWG), DEPTH * NEXP, DM, DEXP, ws + WS_WGU, (size_t)4096 * DM, DM, 128, 256, 0, W8_SCALE, ldsf, P.pad0);
    tconv8(kin(I_EWU), DEPTH * NEXP, DM, DEXP, ws + WS_WGU, (size_t)4096 * DM, DM, 128, 256, 128, W8_SCALE, ldsf, P.pad0);
    tconv8(kin(I_EWD), DEPTH * NEXP, DEXP, DM, ws + WS_WDN, (size_t)DM * DEXP, DEXP, NOBLK, 0, 0, W8_SCALE, ldsf, P.pad0);
    for (int l = 0; l < DEPTH; ++l) {
        bf16_t* wl = (bf16_t*)(ws + WS_WLORA) + (size_t)l * LORA_N * 256;
        tconv(kin(I_WUP) + (size_t)l * 2 * 64 * 1024, 2, 64, 1024, wl, (size_t)1024 * 256, 256, NOBLK, 0, 0, ldsf, P.pad0);
        tconv(kin(I_AUP) + (size_t)l * 2 * 64 * 1024, 2, 64, 1024, wl + (size_t)2048 * 256 + 64, (size_t)1024 * 256, 256, NOBLK, 0, 0, ldsf, P.pad0);
        tconv(kin(I_GUP) + (size_t)l * 128 * 1024, 1, 128, 1024, wl + (size_t)4096 * 256 + 128, 0, 256, NOBLK, 0, 0, ldsf, P.pad0);
    }
    const size_t gtid = (size_t)blockIdx.x * NTHR + otid(P.pad0), gsz = (size_t)gridDim.x * NTHR;
    { u32x4* wl4 = (u32x4*)(ws + WS_WLORA); const u32x4 zz = {0u, 0u, 0u, 0u};
      for (size_t i = gtid; i < (size_t)DEPTH * LORA_N * 32; i += gsz) { const int k8 = (int)(i & 31), n = (int)((i >> 5) % LORA_N);
          const bool blockpart = n < 2048 ? (k8 < 8) : (n < 4096 ? (k8 >= 8 && k8 < 16) : (k8 >= 16));
          if (!blockpart) wl4[i] = zz; } }
    { const f32x4* x4 = (const f32x4*)kin(I_X); f32x4* xf4 = (f32x4*)(ws + WS_XF); u32x2* xb2 = (u32x2*)(ws + WS_XB);
      for (size_t i0 = gtid; i0 < (size_t)NTOK * DM / 4; i0 += gsz * 8) { f32x4 v[8];
#pragma unroll
          for (int q = 0; q < 8; ++q) { const size_t i = i0 + q * gsz; v[q] = i < (size_t)NTOK * DM / 4 ? x4[i] : (f32x4){0.f, 0.f, 0.f, 0.f}; }
#pragma unroll
          for (int q = 0; q < 8; ++q) { const size_t i = i0 + q * gsz; if (i < (size_t)NTOK * DM / 4) { xf4[i] = v[q]; u32x2 w; w.x = cvt_pk_bf16(v[q][0], v[q][1]); w.y = cvt_pk_bf16(v[q][2], v[q][3]); xb2[i] = w; } } } }
    { const f32x4* m4 = (const f32x4*)kin(I_MEM); u32x2* mb2 = (u32x2*)(ws + WS_MEMB);
      for (size_t i = gtid; i < (size_t)NBATCH * NMEM * DM / 4; i += gsz) { const f32x4 v = m4[i]; u32x2 w; w.x = cvt_pk_bf16(v[0], v[1]); w.y = cvt_pk_bf16(v[2], v[3]); mb2[i] = w; } }
}

__device__ __forceinline__ void phase_prepass(const Params& P, int l) {
    const bf16_t* p = (const bf16_t*)(kws() + WS_P); bf16_t* ap = (bf16_t*)(kws() + WS_APR);
    const float* mu = kin(I_MU) + (size_t)l * 2 * RWC;
    const int gtid = blockIdx.x * NTHR + otid(P.pad0), gsz = gridDim.x * NTHR;
    const int jg = gtid & 63, col = C_DW + jg * 4;
    const f32x4 m0 = *(const f32x4*)(mu + col), m1 = *(const f32x4*)(mu + RWC + col);
    for (int t0 = gtid >> 6; t0 < NTOK; t0 += (gsz >> 6) * 4) {
        u32x2 xc[4], xp[4], xn[4];
#pragma unroll
        for (int q = 0; q < 4; ++q) { const int tok = t0 + q * (gsz >> 6); const int tk = tok < NTOK ? tok : 0; const int s = tk & (SEQ - 1); const bf16_t* pr = p + (size_t)tk * INC + col; const u32x2 zz = {0u, 0u};
            xc[q] = *(const u32x2*)pr; xp[q] = s > 0 ? *(const u32x2*)(pr - INC) : zz; xn[q] = s < SEQ - 1 ? *(const u32x2*)(pr + INC) : zz; }
#pragma unroll
        for (int q = 0; q < 4; ++q) { const int tok = t0 + q * (gsz >> 6);
            f32x4 x, a, b;
            x[0] = bflo(xc[q].x); x[1] = bfhi(xc[q].x); x[2] = bflo(xc[q].y); x[3] = bfhi(xc[q].y);
            a[0] = bflo(xp[q].x); a[1] = bfhi(xp[q].x); a[2] = bflo(xp[q].y); a[3] = bfhi(xp[q].y);
            b[0] = bflo(xn[q].x); b[1] = bfhi(xn[q].x); b[2] = bflo(xn[q].y); b[3] = bfhi(xn[q].y);
            f32x4 v = x + m0 * (a - x) + m1 * (b - x);
            if (jg < 16) {
#pragma unroll
                for (int j = 0; j < 4; ++j) v[j] = 1.0f - 2.0f * __builtin_amdgcn_rcpf(1.0f + __expf(2.0f * v[j]));
            } else if (jg >= 32) {
#pragma unroll
                for (int j = 0; j < 4; ++j) v[j] = sigmoidf_(v[j]);
            }
            if (tok < NTOK) { typedef __bf16 bf4_ __attribute__((ext_vector_type(4)));
                *(bf4_*)(ap + (size_t)tok * 256 + jg * 4) = __builtin_convertvector(v, bf4_); } }
    }
}

__device__ __forceinline__ void phase_post(const Params& P, int l) {
    const bf16_t* p = (const bf16_t*)(kws() + WS_P); const bf16_t* lora = (const bf16_t*)(kws() + WS_LORA);
    const bf16_t* ydir = (const bf16_t*)(kws() + WS_YDIR); const float* bonus = (const float*)(kws() + WS_BONUS);
    bf16_t* ycat = (bf16_t*)(kws() + WS_YCAT);
    const int tid = otid(P.pad0), lane = tid & 63, wid = tid >> 6;
    const float* mu = kin(I_MU) + (size_t)l * 2 * RWC;
    const int gw = blockIdx.x * 8 + wid, ngw = gridDim.x * 8;
    { const int hg = gw & 3, c4 = hg * 256 + lane * 4, h = hg * 4 + (lane >> 4);
      const f32x4 gng = *(const f32x4*)(kin(I_GNG) + l * 1024 + c4), gnb = *(const f32x4*)(kin(I_GNB) + l * 1024 + c4);
      const f32x4 mu0 = *(const f32x4*)(mu + C_V + c4), mu1 = *(const f32x4*)(mu + RWC + C_V + c4);
      for (int t0 = gw >> 2; t0 < NTOK; t0 += (ngw >> 2) * 4) {
          f32x4 y[4]; u32x2 vc[4], vp[4], vn[4], gg[4]; float bon[4]; bool ok[4];
#pragma unroll
          for (int q = 0; q < 4; ++q) { const int tok = t0 + q * (ngw >> 2); ok[q] = tok < NTOK; const int tk = ok[q] ? tok : 0; const int s = tk & (SEQ - 1);
              { const u32x2 y0 = *(const u32x2*)(ydir + (size_t)tk * DM + c4), y1 = *(const u32x2*)(ydir + ((size_t)NTOK + tk) * DM + c4);
                y[q][0] = bflo(y0.x) + bflo(y1.x); y[q][1] = bfhi(y0.x) + bfhi(y1.x); y[q][2] = bflo(y0.y) + bflo(y1.y); y[q][3] = bfhi(y0.y) + bfhi(y1.y); }
              const bf16_t* pv = p + (size_t)tk * INC + C_V + c4; const u32x2 zz = {0u, 0u};
              vc[q] = *(const u32x2*)pv; vp[q] = s > 0 ? *(const u32x2*)(pv - INC) : zz; vn[q] = s < SEQ - 1 ? *(const u32x2*)(pv + INC) : zz;
              gg[q] = *(const u32x2*)(lora + (size_t)tk * LORA_N + 4096 + c4);
              bon[q] = bonus[(size_t)tk * 16 + h] + bonus[((size_t)NTOK + tk) * 16 + h]; }
#pragma unroll
          for (int q = 0; q < 4; ++q) { const int tok = t0 + q * (ngw >> 2);
              const float mean = sum16((y[q][0] + y[q][1]) + (y[q][2] + y[q][3])) * (1.0f / 64.0f); const f32x4 dy = y[q] - mean;
              const float var = sum16((dy[0] * dy[0] + dy[1] * dy[1]) + (dy[2] * dy[2] + dy[3] * dy[3])) * (1.0f / 64.0f);
              const f32x4 yn = dy * rsqrtf(var + 64e-5f) * gng + gnb;
              f32x4 v, vpv, vnx, g;
              v[0] = bflo(vc[q].x); v[1] = bfhi(vc[q].x); v[2] = bflo(vc[q].y); v[3] = bfhi(vc[q].y);
              vpv[0] = bflo(vp[q].x); vpv[1] = bfhi(vp[q].x); vpv[2] = bflo(vp[q].y); vpv[3] = bfhi(vp[q].y);
              vnx[0] = bflo(vn[q].x); vnx[1] = bfhi(vn[q].x); vnx[2] = bflo(vn[q].y); vnx[3] = bfhi(vn[q].y);
              g[0] = bflo(gg[q].x); g[1] = bfhi(gg[q].x); g[2] = bflo(gg[q].y); g[3] = bfhi(gg[q].y);
              const f32x4 vs = v + mu0 * (vpv - v) + mu1 * (vnx - v);
              const f32x4 o = (yn + vs * bon[q]) * g;
              if (ok[q]) { u32x2 w; w.x = cvt_pk_bf16(o[0], o[1]); w.y = cvt_pk_bf16(o[2], o[3]); *(u32x2*)(ycat + (size_t)tok * BRK + c4) = w; } }
      } }
}

__device__ __forceinline__ void phase_ln1(const Params& P, int l, float* ldsf) {
    const float* pre = (const float*)(kws() + WS_PRELN); float* xf = (float*)(kws() + WS_XF); bf16_t* xb = (bf16_t*)(kws() + WS_XB); float* aff = (float*)(kws() + WS_AFF);
    const float* g = kin(I_LN1G) + l * DM; const float* bt = kin(I_LN1B) + l * DM; const float* router = kin(I_ROUTER) + (size_t)l * DM * 16;
    const int tid = otid(P.pad0), lane = tid & 63, wid = tid >> 6;
    { f32x4 tmp[8];
#pragma unroll
      for (int k8 = 0; k8 < 8; ++k8) tmp[k8] = ((const f32x4*)router)[tid + k8 * NTHR];
#pragma unroll
      for (int k8 = 0; k8 < 8; ++k8) { const int i = tid + k8 * NTHR, d = i >> 2, e0 = (i & 3) * 4; ldsf[(e0 + 0) * DM + d] = tmp[k8][0]; ldsf[(e0 + 1) * DM + d] = tmp[k8][1]; ldsf[(e0 + 2) * DM + d] = tmp[k8][2]; ldsf[(e0 + 3) * DM + d] = tmp[k8][3]; } }
    __syncthreads();
    f32x4 gv[4], bv[4];
#pragma unroll
    for (int i = 0; i < 4; ++i) { gv[i] = *(const f32x4*)(g + lane * 4 + 256 * i); bv[i] = *(const f32x4*)(bt + lane * 4 + 256 * i); }
    const int row_first = blockIdx.x * 8 + wid, row_step = gridDim.x * 8;
    f32x4 vnx[4];
    if (row_first < NTOK) {
#pragma unroll
        for (int i = 0; i < 4; ++i) vnx[i] = *(const f32x4*)(pre + (size_t)row_first * DM + lane * 4 + 256 * i);
    }
    for (int row = row_first; row < NTOK; row += row_step) {
        f32x4 v[4]; float s = 0.f;
#pragma unroll
        for (int i = 0; i < 4; ++i) { v[i] = vnx[i]; s += (v[i][0] + v[i][1]) + (v[i][2] + v[i][3]); }
        if (row + row_step < NTOK) {
#pragma unroll
            for (int i = 0; i < 4; ++i) vnx[i] = *(const f32x4*)(pre + (size_t)(row + row_step) * DM + lane * 4 + 256 * i);
        }
        const float mean = wave_sum(s) * (1.0f / DM); float s2 = 0.f;
#pragma unroll
        for (int i = 0; i < 4; ++i) { v[i] = v[i] - mean; s2 += (v[i][0] * v[i][0] + v[i][1] * v[i][1]) + (v[i][2] * v[i][2] + v[i][3] * v[i][3]); }
        const float rstd = rsqrtf(wave_sum(s2) * (1.0f / DM) + 1e-5f);
        float lg[16];
#pragma unroll
        for (int e = 0; e < 16; ++e) lg[e] = 0.f;
#pragma unroll
        for (int i = 0; i < 4; ++i) { v[i] = v[i] * rstd * gv[i] + bv[i];
            *(f32x4*)(xf + (size_t)row * DM + lane * 4 + 256 * i) = v[i];
            u32x2 w; w.x = cvt_pk_bf16(v[i][0], v[i][1]); w.y = cvt_pk_bf16(v[i][2], v[i][3]); *(u32x2*)(xb + (size_t)row * DM + lane * 4 + 256 * i) = w;
#pragma unroll
            for (int e = 0; e < 16; ++e) { const f32x4 r = *(const f32x4*)(ldsf + e * DM + lane * 4 + 256 * i); lg[e] += (v[i][0] * r[0] + v[i][1] * r[1]) + (v[i][2] * r[2] + v[i][3] * r[3]); } }
        const int lid = lane_id();
#define LN_HALVE(M, H) do { const bool up_ = (lid & (M)) != 0; _Pragma("unroll") for (int j = 0; j < (H); ++j) { const float send_ = up_ ? lg[j] : lg[j + (H)], keep_ = up_ ? lg[j + (H)] : lg[j]; \
            lg[j] = keep_ + __builtin_bit_cast(float, __builtin_amdgcn_ds_bpermute((lid ^ (M)) << 2, __builtin_bit_cast(int, send_))); } } while (0)
        LN_HALVE(32, 8); LN_HALVE(16, 4); LN_HALVE(8, 2); LN_HALVE(4, 1);
#undef LN_HALVE
        float tot = lg[0];
        tot += __builtin_bit_cast(float, __builtin_amdgcn_ds_bpermute((lid ^ 2) << 2, __builtin_bit_cast(int, tot)));
        tot += __builtin_bit_cast(float, __builtin_amdgcn_ds_bpermute((lid ^ 1) << 2, __builtin_bit_cast(int, tot)));
        float mx = tot;
#pragma unroll
        for (int M = 4; M < 64; M <<= 1) mx = fmaxf(mx, __builtin_bit_cast(float, __builtin_amdgcn_ds_bpermute((lid ^ M) << 2, __builtin_bit_cast(int, mx))));
        const float ex = expf(tot - mx); float se = ex;
#pragma unroll
        for (int M = 4; M < 64; M <<= 1) se += __builtin_bit_cast(float, __builtin_amdgcn_ds_bpermute((lid ^ M) << 2, __builtin_bit_cast(int, se)));
        const int eidx = ((lid >> 5) & 1) * 8 + ((lid >> 4) & 1) * 4 + ((lid >> 3) & 1) * 2 + ((lid >> 2) & 1);
        if ((lid & 3) == 0) aff[(size_t)row * 16 + eidx] = ex / se;
    }
    __syncthreads();
}
__device__ __forceinline__ void phase_ln2(const Params& P, int l) {
    float* xf = (float*)(kws() + WS_XF); bf16_t* xb = (bf16_t*)(kws() + WS_XB); const bf16_t* ye = (const bf16_t*)(kws() + WS_YE); const int* slot_of = (const int*)(kws() + WS_SLOT);
    const float* g = kin(I_LN2G) + l * DM; const float* bt = kin(I_LN2B) + l * DM;
    float* dst = (l == DEPTH - 1) ? kout() : xf;
    const int tid = otid(P.pad0), lane = tid & 63, wid = __builtin_amdgcn_readfirstlane(tid >> 6);
    f32x4 gv[4], bv[4];
#pragma unroll
    for (int i = 0; i < 4; ++i) { gv[i] = *(const f32x4*)(g + lane * 4 + 256 * i); bv[i] = *(const f32x4*)(bt + lane * 4 + 256 * i); }
    const int gw = blockIdx.x * 8 + wid, ngw = gridDim.x * 8;
    for (int r0 = gw; r0 < NTOK; r0 += 4 * ngw) {
        const int rk = r0 + (lane >> 4) * ngw; const int slv = rk < NTOK ? slot_of[(size_t)rk * 16 + (lane & 15)] : -1;
        const unsigned long long m64 = __ballot(slv >= 0);
#pragma unroll
        for (int pr = 0; pr < 2; ++pr) {
            f32x4 v[2][4]; u32x2 tmp[2][4][4]; int nv[2]; bool ok[2];
#pragma unroll
            for (int q = 0; q < 2; ++q) { const int k = pr * 2 + q; const int row = r0 + k * ngw; ok[q] = row < NTOK; const int rw = ok[q] ? row : 0; const int b = rw >> 11;
#pragma unroll
                for (int i = 0; i < 4; ++i) v[q][i] = *(const f32x4*)(xf + (size_t)rw * DM + lane * 4 + 256 * i);
                unsigned bits = ok[q] ? (unsigned)((m64 >> (16 * k)) & 0xFFFFull) : 0u; nv[q] = 0;
#pragma unroll
                for (int j = 0; j < 4; ++j) { if (bits) { const int e = __builtin_ctz(bits); bits &= bits - 1; const int sl = __builtin_amdgcn_readlane(slv, 16 * k + e);
                        const bf16_t* yr = ye + ((size_t)(e * 8 + b) * 256 + sl) * DM + lane * 4;
#pragma unroll
                        for (int i = 0; i < 4; ++i) tmp[q][j][i] = *(const u32x2*)(yr + 256 * i);
                        nv[q] = j + 1; } }
#pragma unroll
                for (int i = 0; i < 4; ++i) v[q][i] = v[q][i] * DN_ALPHA;
#pragma unroll
                for (int j = 0; j < 4; ++j) if (j < nv[q]) {
#pragma unroll
                    for (int i = 0; i < 4; ++i) { const u32x2 w = tmp[q][j][i]; v[q][i][0] += bflo(w.x); v[q][i][1] += bfhi(w.x); v[q][i][2] += bflo(w.y); v[q][i][3] += bfhi(w.y); } }
                while (bits) { const int e = __builtin_ctz(bits); bits &= bits - 1; const int sl = __builtin_amdgcn_readlane(slv, 16 * k + e);
                    const bf16_t* yr = ye + ((size_t)(e * 8 + b) * 256 + sl) * DM + lane * 4;
#pragma unroll
                    for (int i = 0; i < 4; ++i) { const u32x2 w = *(const u32x2*)(yr + 256 * i); v[q][i][0] += bflo(w.x); v[q][i][1] += bfhi(w.x); v[q][i][2] += bflo(w.y); v[q][i][3] += bfhi(w.y); } }
            }
#pragma unroll
            for (int q = 0; q < 2; ++q) { const int row = r0 + (pr * 2 + q) * ngw;
                float s = 0.f;
#pragma unroll
                for (int i = 0; i < 4; ++i) s += (v[q][i][0] + v[q][i][1]) + (v[q][i][2] + v[q][i][3]);
                const float mean = wave_sum(s) * (1.0f / DM); float s2 = 0.f;
#pragma unroll
                for (int i = 0; i < 4; ++i) { v[q][i] = v[q][i] - mean; s2 += (v[q][i][0] * v[q][i][0] + v[q][i][1] * v[q][i][1]) + (v[q][i][2] * v[q][i][2] + v[q][i][3] * v[q][i][3]); }
                const float rstd = rsqrtf(wave_sum(s2) * (1.0f / DM) + 1e-5f);
                if (ok[q]) {
#pragma unroll
                    for (int i = 0; i < 4; ++i) { const f32x4 o = v[q][i] * rstd * gv[i] + bv[i];
                        *(f32x4*)(dst + (size_t)row * DM + lane * 4 + 256 * i) = o;
                        if (l < DEPTH - 1) { u32x2 w; w.x = cvt_pk_bf16(o[0], o[1]); w.y = cvt_pk_bf16(o[2], o[3]); *(u32x2*)(xb + (size_t)row * DM + lane * 4 + 256 * i) = w; } } }
            }
        }
    }
}

__device__ __forceinline__ void phase_topk(const Params& P, unsigned long long* keys  ) {
    const float* aff = (const float*)(kws() + WS_AFF); float* grow = (float*)(kws() + WS_GROW); int* slot_of = (int*)(kws() + WS_SLOT);
    const bf16_t* xb = (const bf16_t*)(kws() + WS_XB); unsigned char* xe = kws() + WS_XE;
    const int tid = otid(P.pad0);
    for (int u = blockIdx.x; u < NBATCH * NEXP; u += gridDim.x) {
        const int b = u >> 4, e = u & 15;
#pragma unroll
        for (int j = 0; j < 4; ++j) { const int i = tid + 512 * j; const float v = aff[((size_t)b * SEQ + i) * 16 + e];
            keys[i] = ((unsigned long long)__float_as_uint(v) << 32) | (unsigned long long)(0xFFFFFFFFu - (unsigned)i); }
        __syncthreads();
        { const int wv_ = tid >> 6, ln_ = tid & 63;
          for (int k = 2; k <= SEQ; k <<= 1)
            for (int j = k >> 1; j > 0; j >>= 1) {
                if (j >= 256) __syncthreads();
#pragma unroll
                for (int t2 = 0; t2 < 2; ++t2) { const int t = wv_ * 128 + ln_ + 64 * t2; const int i = ((t & ~(j - 1)) << 1) | (t & (j - 1)), ixj = i | j;
                    const unsigned long long a = keys[i], c = keys[ixj]; const bool desc = (i & k) == 0;
                    if (desc ? (a < c) : (a > c)) { keys[i] = c; keys[ixj] = a; } }
                if (j >= 256) __syncthreads();
                else asm volatile("s_waitcnt lgkmcnt(0)" ::: "memory");
            }
          __syncthreads(); }
#pragma unroll
        for (int j = 0; j < 4; ++j) { const int r = tid + 512 * j; const unsigned long long kk = keys[r]; const int tl = (int)(0xFFFFFFFFu - (unsigned)(kk & 0xFFFFFFFFull));
            slot_of[((size_t)b * SEQ + tl) * 16 + e] = r < CAP ? r : -1;
            if (r < CAP) grow[(e * 8 + b) * CAP + r] = __uint_as_float((unsigned)(kk >> 32)); }
        for (int q0 = tid; q0 < CAP * 64; q0 += NTHR * 16) { u32x4 tmp[16][2];
#pragma unroll
            for (int k8 = 0; k8 < 16; ++k8) { const int q = q0 + k8 * NTHR, r = q >> 6, ch = q & 63; const int tl = (int)(0xFFFFFFFFu - (unsigned)(keys[r] & 0xFFFFFFFFull));
                const bf16_t* sp = xb + ((size_t)b * SEQ + tl) * DM + ch * 16; tmp[k8][0] = *(const u32x4*)sp; tmp[k8][1] = *(const u32x4*)(sp + 8); }
#pragma unroll
            for (int k8 = 0; k8 < 16; ++k8) { const int q = q0 + k8 * NTHR, r = q >> 6, ch = q & 63; u32x4 o;
#define BLO(w_) __uint_as_float((w_) << 16)
#define BHI(w_) __uint_as_float((w_) & 0xFFFF0000u)
                o.x = pk_fp8x4(BLO(tmp[k8][0].x), BHI(tmp[k8][0].x), BLO(tmp[k8][0].y), BHI(tmp[k8][0].y)); o.y = pk_fp8x4(BLO(tmp[k8][0].z), BHI(tmp[k8][0].z), BLO(tmp[k8][0].w), BHI(tmp[k8][0].w));
                o.z = pk_fp8x4(BLO(tmp[k8][1].x), BHI(tmp[k8][1].x), BLO(tmp[k8][1].y), BHI(tmp[k8][1].y)); o.w = pk_fp8x4(BLO(tmp[k8][1].z), BHI(tmp[k8][1].z), BLO(tmp[k8][1].w), BHI(tmp[k8][1].w));
#undef BLO
#undef BHI
                *(u32x4*)(xe + ((size_t)(e * 8 + b) * CAP + r) * DM + ch * 16) = o; } }
        __syncthreads();
    }
}

typedef float f32x16 __attribute__((ext_vector_type(16)));
__device__ __forceinline__ float xmax32(float v) { float a = v, b = v; asm volatile("s_nop 1\n\tv_permlane32_swap_b32 %0, %1\n\ts_nop 1" : "+v"(a), "+v"(b)); return fmaxf(fmaxf(v, a), b); }
typedef short bf16x8s __attribute__((ext_vector_type(8)));
typedef short s16x4 __attribute__((ext_vector_type(4)));
typedef __bf16 bfv8 __attribute__((ext_vector_type(8)));
typedef float fv8 __attribute__((ext_vector_type(8)));
constexpr int FA_KB = 8192;
constexpr float LOG2E = 1.4426950408889634f;
constexpr int FA_TP = 96, FA_TS = 452;
constexpr int FA_OFF_Q = 3 * 8192 + 2 * 64 * (128 * 2 + 64) + 24 * FA_TS * 4;
constexpr float FA_THR = 8.0f;

template <int DV, int MODE>
__device__ __forceinline__ void fa_core(LAS unsigned char* lds, int tid, const bf16_t* qrow  , const bf16_t* kbase, const bf16_t* vbase, size_t ldk,
                                        int tile0, int ntiles, int qw, int qi, const LAS float* btab, f32x16 (&o)[DV / 32], float& m, float& lsum) {
    constexpr int RSV = DV * 2 + 64;
    constexpr int VB = 64 * RSV;
    constexpr int NDB = DV / 32;
    constexpr int NVC = DV / 64;
    constexpr int OFF_K = 0, OFF_V = 3 * FA_KB;
    const int lane = tid & 63, r = lane & 31, hh = lane >> 5, wid = __builtin_amdgcn_readfirstlane(tid >> 6);
    LAS unsigned char* qlds = lds + FA_OFF_Q + wid * 4096 + lane * 16;
#pragma unroll
    for (int s = 0; s < 4; ++s) *(LAS bf16x8s*)(qlds + s * 1024) = *(const bf16x8s*)(qrow + 16 * s + 8 * hh);
    constexpr float c1 = 0.125f * LOG2E;
    const int krow = tid >> 3, kch = tid & 7;
    const unsigned kst = (unsigned)(krow * 128 + ((kch ^ ((krow >> 1) & 7)) * 16));
    u32x4 kreg; u32x4 vreg[NVC];
#define FA_LOADK(t) do { kreg = *(const u32x4*)(kbase + ((size_t)(t) * 64 + krow) * ldk + kch * 8); } while (0)
#define FA_LOADV(t) do { _Pragma("unroll") for (int i_ = 0; i_ < NVC; ++i_) { const int c_ = tid + 512 * i_; const int vr_ = c_ / (DV / 8), vc_ = c_ % (DV / 8); vreg[i_] = *(const u32x4*)(vbase + ((size_t)(t) * 64 + vr_) * ldk + vc_ * 8); } } while (0)
#define FA_STOREK(buf) do { *(LAS u32x4*)(lds + OFF_K + (buf) * FA_KB + kst) = kreg; } while (0)
#define FA_STOREV(buf) do { _Pragma("unroll") for (int i_ = 0; i_ < NVC; ++i_) { const int c_ = tid + 512 * i_; const int vr_ = c_ / (DV / 8), vc_ = c_ % (DV / 8); *(LAS u32x4*)(lds + OFF_V + (buf) * VB + vr_ * RSV + vc_ * 16) = vreg[i_]; } } while (0)
    const unsigned kread = (unsigned)(r * 128);
    const int ksw = (r >> 1) & 7;
    const unsigned vread = (unsigned)((4 * hh + ((lane & 15) >> 2)) * RSV + (16 * ((lane >> 4) & 1) + 4 * (lane & 3)) * 2);
#define FA_NEED(t) ((MODE != 0) || (((t) * 64 + 63 >= qw - 128) && ((t) * 64 <= qw + 31 + 128)))
    { FA_LOADK(tile0); const u32x4 k0_ = kreg; FA_LOADV(tile0); if (ntiles > 1) FA_LOADK(tile0 + 1);
      *(LAS u32x4*)(lds + OFF_K + kst) = k0_; FA_STOREV(0); if (ntiles > 1) FA_STOREK(1); }
    __syncthreads();
    if (ntiles > 2) FA_LOADK(tile0 + 2);
    if (ntiles > 1) FA_LOADV(tile0 + 1);
    if (wid >= 4) __builtin_amdgcn_s_barrier();
    int kb3 = 0;
    for (int it = 0; it < ntiles; ++it) {
        const int t = tile0 + it, k0 = t * 64;
        const bool need = FA_NEED(t);
        bf16x8s pf[2][2];
        if (need) {
            f32x16 sc0, sc1;
            { const LAS unsigned char* Kb_ = lds + OFF_K + kb3 * FA_KB;
#pragma unroll
              for (int i_ = 0; i_ < 16; ++i_) { sc0[i_] = 0.f; sc1[i_] = 0.f; }
              bf16x8s ka0[4], ka1[4], kq[4];
#pragma unroll
              for (int s_ = 0; s_ < 4; ++s_) { const unsigned co_ = (unsigned)(((2 * s_ + hh) ^ ksw) * 16);
                  ka0[s_] = *(const LAS bf16x8s*)(Kb_ + kread + co_); ka1[s_] = *(const LAS bf16x8s*)(Kb_ + 32 * 128 + kread + co_); kq[s_] = *(const LAS bf16x8s*)(qlds + s_ * 1024); }
              __builtin_amdgcn_sched_barrier(0);
#pragma unroll
              for (int s_ = 0; s_ < 4; ++s_) { sc0 = __builtin_amdgcn_mfma_f32_32x32x16_bf16(ka0[s_], kq[s_], sc0, 0, 0, 0); sc1 = __builtin_amdgcn_mfma_f32_32x32x16_bf16(ka1[s_], kq[s_], sc1, 0, 0, 0); }
              __builtin_amdgcn_sched_barrier(0); }
            if (MODE == 2) {
#pragma unroll
                for (int i = 0; i < 16; ++i) { sc0[i] *= c1; sc1[i] *= c1; }
            } else {
                const int rmin = k0 - (qw + 31), rmax = k0 + 63 - qw;
                if (rmin >= 129 || rmax <= -129) { const float bc = rmin >= 129 ? btab[258] : btab[0];
#pragma unroll
                    for (int i = 0; i < 16; ++i) { sc0[i] = sc0[i] * c1 + bc; sc1[i] = sc1[i] * c1 + bc; }
                } else { int rb = k0 + 4 * hh - qi + 129; asm volatile("" : "+v"(rb));
#pragma unroll
                    for (int g = 0; g < 4; ++g) {
#pragma unroll
                        for (int e = 0; e < 4; ++e) { const int i = 4 * g + e;
                            sc0[i] = sc0[i] * c1 + btab[rb + e + 8 * g]; sc1[i] = sc1[i] * c1 + btab[rb + e + 8 * g + 32]; }
                    }
                }
            }
            float mx = sc0[0];
#pragma unroll
            for (int i = 1; i < 16; ++i) mx = fmaxf(mx, sc0[i]);
#pragma unroll
            for (int i = 0; i < 16; ++i) mx = fmaxf(mx, sc1[i]);
            mx = xmax32(mx);
            if (__any(mx > m + FA_THR)) {
                const float mn = fmaxf(m, mx), corr = __builtin_amdgcn_exp2f(m - mn); m = mn; lsum *= corr;
#pragma unroll
                for (int d = 0; d < NDB; ++d)
#pragma unroll
                    for (int i = 0; i < 16; ++i) o[d][i] *= corr;
            }
            float ps = 0.f;
#pragma unroll
            for (int i = 0; i < 16; ++i) { sc0[i] = __builtin_amdgcn_exp2f(sc0[i] - m); sc1[i] = __builtin_amdgcn_exp2f(sc1[i] - m); ps += sc0[i] + sc1[i]; }
            lsum += ps;
#pragma unroll
            for (int s2 = 0; s2 < 2; ++s2) { fv8 x0, x1;
#pragma unroll
                for (int j = 0; j < 8; ++j) { x0[j] = sc0[8 * s2 + j]; x1[j] = sc1[8 * s2 + j]; }
                pf[0][s2] = __builtin_bit_cast(bf16x8s, __builtin_convertvector(x0, bfv8)); pf[1][s2] = __builtin_bit_cast(bf16x8s, __builtin_convertvector(x1, bfv8)); }
        }
        __builtin_amdgcn_s_waitcnt(0xc07f);
        __builtin_amdgcn_s_barrier();
        if (need) {
            const LAS unsigned char* Vb = lds + OFF_V + (it & 1) * VB;
            s16x4 vt[2][NDB][2];
#define FA_VLOAD(slot, grp) do { _Pragma("unroll") for (int d_ = 0; d_ < NDB; ++d_) { const LAS unsigned char* vp_ = Vb + vread + (((grp) >> 1) * 32 + 16 * ((grp) & 1)) * RSV + d_ * 64; \
                vt[slot][d_][0] = __builtin_amdgcn_ds_read_tr16_b64_v4i16((LAS s16x4*)vp_); vt[slot][d_][1] = __builtin_amdgcn_ds_read_tr16_b64_v4i16((LAS s16x4*)(vp_ + 8 * RSV)); } } while (0)
            FA_VLOAD(0, 0);
            __builtin_amdgcn_sched_barrier(0);
#pragma unroll
            for (int grp = 0; grp < 4; ++grp) {
                if (grp + 1 < 4) FA_VLOAD((grp + 1) & 1, grp + 1);
                __builtin_amdgcn_sched_barrier(0);
#pragma unroll
                for (int d = 0; d < NDB; ++d) { const s16x4 t0 = vt[grp & 1][d][0], t1 = vt[grp & 1][d][1];
                    bf16x8s a; a[0] = t0[0]; a[1] = t0[1]; a[2] = t0[2]; a[3] = t0[3]; a[4] = t1[0]; a[5] = t1[1]; a[6] = t1[2]; a[7] = t1[3];
                    o[d] = __builtin_amdgcn_mfma_f32_32x32x16_bf16(a, pf[grp >> 1][grp & 1], o[d], 0, 0, 0); }
                __builtin_amdgcn_sched_barrier(0);
            }
#undef FA_VLOAD
        }
        { int kb2 = kb3 + 2; if (kb2 >= 3) kb2 -= 3;
          if (it + 2 < ntiles) FA_STOREK(kb2); }
        if (it + 1 < ntiles) FA_STOREV((it + 1) & 1);
        if (it + 3 < ntiles) FA_LOADK(t + 3);
        if (it + 2 < ntiles) FA_LOADV(t + 2);
        __syncthreads();
        kb3 = kb3 == 2 ? 0 : kb3 + 1;
    }
    if (wid < 4) __builtin_amdgcn_s_barrier();
#undef FA_LOADK
#undef FA_LOADV
#undef FA_STOREK
#undef FA_STOREV
#undef FA_NEED
}

constexpr int FA_OFF_T = 3 * FA_KB + 2 * 64 * (128 * 2 + 64);

template <int MODE>
__device__ __forceinline__ void fa_unit64(const Params& P, int l, int unit, LAS unsigned char* lds) {
    const bf16_t* p = (const bf16_t*)(kws() + WS_P);
    const int tid = otid(P.pad0), lane = tid & 63, wid = __builtin_amdgcn_readfirstlane(tid >> 6), r = lane & 31, hh = lane >> 5;
    int b, qblk, head = 0, hd = 0;
    const bf16_t *qbase, *kbase, *vbase; size_t ldk;
    if (MODE == 0) { qblk = unit & 7; head = (unit >> 3) & 15; b = unit >> 7; const int kvh = head >> 2;
        qbase = p + (size_t)(b * SEQ) * INC + C_WQ + head * 64; kbase = p + (size_t)(b * SEQ) * INC + C_WK + kvh * 64; vbase = p + (size_t)(b * SEQ) * INC + C_WV + kvh * 64; ldk = INC;
    } else { qblk = unit & 7; hd = (unit >> 3) & 3; b = unit >> 5; const bf16_t* kv = (const bf16_t*)(kws() + WS_KVMEM);
        qbase = p + (size_t)(b * SEQ) * INC + C_MQ + hd * 64; kbase = kv + (size_t)(b * NMEM) * 2048 + l * 512 + hd * 64; vbase = kbase + 256; ldk = 2048;
    }
    const int q0 = qblk * 256, qw = q0 + wid * 32, qi = qw + r;
    int tile0, ntiles;
    if (MODE == 0) { tile0 = q0 / 64 - 2; int tl = q0 / 64 + 5; if (tile0 < 0) tile0 = 0; if (tl > SEQ / 64 - 1) tl = SEQ / 64 - 1; ntiles = tl - tile0 + 1; }
    else { tile0 = 0; ntiles = NMEM / 64; }
    const LAS float* btab = (const LAS float*)(lds + FA_OFF_T) + head * FA_TS + FA_TP;
    f32x16 o[2];
#pragma unroll
    for (int d = 0; d < 2; ++d)
#pragma unroll
        for (int i = 0; i < 16; ++i) o[d][i] = 0.f;
    float m = -INFINITY, lsum = 0.f;
    if (MODE == 0) { m = kin(I_SINK)[l * 16 + head] * LOG2E; lsum = hh == 0 ? 1.0f : 0.0f; }
    fa_core<64, MODE>(lds, tid, qbase + (size_t)qi * INC, kbase, vbase, ldk, tile0, ntiles, qw, qi, btab, o, m, lsum);
    const float lt = lsum + shfl_xor_o(lsum, 32); const float inv = 1.0f / lt;
    const size_t tok = (size_t)b * SEQ + qi;
    bf16_t* yp = (bf16_t*)(kws() + WS_YCAT) + tok * BRK + (MODE == 0 ? 1024 + head * 64 : 3072 + hd * 64) + 4 * hh;
#pragma unroll
    for (int d = 0; d < 2; ++d)
#pragma unroll
        for (int g = 0; g < 4; ++g) { u32x2 w; w.x = cvt_pk_bf16(o[d][4 * g] * inv, o[d][4 * g + 1] * inv); w.y = cvt_pk_bf16(o[d][4 * g + 2] * inv, o[d][4 * g + 3] * inv); *(u32x2*)(yp + 32 * d + 8 * g) = w; }
}

__device__ __forceinline__ void fa_unit_win(const Params& P, int l, int unit, LAS unsigned char* lds) {
    const bf16_t* p = (const bf16_t*)(kws() + WS_P);
    const int tid = otid(P.pad0), lane = tid & 63, wid = __builtin_amdgcn_readfirstlane(tid >> 6), r = lane & 31, hh = lane >> 5;
    const int qb = unit & 31, kvh = (unit >> 5) & 3, b = unit >> 7;
    const int head = kvh * 4 + (wid >> 1);
    const int q0 = qb * 64, qw = q0 + (wid & 1) * 32, qi = qw + r;
    const bf16_t* qbase = p + (size_t)(b * SEQ) * INC + C_WQ + head * 64; const bf16_t* kbase = p + (size_t)(b * SEQ) * INC + C_WK + kvh * 64; const bf16_t* vbase = p + (size_t)(b * SEQ) * INC + C_WV + kvh * 64;
    int tile0 = q0 / 64 - 2, tl = q0 / 64 + 2; if (tile0 < 0) tile0 = 0; if (tl > SEQ / 64 - 1) tl = SEQ / 64 - 1; const int ntiles = tl - tile0 + 1;
    const LAS float* btab = (const LAS float*)(lds + FA_OFF_T) + head * FA_TS + FA_TP;
    f32x16 o[2];
#pragma unroll
    for (int d = 0; d < 2; ++d)
#pragma unroll
        for (int i = 0; i < 16; ++i) o[d][i] = 0.f;
    float m = kin(I_SINK)[l * 16 + head] * LOG2E, lsum = hh == 0 ? 1.0f : 0.0f;
    fa_core<64, 0>(lds, tid, qbase + (size_t)qi * INC, kbase, vbase, (size_t)INC, tile0, ntiles, qw, qi, btab, o, m, lsum);
    const float lt = lsum + shfl_xor_o(lsum, 32); const float inv = 1.0f / lt;
    const size_t tok = (size_t)b * SEQ + qi;
    bf16_t* yp = (bf16_t*)(kws() + WS_YCAT) + tok * BRK + 1024 + head * 64 + 4 * hh;
#pragma unroll
    for (int d = 0; d < 2; ++d)
#pragma unroll
        for (int g = 0; g < 4; ++g) { u32x2 w; w.x = cvt_pk_bf16(o[d][4 * g] * inv, o[d][4 * g + 1] * inv); w.y = cvt_pk_bf16(o[d][4 * g + 2] * inv, o[d][4 * g + 3] * inv); *(u32x2*)(yp + 32 * d + 8 * g) = w; }
}

__device__ __forceinline__ void fa_unit_diff(const Params& P, int l, int unit, LAS unsigned char* lds, float lam_full, float one_m_li) {
    const bf16_t* p = (const bf16_t*)(kws() + WS_P);
    const int tid = otid(P.pad0), lane = tid & 63, wid = __builtin_amdgcn_readfirstlane(tid >> 6), r = lane & 31, hh = lane >> 5;
    const int qblk = unit & 7, h = (unit >> 3) & 7, b = unit >> 6;
    const int q0 = qblk * 256, qw = q0 + wid * 32, qi = qw + r;
    const LAS float* btab = (const LAS float*)(lds + FA_OFF_T) + (16 + h) * FA_TS + FA_TP;
    const size_t tok = (size_t)b * SEQ + qi;
    const bf16_t* vbase = p + (size_t)(b * SEQ) * INC + C_DV + h * 128;
    float* dp = (float*)(kws() + WS_DTMP) + tok * 1024 + h * 128 + 4 * hh;
    for (int cc = 0; cc < 2; ++cc) {
        const bf16_t* qrow = p + tok * INC + C_DQ + h * 128 + cc * 64;
        const bf16_t* kbase = p + (size_t)(b * SEQ) * INC + C_DK + h * 128 + cc * 64;
        f32x16 o[4];
#pragma unroll
        for (int d = 0; d < 4; ++d)
#pragma unroll
            for (int i = 0; i < 16; ++i) o[d][i] = 0.f;
        float m = -INFINITY, lsum = 0.f;
        fa_core<128, 1>(lds, tid, qrow, kbase, vbase, (size_t)INC, 0, SEQ / 64, qw, qi, btab, o, m, lsum);
        const float lt = lsum + shfl_xor_o(lsum, 32); const float inv = 1.0f / lt;
        if (cc == 0) {
#pragma unroll
            for (int d = 0; d < 4; ++d)
#pragma unroll
                for (int g = 0; g < 4; ++g) { f32x4 v; v[0] = o[d][4 * g] * inv; v[1] = o[d][4 * g + 1] * inv; v[2] = o[d][4 * g + 2] * inv; v[3] = o[d][4 * g + 3] * inv; *(f32x4*)(dp + 32 * d + 8 * g) = v; }
        } else {
            float ssq = 0.f;
#pragma unroll
            for (int d = 0; d < 4; ++d)
#pragma unroll
                for (int g = 0; g < 4; ++g) { const f32x4 a = *(const f32x4*)(dp + 32 * d + 8 * g);
#pragma unroll
                    for (int e = 0; e < 4; ++e) { const float x = a[e] - lam_full * (o[d][4 * g + e] * inv); o[d][4 * g + e] = x; ssq += x * x; } }
            ssq += shfl_xor_o(ssq, 32);
            const float rs = rsqrtf(ssq * (1.0f / 128.0f) + 1e-5f) * one_m_li;
            bf16_t* yp = (bf16_t*)(kws() + WS_YCAT) + tok * BRK + 2048 + h * 128 + 4 * hh;
            const float* sg = kin(I_SUBLN) + l * 128 + 4 * hh;
#pragma unroll
            for (int d = 0; d < 4; ++d)
#pragma unroll
                for (int g = 0; g < 4; ++g) { const f32x4 gv = *(const f32x4*)(sg + 32 * d + 8 * g);
                    u32x2 w; w.x = cvt_pk_bf16(o[d][4 * g] * rs * gv[0], o[d][4 * g + 1] * rs * gv[1]); w.y = cvt_pk_bf16(o[d][4 * g + 2] * rs * gv[2], o[d][4 * g + 3] * rs * gv[3]);
                    *(u32x2*)(yp + 32 * d + 8 * g) = w; }
        }
    }
}
__device__ __forceinline__ void phase_attn_mfma(const Params& P, int l, LAS unsigned char* lds) {
    const int tid0 = otid(P.pad0), lane = tid0 & 63;
    { float* bt = (float*)(lds + FA_OFF_T); const float* relb = kin(I_RELB); constexpr int NE = 259 + 2 * FA_TP;
      for (int i = tid0; i < 24 * NE; i += NTHR) { const int hq = i / NE, j = i - hq * NE, rel = j - FA_TP - 129; const int rc = rel < -128 ? -128 : (rel > 128 ? 128 : rel);
          const float v = relb[t5_bucket(rc) * 24 + hq] * LOG2E; bt[hq * FA_TS + j] = (hq < 16 && (rel < -128 || rel > 128)) ? -INFINITY : v; } }
    __syncthreads();
    const float* lam = kin(I_LAM) + l * 256;
    const float l1 = wave_sum(lam[lane] * lam[64 + lane]), l2 = wave_sum(lam[128 + lane] * lam[192 + lane]);
    const float lambda_init = 0.8f - 0.6f * expf(-0.3f * (float)l);
    const float lam_full = expf(l1) - expf(l2) + lambda_init;
    const int G = gridDim.x, c = blockIdx.x;
    if ((G & 7) == 0 && G >= 8) {
        const int x = c & 7, j = c >> 3, W = G >> 3;
        for (int lu = j; lu < 64; lu += W) { const int pair = x * 8 + (lu >> 3); fa_unit_diff(P, l, (pair << 3) | (lu & 7), lds, lam_full, 1.0f - lambda_init); }
        for (int lu = j; lu < 128; lu += W) { const int grp = x * 4 + (lu >> 5), g = (lu >> 3) & 3, qb = lu & 7; const int b = grp >> 2, kvh = grp & 3;
            fa_unit64<0>(P, l, (b << 7) | ((kvh * 4 + g) << 3) | qb, lds); }
        for (int lu = j; lu < 32; lu += W) { const int grp = x * 4 + (lu >> 3); fa_unit64<2>(P, l, (grp << 3) | (lu & 7), lds); }
    } else {
        for (int u = c; u < 512; u += G) fa_unit_diff(P, l, u, lds, lam_full, 1.0f - lambda_init);
        for (int u = c; u < 1024; u += G) fa_unit_win(P, l, u, lds);
        for (int u = c; u < 256; u += G) fa_unit64<2>(P, l, u, lds);
    }
}

#ifndef STAMP_SCAN
#define STAMP_SCAN 0
#endif
constexpr int CRP = 144, CIMG = 64 * CRP;
enum { SL_KQ = 0, SL_RQ, SL_AK, SL_DK, SL_VV, SL_B, SL_M2, SL_N1, SL_N2, SL_A, SL_C, SL_D, SL_X1, SL_S0, SL_S1, SL_COUNT };
constexpr int CS_GC = SL_COUNT * CIMG;
constexpr int CS_CONST = CS_GC + 256;
constexpr int CS_LD = SL_A * CIMG;
constexpr int CS_SEG = CS_LD + 64 * 64 * 4;

__device__ __forceinline__ int cs_off_row(int tile, int lane) { return (32 * tile + (lane & 31)) * CRP + 16 * (lane >> 5); }
__device__ __forceinline__ int cs_off_tr(int tile, int lane) { return (8 * (lane >> 5) + ((lane & 15) >> 2)) * CRP + (32 * tile + 16 * ((lane >> 4) & 1) + 4 * (lane & 3)) * 2; }
__device__ __forceinline__ int cs_off_cm(int ti, int tj, int lane) { return (32 * tj + (lane & 31)) * CRP + (32 * ti + 4 * (lane >> 5)) * 2; }
__device__ __forceinline__ bf16x8s cs_rowfrag(const LAS unsigned char* img, int off, int s) { return *(const LAS bf16x8s*)(img + off + 32 * s); }
__device__ __forceinline__ bf16x8s cs_trfrag(const LAS unsigned char* img, int off, int s) {
    const LAS unsigned char* a = img + off + 16 * s * CRP;
    const s16x4 t0 = __builtin_amdgcn_ds_read_tr16_b64_v4i16((LAS s16x4*)a), t1 = __builtin_amdgcn_ds_read_tr16_b64_v4i16((LAS s16x4*)(a + 4 * CRP));
    bf16x8s f; f[0] = t0[0]; f[1] = t0[1]; f[2] = t0[2]; f[3] = t0[3]; f[4] = t1[0]; f[5] = t1[1]; f[6] = t1[2]; f[7] = t1[3];
    return f;
}
template <bool ATR, bool BTR>
__device__ __forceinline__ f32x16 cs_mm(f32x16 acc, const LAS unsigned char* Ai, int aoff, const LAS unsigned char* Bi, int boff) {
    bf16x8s a[4], b[4];
#pragma unroll
    for (int s = 0; s < 4; ++s) { a[s] = ATR ? cs_trfrag(Ai, aoff, s) : cs_rowfrag(Ai, aoff, s); b[s] = BTR ? cs_trfrag(Bi, boff, s) : cs_rowfrag(Bi, boff, s); }
    __builtin_amdgcn_sched_barrier(0);
#pragma unroll
    for (int s = 0; s < 4; ++s) acc = __builtin_amdgcn_mfma_f32_32x32x16_bf16(a[s], b[s], acc, 0, 0, 0);
    return acc;
}
__device__ __forceinline__ void cs_store_cm(LAS unsigned char* img, int off, const f32x16& acc) {
#pragma unroll
    for (int g = 0; g < 4; ++g) { fv8 x; x[0] = acc[4 * g]; x[1] = acc[4 * g + 1]; x[2] = acc[4 * g + 2]; x[3] = acc[4 * g + 3]; x[4] = 0.f; x[5] = 0.f; x[6] = 0.f; x[7] = 0.f;
        const bf16x8s y = __builtin_bit_cast(bf16x8s, __builtin_convertvector(x, bfv8)); s16x4 w; w[0] = y[0]; w[1] = y[1]; w[2] = y[2]; w[3] = y[3];
        *(LAS s16x4*)(img + off + 16 * g) = w; }
}
__device__ __forceinline__ f32x16 cs_load_cm(const LAS unsigned char* img, int off) {
    f32x16 v;
#pragma unroll
    for (int g = 0; g < 4; ++g) { const u32x2 w = *(const LAS u32x2*)(img + off + 16 * g);
        v[4 * g] = bflo(w.x); v[4 * g + 1] = bfhi(w.x); v[4 * g + 2] = bflo(w.y); v[4 * g + 3] = bfhi(w.y); }
    return v;
}
__device__ __forceinline__ f32x16 cs_zero() { f32x16 z;
#pragma unroll
    for (int i = 0; i < 16; ++i) z[i] = 0.f;
    return z; }

__device__ __forceinline__ void phase_scan_chunked(const Params& P, int l, LAS unsigned char* lds) {
    const bf16_t* p = (const bf16_t*)(kws() + WS_P); const bf16_t* lora = (const bf16_t*)(kws() + WS_LORA);
    bf16_t* ydir = (bf16_t*)(kws() + WS_YDIR); float* bonus = (float*)(kws() + WS_BONUS);
    const int tid = otid(P.pad0), lane = tid & 63, wid = __builtin_amdgcn_readfirstlane(tid >> 6), r = lane & 31, hh = lane >> 5;
    const int pt = tid >> 3, pc8 = tid & 7;
    const int w4 = wid & 3, ti = w4 >> 1, tj = w4 & 1;
    const bool grpA = wid < 4;
#define IMG(s) (lds + (s) * CIMG)
    LAS float* LD = (LAS float*)(lds + CS_LD); LAS float* SEG = (LAS float*)(lds + CS_SEG); LAS float* GC = (LAS float*)(lds + CS_GC); LAS float* CN = (LAS float*)(lds + CS_CONST);
    for (int u = blockIdx.x; u < 256; u += gridDim.x) {
        const int z = u & 1, h = (u >> 1) & 15, b = u >> 5;
        const int c8 = h * 64 + pc8 * 8;
        const float* mu = kin(I_MU) + (size_t)l * 2 * RWC;
        __syncthreads();
        for (int i = tid; i < 9 * 64; i += NTHR) { const int vq = i >> 6, ch = i & 63, cch = h * 64 + ch; float v;
            if (vq < 3) v = mu[vq * 1024 + cch]; else if (vq < 6) v = mu[RWC + (vq - 3) * 1024 + cch]; else if (vq == 6) v = kin(I_KK)[l * 1024 + cch]; else if (vq == 7) v = kin(I_KA)[l * 1024 + cch]; else v = kin(I_RK)[l * 1024 + cch];
            CN[i] = v; }
        { LAS unsigned char* s0 = IMG(SL_S0); for (int i = tid; i < CIMG / 16; i += NTHR) *(LAS u32x4*)(s0 + i * 16) = (u32x4){0u, 0u, 0u, 0u}; }
        u32x4 rw[3][3], lw[2];
#define CS_LOAD(n) do { const int i_ = (n) * 64 + pt; const int t_ = z ? (SEQ - 1) - i_ : i_; const bf16_t* pr_ = p + (size_t)(b * SEQ + t_) * INC + c8; \
        const bool okp_ = t_ > 0, okn_ = t_ < SEQ - 1; const u32x4 zz_ = {0u, 0u, 0u, 0u}; \
        _Pragma("unroll") for (int x_ = 0; x_ < 3; ++x_) { rw[x_][0] = *(const u32x4*)(pr_ + x_ * 1024); rw[x_][1] = okp_ ? *(const u32x4*)(pr_ - INC + x_ * 1024) : zz_; rw[x_][2] = okn_ ? *(const u32x4*)(pr_ + INC + x_ * 1024) : zz_; } \
        const bf16_t* lr_ = lora + (size_t)(b * SEQ + t_) * LORA_N + z * 1024 + c8; lw[0] = *(const u32x4*)lr_; lw[1] = *(const u32x4*)(lr_ + 2048); } while (0)
        CS_LOAD(0);
        f32x16 accR = cs_zero();
        for (int n = 0; n < SEQ / 64; ++n) {
#if STAMP_SCAN
            const unsigned ts0 = (unsigned)__builtin_readcyclecounter();
#endif
            const int sOld = (n & 1) ? SL_S1 : SL_S0, sNew = (n & 1) ? SL_S0 : SL_S1;
            int rowI = cs_off_row(ti, lane), rowJ = cs_off_row(tj, lane), trI = cs_off_tr(ti, lane), trJ = cs_off_tr(tj, lane), cmO = cs_off_cm(ti, tj, lane);
            asm volatile("" : "+v"(rowI), "+v"(rowJ), "+v"(trI), "+v"(trJ), "+v"(cmO));
            { float ldv[8];
#pragma unroll
              for (int q = 0; q < 2; ++q) { const unsigned l0 = q ? lw[0].z : lw[0].x, l1 = q ? lw[0].w : lw[0].y; ldv[4 * q] = bflo(l0); ldv[4 * q + 1] = bfhi(l0); ldv[4 * q + 2] = bflo(l1); ldv[4 * q + 3] = bfhi(l1); }
              LAS float* ldp = LD + pt * 64 + pc8 * 8;
              *(LAS f32x4*)ldp = (f32x4){ldv[0], ldv[1], ldv[2], ldv[3]}; *(LAS f32x4*)(ldp + 4) = (f32x4){ldv[4], ldv[5], ldv[6], ldv[7]}; }
            __syncthreads();
            { const int k = tid & 63, seg = tid >> 6; float c[8]; float run = 0.f;
#pragma unroll
              for (int j = 0; j < 8; ++j) { run += LD[(seg * 8 + j) * 64 + k]; c[j] = run; }
              SEG[seg * 64 + k] = run;
              __syncthreads();
              float pre = 0.f;
#pragma unroll
              for (int s = 0; s < 7; ++s) pre += (s < seg) ? SEG[s * 64 + k] : 0.f;
#pragma unroll
              for (int j = 0; j < 8; ++j) LD[(seg * 8 + j) * 64 + k] = pre + c[j];
            }
            __syncthreads();
            { const int i = n * 64 + pt, tok = b * SEQ + (z ? (SEQ - 1) - i : i);
              float xs[3][8];
#pragma unroll
              for (int x = 0; x < 3; ++x)
#pragma unroll
                  for (int q = 0; q < 2; ++q) {
                      const unsigned c0 = q ? rw[x][0].z : rw[x][0].x, c1 = q ? rw[x][0].w : rw[x][0].y, p0 = q ? rw[x][1].z : rw[x][1].x, p1 = q ? rw[x][1].w : rw[x][1].y, n0 = q ? rw[x][2].z : rw[x][2].x, n1 = q ? rw[x][2].w : rw[x][2].y;
                      f32x4 c, pv, nx; c[0] = bflo(c0); c[1] = bfhi(c0); c[2] = bflo(c1); c[3] = bfhi(c1); pv[0] = bflo(p0); pv[1] = bfhi(p0); pv[2] = bflo(p1); pv[3] = bfhi(p1); nx[0] = bflo(n0); nx[1] = bfhi(n0); nx[2] = bflo(n1); nx[3] = bfhi(n1);
                      const f32x4 m0 = *(const LAS f32x4*)(CN + x * 64 + pc8 * 8 + 4 * q), m1 = *(const LAS f32x4*)(CN + (3 + x) * 64 + pc8 * 8 + 4 * q);
                      const f32x4 o = c + m0 * (pv - c) + m1 * (nx - c);
                      xs[x][4 * q] = o[0]; xs[x][4 * q + 1] = o[1]; xs[x][4 * q + 2] = o[2]; xs[x][4 * q + 3] = o[3]; }
              float av[8], ckk[8], cka[8], crk[8];
#pragma unroll
              for (int q = 0; q < 2; ++q) { const unsigned a0 = q ? lw[1].z : lw[1].x, a1 = q ? lw[1].w : lw[1].y;
                  av[4 * q] = bflo(a0); av[4 * q + 1] = bfhi(a0); av[4 * q + 2] = bflo(a1); av[4 * q + 3] = bfhi(a1);
                  const f32x4 t6 = *(const LAS f32x4*)(CN + 6 * 64 + pc8 * 8 + 4 * q), t7 = *(const LAS f32x4*)(CN + 7 * 64 + pc8 * 8 + 4 * q), t8 = *(const LAS f32x4*)(CN + 8 * 64 + pc8 * 8 + 4 * q);
#pragma unroll
                  for (int e = 0; e < 4; ++e) { ckk[4 * q + e] = t6[e]; cka[4 * q + e] = t7[e]; crk[4 * q + e] = t8[e]; } }
              float kk[8], kd[8]; float ss = 0.f, bq = 0.f;
#pragma unroll
              for (int j = 0; j < 8; ++j) { const float kx = xs[1][j]; const float kraw = kx * ckk[j]; kk[j] = kraw; ss += kraw * kraw;
                  kd[j] = kx * (1.0f + (av[j] - 1.0f) * cka[j]); bq += xs[0][j] * kd[j] * crk[j]; }
              ss = sum8(ss); bq = sum8(bq);
              const float rn = rsqrtf(fmaxf(ss, 1e-12f));
              if (pc8 == 0) bonus[((size_t)z * NTOK + tok) * 16 + h] = bq;
              const LAS float* cu = LD + pt * 64 + pc8 * 8;
              float cum[8], cup[8];
#pragma unroll
              for (int q = 0; q < 2; ++q) { const f32x4 a = *(const LAS f32x4*)(cu + 4 * q); cum[4 * q] = a[0]; cum[4 * q + 1] = a[1]; cum[4 * q + 2] = a[2]; cum[4 * q + 3] = a[3];
                  f32x4 bpv = {0.f, 0.f, 0.f, 0.f}; if (pt > 0) bpv = *(const LAS f32x4*)(cu - 64 + 4 * q); cup[4 * q] = bpv[0]; cup[4 * q + 1] = bpv[1]; cup[4 * q + 2] = bpv[2]; cup[4 * q + 3] = bpv[3]; }
              fv8 okq, orq, oak, odk, ovv;
#pragma unroll
              for (int j = 0; j < 8; ++j) { const float gt = __expf(cum[j]), gp = __expf(cup[j]), gi = __builtin_amdgcn_rcpf(gt); const float kkn = kk[j] * rn;
                  okq[j] = kkn * gp; orq[j] = xs[0][j] * gt; oak[j] = av[j] * kkn * gi; odk[j] = kd[j] * gi; ovv[j] = xs[2][j];
                  if (pt == 63) GC[pc8 * 8 + j] = gt; }
              const int off = pt * CRP + pc8 * 16;
              *(LAS bfv8*)(IMG(SL_KQ) + off) = __builtin_convertvector(okq, bfv8); *(LAS bfv8*)(IMG(SL_RQ) + off) = __builtin_convertvector(orq, bfv8);
              *(LAS bfv8*)(IMG(SL_AK) + off) = __builtin_convertvector(oak, bfv8); *(LAS bfv8*)(IMG(SL_DK) + off) = __builtin_convertvector(odk, bfv8);
              *(LAS bfv8*)(IMG(SL_VV) + off) = __builtin_convertvector(ovv, bfv8);
            }
            __syncthreads();
            if (n + 1 < SEQ / 64) CS_LOAD(n + 1);
#if STAMP_SCAN
            const unsigned ts1 = (unsigned)__builtin_readcyclecounter();
#endif
            { const int pr = wid >> 1; const LAS unsigned char* Ai = IMG(pr < 2 ? SL_KQ : SL_RQ); const LAS unsigned char* Bi = IMG((pr & 1) ? SL_DK : SL_AK);
              LAS unsigned char* Oi = IMG(pr == 0 ? SL_B : (pr == 1 ? SL_M2 : (pr == 2 ? SL_N1 : SL_N2)));
#pragma unroll
              for (int q = 0; q < 2; ++q) { const int ti1 = wid & 1, tj1 = q;
                  f32x16 acc = cs_mm<false, false>(cs_zero(), Ai, cs_off_row(ti1, lane), Bi, cs_off_row(tj1, lane));
                  f32x16 t1;
#pragma unroll
                  for (int i = 0; i < 16; ++i) { const int m = 32 * ti1 + (i & 3) + 8 * (i >> 2) + 4 * hh, nn = 32 * tj1 + r; const bool keep = pr < 2 ? (nn < m) : (nn <= m);
                      acc[i] = keep ? acc[i] : 0.f; t1[i] = (m == nn ? 1.0f : 0.0f) - acc[i]; }
                  cs_store_cm(Oi, cs_off_cm(ti1, tj1, lane), acc);
                  if (pr == 0) cs_store_cm(IMG(SL_C), cs_off_cm(ti1, tj1, lane), t1); } }
            __syncthreads();
            if (grpA) { const f32x16 acc = cs_mm<true, false>(cs_zero(), IMG(SL_B), trI, IMG(SL_B), rowJ); cs_store_cm(IMG(SL_A), cmO, acc); }
            else { const f32x16 acc = cs_mm<true, true>(cs_zero(), IMG(SL_M2), trI, IMG(SL_VV), trJ); cs_store_cm(IMG(SL_X1), cmO, acc); }
            __syncthreads();
#pragma unroll
            for (int st = 0; st < 5; ++st) {
                const int qs = (st & 1) ? SL_B : SL_A, qd = (st & 1) ? SL_A : SL_B, ts = (st & 1) ? SL_D : SL_C, td = (st & 1) ? SL_C : SL_D;
                if (grpA) { if (st < 4) { const f32x16 acc = cs_mm<true, false>(cs_zero(), IMG(qs), trI, IMG(qs), rowJ); cs_store_cm(IMG(qd), cmO, acc); } }
                else { const f32x16 acc = cs_mm<true, false>(cs_load_cm(IMG(ts), cmO), IMG(ts), trI, IMG(qs), rowJ); cs_store_cm(IMG(td), cmO, acc); }
                __syncthreads();
            }
            if (grpA) { const f32x16 acc = cs_mm<true, true>(cs_zero(), IMG(SL_D), trI, IMG(SL_KQ), trJ); cs_store_cm(IMG(SL_A), cmO, acc); }
            else { const f32x16 acc = cs_mm<true, false>(cs_zero(), IMG(SL_D), trI, IMG(SL_X1), rowJ); cs_store_cm(IMG(SL_B), cmO, acc); }
            __syncthreads();
            if (grpA) { f32x16 acc = cs_mm<false, true>(cs_zero(), IMG(SL_A), rowI, IMG(SL_N1), trJ);
                const f32x16 rq = cs_load_cm(IMG(SL_RQ), cmO);
                acc = rq - acc;
                cs_store_cm(IMG(SL_M2), cmO, acc); }
            else { const f32x16 a1 = cs_mm<true, true>(cs_zero(), IMG(SL_VV), trI, IMG(SL_N2), trJ); const f32x16 a2 = cs_mm<false, true>(cs_zero(), IMG(SL_B), rowI, IMG(SL_N1), trJ); accR = a1 - a2; }
            if (!grpA) { f32x16 acc = cs_mm<false, true>(cs_zero(), IMG(SL_A), rowI, IMG(SL_AK), trJ); const float gc = GC[32 * tj + r];
#pragma unroll
                for (int i = 0; i < 16; ++i) { const int m = 32 * ti + (i & 3) + 8 * (i >> 2) + 4 * hh, nn = 32 * tj + r; acc[i] = ((m == nn ? 1.0f : 0.0f) - acc[i]) * gc; }
                cs_store_cm(IMG(SL_C), cmO, acc); }
            else { const f32x16 a1 = cs_mm<true, true>(cs_zero(), IMG(SL_DK), trI, IMG(SL_VV), trJ); const f32x16 a2 = cs_mm<true, false>(cs_zero(), IMG(SL_AK), trI, IMG(SL_B), rowJ);
#pragma unroll
                for (int g = 0; g < 4; ++g) { const f32x4 gcv = *(const LAS f32x4*)(GC + 32 * ti + 8 * g + 4 * hh);
#pragma unroll
                    for (int e = 0; e < 4; ++e) accR[4 * g + e] = (a1[4 * g + e] - a2[4 * g + e]) * gcv[e]; } }
            __syncthreads();
            if (grpA) { accR = cs_mm<false, false>(accR, IMG(SL_C), rowI, IMG(sOld), rowJ); cs_store_cm(IMG(sNew), cmO, accR); }
            else { accR = cs_mm<false, false>(accR, IMG(sOld), rowI, IMG(SL_M2), rowJ);
                const int t = 32 * tj + r, ii = n * 64 + t; const int tk = z ? (SEQ - 1) - ii : ii;
                bf16_t* yp = ydir + ((size_t)z * NTOK + b * SEQ + tk) * DM + h * 64 + 32 * ti + 4 * hh;
#pragma unroll
                for (int g = 0; g < 4; ++g) { fv8 x; x[0] = accR[4 * g]; x[1] = accR[4 * g + 1]; x[2] = accR[4 * g + 2]; x[3] = accR[4 * g + 3]; x[4] = 0.f; x[5] = 0.f; x[6] = 0.f; x[7] = 0.f;
                    const bf16x8s y8 = __builtin_bit_cast(bf16x8s, __builtin_convertvector(x, bfv8)); s16x4 w; w[0] = y8[0]; w[1] = y8[1]; w[2] = y8[2]; w[3] = y8[3];
                    *(s16x4*)(yp + 8 * g) = w; } }
            __syncthreads();
#if STAMP_SCAN
            { const unsigned ts2 = (unsigned)__builtin_readcyclecounter(); if (blockIdx.x == 0 && tid == 0) { unsigned* acc = (unsigned*)(kws() + 8192);
                acc[0] += (STAMP_SCAN == 1 ? (ts1 - ts0) : (STAMP_SCAN == 2 ? (ts2 - ts1) : (ts2 - ts0))); } }
#endif
        }
#undef CS_LOAD
    }
#undef IMG
}
#define XB_TMO      128
#define XB_XCNT(j)  (256  + 64 * (j))
#define XB_XSUB(j)  (1280 + 64 * (j))
#define XB_XGEN(j)  (2304 + 64 * (j))
#define XB_TOP      3328
#define XB_TOPGEN   3392
#define XCD_BAR_WORDS 3456
#define XB_SPIN_CAP (1u << 20)

__device__ __forceinline__ unsigned xb_ld(unsigned* p)              { return __hip_atomic_load(p, __ATOMIC_RELAXED, __HIP_MEMORY_SCOPE_AGENT); }
__device__ __forceinline__ unsigned xb_add(unsigned* p, unsigned v) { return __hip_atomic_fetch_add(p, v, __ATOMIC_RELAXED, __HIP_MEMORY_SCOPE_AGENT); }
__device__ __forceinline__ unsigned xb_xcc_id() { return (unsigned)__builtin_amdgcn_s_getreg((3 << 11) | 20) & 0xFu; }
#define XB_SPIN(cond, bar) do { unsigned _sp = 0; while (cond) { __builtin_amdgcn_s_sleep(1); \
    if ((++_sp & 255u) == 0u) { if (xb_ld(&(bar)[XB_TMO])) break; if (_sp > XB_SPIN_CAP) { atomicAdd(&(bar)[XB_TMO], 1u); break; } } } } while (0)

struct XcdBarrier {
    unsigned* bar; unsigned x; int wv;
    volatile LAS unsigned* st;
};

__device__ __forceinline__ XcdBarrier xcd_barrier_post(unsigned* bar, volatile LAS unsigned* st) {
    XcdBarrier b; b.bar = bar; b.x = xb_xcc_id(); b.st = st;
    if (threadIdx.x == 0) (void)xb_add(&bar[XB_XCNT(b.x)], 1u);
    return b;
}
__device__ __forceinline__ void xcd_barrier_complete(unsigned* bar, unsigned x, unsigned& nloc, unsigned& nx) {
    const unsigned G = gridDim.x * gridDim.y * gridDim.z;
    unsigned sum, cnt, mine, sp = 0u;
    for (;;) {
        sum = 0u; cnt = 0u; mine = 0u;
#pragma unroll
        for (unsigned j = 0; j < 16; ++j) { const unsigned c = xb_ld(&bar[XB_XCNT(j)]); sum += c; cnt += (c > 0u) ? 1u : 0u; mine = (j == x) ? c : mine; }
        if (sum == G) break;
        __builtin_amdgcn_s_sleep(1);
        if ((++sp & 255u) == 0u) { if (xb_ld(&bar[XB_TMO])) break; if (sp > XB_SPIN_CAP) { atomicAdd(&bar[XB_TMO], 1u); break; } }
    }
    nloc = mine > 0u ? mine : 1u; nx = cnt > 0u ? cnt : 1u;
}

__device__ __forceinline__ void xcd_barrier(const XcdBarrier& b) {
    asm volatile("s_waitcnt vmcnt(0)" ::: "memory");
    __syncthreads();
    unsigned xz_ = 0u; asm volatile("" : "+v"(xz_));
    if (b.wv == 0 && __builtin_amdgcn_mbcnt_hi(~0u, __builtin_amdgcn_mbcnt_lo(~0u, xz_)) == 0u) {
        unsigned* bar = b.bar; asm volatile("" : "+s"(bar));
        __builtin_amdgcn_s_waitcnt(0);
        unsigned nloc = b.st[0], nx = b.st[1];
        if (nloc == 0u) { xcd_barrier_complete(bar, b.x, nloc, nx); b.st[0] = nloc; b.st[1] = nx; }
        const unsigned old = xb_add(&bar[XB_XSUB(b.x)], 1u);
        const unsigned gen = old / nloc;
        if (old + 1u == (gen + 1u) * nloc) {
            __builtin_amdgcn_fence(__ATOMIC_RELEASE, "agent");
            asm volatile("s_waitcnt vmcnt(0)" ::: "memory");
            const unsigned og = xb_add(&bar[XB_TOP], 1u);
            const unsigned tg = og / nx;
            if (og + 1u == (tg + 1u) * nx) xb_add(&bar[XB_TOPGEN], 1u);
            else XB_SPIN(xb_ld(&bar[XB_TOPGEN]) == tg, bar);
            __builtin_amdgcn_fence(__ATOMIC_ACQUIRE, "agent");
            xb_add(&bar[XB_XGEN(b.x)], 1u);
            asm volatile("s_waitcnt vmcnt(0)" ::: "memory");
        } else {
            XB_SPIN(xb_ld(&bar[XB_XGEN(b.x)]) == gen, bar);
            __builtin_amdgcn_fence(__ATOMIC_ACQUIRE, "agent");
            asm volatile("s_waitcnt vmcnt(0)" ::: "memory");
        }
    }
    __syncthreads();
}


template <class Epi, class Sched>
__device__ __forceinline__ void run_gemm(int wv, LAS unsigned char* lds, const bf16_t* A, int lda, const bf16_t* Bt, int ldb, int M, int N, int K, const Sched& S, const Epi& E, int pshift = 30, int pmask = -1, int koff = 0, int alt_from = 1 << 30, int nt_alt = 0) {
    asm volatile("" : "+s"(K));
    Gemm g; g.A = A; g.Bt = Bt; g.M = M; g.N = N; g.K = K; g.lda = lda; g.ldb = ldb; g.wv = wv; g.sa = 0; g.sb = 0; g.pshift = pshift; g.pmask = pmask; g.koff = koff; g.alt_from = alt_from; g.nt_alt = nt_alt;
    pg8::gemm_phase<Epi, Sched, false>(lds, g, S, E, nullptr);
}
template <class Epi, class Sched>
__device__ __forceinline__ void run_gemm_f8(int wv, LAS unsigned char* lds, const unsigned char* A, int lda, const unsigned char* Bt, int ldb, int M, int N, int K, int sa, int sb, const Sched& S, const Epi& E) {
    asm volatile("" : "+s"(K));
    Gemm g; g.A = (const bf16_t*)A; g.Bt = (const bf16_t*)Bt; g.M = M; g.N = N; g.K = K; g.lda = lda; g.ldb = ldb; g.wv = wv; g.sa = sa; g.sb = sb; g.pshift = 30; g.pmask = -1; g.koff = 0; g.alt_from = 1 << 30; g.nt_alt = 0;
    pg8::gemm_phase_f8<Epi, Sched, false>(lds, g, S, E, nullptr);
}

#ifndef EN_MASK
#define EN_MASK 0xFFFFFFFFu
#endif
#define EN_PH(k) ((EN_MASK >> (k)) & 1u)
#ifndef PROBE_REP
#define PROBE_REP (-1)
#endif
#ifndef PROBE_MASK
#define PROBE_MASK 0u
#endif
#define REP(k) for (int rep_ = 0; rep_ < (((PROBE_REP == (k)) || ((k) < 32 && ((PROBE_MASK >> ((k) & 31)) & 1u))) ? 2 : 1); ++rep_)
constexpr int NPH_PRO = 2, NPH_LAYER = 12, NPH_TOTAL = NPH_PRO + DEPTH * NPH_LAYER;

__global__ void __launch_bounds__(512, 2) mega(Params Pk) {
    Params P = Pk; P.pad0 = __builtin_amdgcn_readfirstlane((int)threadIdx.x >> 6);
    extern __shared__ __attribute__((aligned(16))) unsigned char shm[];
    float* ldsf = (float*)shm;
    LAS unsigned char* ldsl = (LAS unsigned char*)shm;
    unsigned char* ws = kws();
    const int G = gridDim.x, c = blockIdx.x;
    XcdBarrier bar;
    if (P.fused) {
        volatile LAS unsigned* st = (volatile LAS unsigned*)(ldsl + LDS_BYTES - 16);
        if (threadIdx.x == 0) { st[0] = 0u; st[1] = 0u; st[2] = 0u; st[3] = 0u; }
        __syncthreads();
        bar = xcd_barrier_post((unsigned*)(ws + WS_CTL), st); bar.wv = P.pad0;
    }
    int ph = 0;
#define PH_BEGIN if (ph >= P.ph_lo && ph < P.ph_hi) {
#ifndef BAR_TWICE
#define BAR_TWICE 0
#endif
#define PH_END_  if (P.fused) { xcd_barrier(bar); if (BAR_TWICE) xcd_barrier(bar); } else __syncthreads(); } ++ph;

    PH_BEGIN
#if EN_PH(0)
REP(0) { if (rep_) __syncthreads();
phase_convert(P, ldsf);
}
#endif
 PH_END_
    PH_BEGIN
#if EN_PH(1)
REP(1) { if (rep_) __syncthreads();
{ pg8::StaticOrder S; S.init(NBATCH * NMEM, DEPTH * 512, G, c); EpiBf16Store E; E.O = (bf16_t*)(ws + WS_KVMEM); E.ldc = DEPTH * 512; E.st = ldsl + 131072; E.GP = nullptr;
        run_gemm(P.pad0, ldsl, (const bf16_t*)(ws + WS_MEMB), DM, (const bf16_t*)(ws + WS_WKV), DM, NBATCH * NMEM, DEPTH * 512, DM, S, E); }
}
#endif
 PH_END_

    for (int l = 0; l < DEPTH; ++l) {
        PH_BEGIN
#if EN_PH(2)
REP(2) { if (rep_) __syncthreads();
{ pg8::StaticOrder S; S.init(NTOK, INC, G, c); EpiBf16Store E; E.O = (bf16_t*)(ws + WS_P); E.ldc = INC; E.st = ldsl + 131072; E.GP = (bf16_t*)(ws + WS_GATEP);
            run_gemm(P.pad0, ldsl, (const bf16_t*)(ws + WS_XB), DM, (const bf16_t*)(ws + WS_WIN) + (size_t)l * INC * DM, DM, NTOK, INC, DM, S, E); }
}
#endif
 PH_END_
        PH_BEGIN
#if EN_PH(3)
REP(3) { if (rep_) __syncthreads();
phase_prepass(P, l);
}
#endif
 PH_END_
        PH_BEGIN
#if EN_PH(4)
REP(4) { if (rep_) __syncthreads();
{ pg8::StaticOrder S; S.init(NTOK, LORA_N, G, c); EpiLora E; E.O = (bf16_t*)(ws + WS_LORA); E.w0 = kin(I_W0) + l * 2048; E.a0 = kin(I_A0) + l * 2048;
            run_gemm(P.pad0, ldsl, (const bf16_t*)(ws + WS_APR), 256, (const bf16_t*)(ws + WS_WLORA) + (size_t)l * LORA_N * 256, 256, NTOK, LORA_N, 128, S, E, 4, -1, 256); }
}
#endif
 PH_END_
        PH_BEGIN
#if EN_PH(5)
REP(5) { if (rep_) __syncthreads();
REP(100) { if (rep_) __syncthreads(); phase_scan_chunked(P, l, ldsl); }
        REP(101) { if (rep_) __syncthreads(); phase_attn_mfma(P, l, ldsl); }
}
#endif
 PH_END_
        PH_BEGIN
#if EN_PH(6)
REP(6) { if (rep_) __syncthreads();
phase_post(P, l);
}
#endif
 PH_END_
        PH_BEGIN
#if EN_PH(7)
REP(7) { if (rep_) __syncthreads();
{ BranchOrder S; S.init(NTOK, DM, G, c);
            const bf16_t* ycat = (const bf16_t*)(ws + WS_YCAT); const bf16_t* wbr = (const bf16_t*)(ws + WS_WBR) + (size_t)l * DM * BRK;
            EpiBranchAll E; E.gateP = (const bf16_t*)(ws + WS_GATEP); E.mbP = (bf16_t*)(ws + WS_MBP); E.mb = (bf16_t*)(ws + WS_MB); E.st = ldsl + 131072;
            run_gemm(P.pad0, ldsl, ycat, BRK, wbr, BRK, NTOK, DM, 1024, S, E, 2, 3, 2048, 3, 4); }
}
#endif
 PH_END_
        PH_BEGIN
#if EN_PH(8)
REP(8) { if (rep_) __syncthreads();
{ pg8::StaticOrder S; S.init(NTOK, DM, G, c); EpiResid E; E.xf = (const float*)(ws + WS_XF); E.o = (float*)(ws + WS_PRELN);
            run_gemm(P.pad0, ldsl, (const bf16_t*)(ws + WS_MB), DM, (const bf16_t*)(ws + WS_WOUT) + (size_t)l * DM * DM, DM, NTOK, DM, DM, S, E); }
}
#endif
 PH_END_
        PH_BEGIN
#if EN_PH(9)
REP(9) { if (rep_) __syncthreads();
phase_ln1(P, l, ldsf);
}
#endif
 PH_END_
        PH_BEGIN
#if EN_PH(10)
REP(10) { if (rep_) __syncthreads();
phase_topk(P, (unsigned long long*)shm);
}
#endif
 PH_END_
        PH_BEGIN
#if EN_PH(11)
REP(11) { if (rep_) __syncthreads();
{ GroupedOrder S; S.init(8, 16, NEXP, G, c); EpiSwiGLU E; E.H = ws + WS_H;
            run_gemm_f8(P.pad0, ldsl, ws + WS_XE, DM, ws + WS_WGU + (size_t)l * NEXP * 4096 * DM, DM, NEXP * 2048, NEXP * 4096, DM, E8_ONE, E8_W, S, E); }
}
#endif
 PH_END_
        PH_BEGIN
#if EN_PH(12)
REP(12) { if (rep_) __syncthreads();
{ GroupedOrder S; S.init(8, 4, NEXP, G, c); EpiDown E; E.Y = (bf16_t*)(ws + WS_YE); E.grow = (const float*)(ws + WS_GROW);
            run_gemm_f8(P.pad0, ldsl, ws + WS_H, DEXP, ws + WS_WDN + (size_t)l * NEXP * DM * DEXP, DEXP, NEXP * 2048, NEXP * DM, DEXP, E8_H, E8_W, S, E); }
}
#endif
 PH_END_
        PH_BEGIN
#if EN_PH(13)
REP(13) { if (rep_) __syncthreads();
phase_ln2(P, l);
}
#endif
 PH_END_
    }
#undef PH_BEGIN
#undef PH_END_
#if STAMP_SCAN
    if (blockIdx.x == 0 && threadIdx.x == 0) { const unsigned long long want = 4ull * *(volatile unsigned*)(kws() + 8192); const long long t0 = clock64(); while ((unsigned long long)(clock64() - t0) < want) __builtin_amdgcn_s_sleep(8); }
#endif
}

#ifndef MK_FUSED
#define MK_FUSED 1
#endif

extern "C" void kernel_launch(void* const* d_in, const int* in_sizes, int n_in, void* d_out, int out_size, void* d_ws, size_t ws_size, hipStream_t stream) {
    static int grid = 0;
    if (grid == 0) {
        if (n_in != N_IN || ws_size < WS_END) { fprintf(stderr, "kernel_launch: unexpected n_in %d or ws_size %zu (< %zu)\n", n_in, ws_size, (size_t)WS_END); grid = -1; return; }
        int dev = 0, cus = 0;
        if (hipGetDevice(&dev) != hipSuccess || hipDeviceGetAttribute(&cus, hipDeviceAttributeMultiprocessorCount, dev) != hipSuccess) { grid = -1; return; }
        if (hipFuncSetAttribute((const void*)mega, hipFuncAttributeMaxDynamicSharedMemorySize, LDS_BYTES) != hipSuccess) { fprintf(stderr, "kernel_launch: hipFuncSetAttribute failed\n"); grid = -1; return; }
        grid = cus > 0 ? cus : 256;
    }
    if (grid < 0) return;
    Params P{};
    for (int i = 0; i < N_IN; ++i) P.in[i] = (const float*)d_in[i];
    P.out = (float*)d_out; P.ws = (unsigned char*)d_ws; P.pad0 = 0;
#if MK_FUSED
    (void)hipMemsetAsync((char*)d_ws + WS_CTL, 0, XCD_BAR_WORDS * sizeof(unsigned), stream);
    P.ph_lo = 0; P.ph_hi = NPH_TOTAL; P.fused = 1;
    hipLaunchKernelGGL(mega, dim3(grid), dim3(NTHR), LDS_BYTES, stream, P);
#else
    for (int ph = 0; ph < NPH_TOTAL; ++ph) {
        P.ph_lo = ph; P.ph_hi = ph + 1; P.fused = 0;
        hipLaunchKernelGGL(mega, dim3(grid), dim3(NTHR), LDS_BYTES, stream, P);
    }
#endif
}
```

```cpp
#include <hip/hip_runtime.h>
#include <stdint.h>
#include <stdio.h>

namespace pg8 {
#define PG8_LAS __attribute__((address_space(3)))
typedef unsigned short bf16_t;
typedef short bf16x8 __attribute__((ext_vector_type(8)));
typedef float f32x4 __attribute__((ext_vector_type(4)));
typedef unsigned u32x4 __attribute__((ext_vector_type(4)));
constexpr int BM = 256, BK = 64, HALF = 128, HTB = HALF * BK * 2  , STAGE_BYTES = 8 * HTB, NXCD = 8, WGM = 8;

__host__ __device__ __forceinline__ int lds_byte(int r, int c) { const int st = (r >> 4) * 2 + (c >> 5), rr = r & 15, cc = c & 31, ob = rr * 64 + cc * 2; return st * 1024 + (ob ^ (((ob >> 9) & 1) << 5)); }
__host__ __device__ __forceinline__ void stage_rc(int b, int& R, int& C) { const int st = b / 1024, sb = b % 1024, swz = sb ^ (((sb >> 9) & 1) << 5); R = (st >> 1) * 16 + swz / 64; C = (st & 1) * 32 + (swz % 64) / 2; }
__host__ __device__ __forceinline__ int perm32(int rho) { const int n = rho >> 4, i = rho & 15; return 8 * (i >> 2) + 4 * n + (i & 3); }

struct Unit { int pm, pn; };
struct Gemm { const bf16_t* A; const bf16_t* Bt; int M, N, K, lda, ldb, wv, sa, sb, pshift, pmask, koff, alt_from, nt_alt; };
struct StaticOrder {
    int nM, nN, nwg, G, c;
    __host__ __device__ void init(int M, int N, int G_, int c_) { nM = M / BM; nN = N / BM; nwg = nM * nN; G = G_; c = c_; }
    __host__ __device__ bool next(int i, Unit& u) const {
        const long L = (long)i * G + c; if (L >= nwg) return false;
        int wgid = (int)L; { const int q = nwg / NXCD, r = nwg % NXCD, xcd = wgid % NXCD, off = wgid / NXCD; wgid = (xcd < r ? xcd * (q + 1) : r * (q + 1) + (xcd - r) * q) + off; }
        const int nig = WGM * nN, gid = wgid / nig, fm = gid * WGM, gsz = (nM - fm) < WGM ? (nM - fm) : WGM;
        u.pm = fm + ((wgid % nig) % gsz); u.pn = (wgid % nig) / gsz; return true;
    }
    __device__ __forceinline__ void a_ready(const Unit&) const {}
    __device__ __forceinline__ void done(const Unit&) const {}
};
__device__ __forceinline__ unsigned cvt_pk_bf16(float lo, float hi) { unsigned r; asm volatile("v_cvt_pk_bf16_f32 %0, %1, %2" : "=v"(r) : "v"(lo), "v"(hi)); return r; }
template <class Epi, class Sched, bool STAMP = false>
__device__ __forceinline__ void gemm_phase(PG8_LAS unsigned char* lds, const Gemm g, const Sched& S, const Epi& E, unsigned long long* stamps) {
    unsigned z_ = 0u; asm volatile("" : "+v"(z_)); int tid_ = g.wv * 64 + (int)__builtin_amdgcn_mbcnt_hi(~0u, __builtin_amdgcn_mbcnt_lo(~0u, z_)); asm volatile("" : "+v"(tid_));
    const int tid = tid_, wid = __builtin_amdgcn_readfirstlane(tid >> 6), lane = tid & 63, wr = wid >> 2, wc = wid & 3, fr = lane & 15, fq = lane >> 4;
    const int K = g.K, nt = K / BK;
    int ts_lo = 0, ts_hi = 0, nts = 0; const unsigned long long rt_entry = STAMP ? (unsigned long long)wall_clock64() : 0ull;
#define PG8_STAMP() do { if (STAMP && wid == 0 && nts < 64) { const unsigned long long _c = (unsigned long long)clock64(); \
        ts_lo = (lane == nts) ? (int)(unsigned)_c : ts_lo; ts_hi = (lane == nts) ? (int)(unsigned)(_c >> 32) : ts_hi; ++nts; } } while (0)
    PG8_STAMP();
    unsigned voffA[2], voffB[2];
#pragma unroll
    for (int i = 0; i < 2; ++i) { int R, C; stage_rc(tid * 16 + i * 8192, R, C); const int Rb = Epi::PERM ? ((R & ~31) + perm32(R & 31)) : R;
        voffA[i] = (unsigned)(R * g.lda + C) * 2u; voffB[i] = (unsigned)(Rb * g.ldb + C) * 2u; }
    const size_t kstep = (size_t)(BK * 2);
    const size_t hstepA = (size_t)HALF * g.lda * 2, hstepB = (size_t)HALF * g.ldb * 2;
    const size_t tstepA = 2 * hstepA, tstepB = 2 * hstepB;
    const unsigned ldsw = (unsigned)wid * 1024u;
    const int aoff = lds_byte(wr * 64 + fr, fq * 8), boff = lds_byte(wc * 32 + fr, fq * 8);
#define PG8_SA(b, h) (((b) * 2 + (h)) * HTB)
#define PG8_SB(b, h) ((4 + (b) * 2 + (h)) * HTB)
#define PG8_STAGE(bufoff, gbase, voff) do { _Pragma("unroll") for (int _i = 0; _i < 2; ++_i) \
        __builtin_amdgcn_global_load_lds((const unsigned*)((const char*)(gbase) + (voff)[_i]), (PG8_LAS unsigned*)(lds + (bufoff) + ldsw + _i * 8192), 16, 0, 0); } while (0)
#define PG8_LDA(dst, b, h) do { _Pragma("unroll") for (int m = 0; m < 4; ++m) _Pragma("unroll") for (int k = 0; k < 2; ++k) dst[m][k] = *(const PG8_LAS bf16x8*)(lds + PG8_SA(b, h) + aoff + m * 2048 + k * 1024); } while (0)
#define PG8_LDB(dst, b, h) do { _Pragma("unroll") for (int n = 0; n < 2; ++n) _Pragma("unroll") for (int k = 0; k < 2; ++k) dst[n][k] = *(const PG8_LAS bf16x8*)(lds + PG8_SB(b, h) + boff + n * 2048 + k * 1024); } while (0)
#define PG8_MMA(ai, bj, At, Bt) do { __builtin_amdgcn_s_setprio(1); _Pragma("unroll") for (int m = 0; m < 4; ++m) _Pragma("unroll") for (int n = 0; n < 2; ++n) _Pragma("unroll") for (int k = 0; k < 2; ++k) \
        acc[ai][bj][m][n] = __builtin_amdgcn_mfma_f32_16x16x32_bf16(Bt[n][k], At[m][k], acc[ai][bj][m][n], 0, 0, 0); __builtin_amdgcn_s_setprio(0); } while (0)
#define PG8_WAIT_V(n) asm volatile("s_waitcnt vmcnt(" #n ")" ::: "memory")
#define PG8_WAIT_L(n) asm volatile("s_waitcnt lgkmcnt(" #n ")" ::: "memory")
#define PG8_BAR __builtin_amdgcn_s_barrier()
#define PG8_SCHED __builtin_amdgcn_sched_barrier(0)
    Unit cur, nxt; int ui = 0;
    if (!S.next(0, cur)) return;
    f32x4 acc[2][2][4][2];
#pragma unroll
    for (int a = 0; a < 2; ++a)
#pragma unroll
        for (int b = 0; b < 2; ++b)
#pragma unroll
            for (int m = 0; m < 4; ++m)
#pragma unroll
                for (int n = 0; n < 2; ++n) acc[a][b][m][n] = (f32x4){0.f, 0.f, 0.f, 0.f};
    bf16x8 At[4][2], B0[2][2], B1[2][2];
    const char* cA = (const char*)g.A + (size_t)cur.pm * tstepA + (size_t)(cur.pn >> g.pshift) * g.koff; const char* cB = (const char*)g.Bt + (size_t)(cur.pn & g.pmask) * tstepB + (size_t)(cur.pn >> g.pshift) * g.koff;
    S.a_ready(cur);
    PG8_STAGE(PG8_SB(0, 0), cB, voffB); PG8_STAGE(PG8_SA(0, 0), cA, voffA); PG8_STAGE(PG8_SB(0, 1), cB + hstepB, voffB); PG8_STAGE(PG8_SA(0, 1), cA + hstepA, voffA);
    if (wr == 1) PG8_BAR;
    PG8_WAIT_V(4); PG8_BAR;
    PG8_STAGE(PG8_SB(1, 0), cB + kstep, voffB); PG8_STAGE(PG8_SA(1, 0), cA + kstep, voffA); PG8_STAGE(PG8_SB(1, 1), cB + hstepB + kstep, voffB);
    PG8_WAIT_V(6); PG8_BAR;
    PG8_STAMP();
    for (;;) {
        const bool has_next = S.next(ui + 1, nxt);
        const char* nA = has_next ? (const char*)g.A + (size_t)nxt.pm * tstepA + (size_t)(nxt.pn >> g.pshift) * g.koff : cA; const char* nB = has_next ? (const char*)g.Bt + (size_t)(nxt.pn & g.pmask) * tstepB + (size_t)(nxt.pn >> g.pshift) * g.koff : cB;
        const int ntu = ((cur.pn >> g.pshift) >= g.alt_from) ? g.nt_alt : nt;
        for (int t = 0; t < ntu; t += 2) {
            const bool last = (t == ntu - 2);
            const char* a1 = cA + (size_t)(t + 1) * kstep;
            const char* a2 = last ? nA : cA + (size_t)(t + 2) * kstep; const char* b2 = last ? nB : cB + (size_t)(t + 2) * kstep;
            const char* a3 = a2 + kstep; const char* b3 = b2 + kstep;
            if (last && has_next) S.a_ready(nxt);
            PG8_LDB(B0, 0, 0); PG8_SCHED; PG8_LDA(At, 0, 0); PG8_STAGE(PG8_SA(1, 1), a1 + hstepA, voffA);
            PG8_WAIT_L(8); PG8_BAR; PG8_WAIT_L(0); PG8_MMA(0, 0, At, B0); PG8_BAR; PG8_SCHED;
            PG8_LDB(B1, 0, 1); PG8_STAGE(PG8_SB(0, 0), b2, voffB);
            PG8_BAR; PG8_WAIT_L(0); PG8_MMA(0, 1, At, B1); PG8_BAR;
            PG8_LDA(At, 0, 1); PG8_STAGE(PG8_SA(0, 0), a2, voffA);
            PG8_BAR; PG8_WAIT_L(0); PG8_MMA(1, 0, At, B0); PG8_BAR; PG8_SCHED;
            PG8_STAGE(PG8_SB(0, 1), b2 + hstepB, voffB);
            PG8_WAIT_V(6); PG8_BAR; PG8_MMA(1, 1, At, B1); PG8_BAR;
            PG8_LDB(B0, 1, 0); PG8_SCHED; PG8_LDA(At, 1, 0); PG8_STAGE(PG8_SA(0, 1), a2 + hstepA, voffA);
            PG8_WAIT_L(8); PG8_BAR; PG8_WAIT_L(0); PG8_MMA(0, 0, At, B0); PG8_BAR; PG8_SCHED;
            PG8_LDB(B1, 1, 1); PG8_STAGE(PG8_SB(1, 0), b3, voffB);
            PG8_BAR; PG8_WAIT_L(0); PG8_MMA(0, 1, At, B1); PG8_BAR;
            PG8_LDA(At, 1, 1); PG8_STAGE(PG8_SA(1, 0), a3, voffA);
            PG8_BAR; PG8_WAIT_L(0); PG8_MMA(1, 0, At, B0); PG8_BAR; PG8_SCHED;
            PG8_STAGE(PG8_SB(1, 1), b3 + hstepB, voffB);
            PG8_WAIT_V(6); PG8_BAR; PG8_MMA(1, 1, At, B1); PG8_BAR;
        }
        PG8_STAMP();
        if constexpr (!Epi::AFTER_DRAIN) { E(acc, cur, wr, wc, fr, fq); S.done(cur); }
        PG8_STAMP();
        if (!has_next) break;
#pragma unroll
        for (int a = 0; a < 2; ++a)
#pragma unroll
            for (int b = 0; b < 2; ++b)
#pragma unroll
                for (int m = 0; m < 4; ++m)
#pragma unroll
                    for (int n = 0; n < 2; ++n) acc[a][b][m][n] = (f32x4){0.f, 0.f, 0.f, 0.f};
        cur = nxt; cA = nA; cB = nB; ++ui;
    }
    PG8_WAIT_V(0);
    if (wr == 0) PG8_BAR;
    PG8_BAR;
    if constexpr (Epi::AFTER_DRAIN) { E.fused(acc, cur, wr, wc, fr, fq, lds, wid, lane); S.done(cur); }
    PG8_STAMP();
    if (STAMP && wid == 0) { stamps[lane] = lane < nts ? (((unsigned long long)(unsigned)ts_hi << 32) | (unsigned)ts_lo) : 0ull;
        if (lane == 62) stamps[62] = rt_entry; if (lane == 63) stamps[63] = (unsigned long long)wall_clock64(); }
#undef PG8_STAMP
#undef PG8_SA
#undef PG8_SB
#undef PG8_STAGE
#undef PG8_LDA
#undef PG8_LDB
#undef PG8_MMA
#undef PG8_WAIT_V
#undef PG8_WAIT_L
#undef PG8_BAR
#undef PG8_SCHED
}

typedef short bf16x16 __attribute__((ext_vector_type(16)));
typedef int v8i __attribute__((ext_vector_type(8)));
template <class Epi, class Sched, bool STAMP = false>
__device__ __forceinline__ void gemm_phase_f8(PG8_LAS unsigned char* lds, const Gemm g, const Sched& S, const Epi& E, unsigned long long* stamps) {
    unsigned z_ = 0u; asm volatile("" : "+v"(z_)); int tid_ = g.wv * 64 + (int)__builtin_amdgcn_mbcnt_hi(~0u, __builtin_amdgcn_mbcnt_lo(~0u, z_)); asm volatile("" : "+v"(tid_));
    const int tid = tid_, wid = __builtin_amdgcn_readfirstlane(tid >> 6), lane = tid & 63, wr = wid >> 2, wc = wid & 3, fr = lane & 15, fq = lane >> 4;
    const int K = g.K, nt = K / 128;
    int ts_lo = 0, ts_hi = 0, nts = 0; const unsigned long long rt_entry = STAMP ? (unsigned long long)wall_clock64() : 0ull;
#define PG8_STAMP() do { if (STAMP && wid == 0 && nts < 64) { const unsigned long long _c = (unsigned long long)clock64(); \
        ts_lo = (lane == nts) ? (int)(unsigned)_c : ts_lo; ts_hi = (lane == nts) ? (int)(unsigned)(_c >> 32) : ts_hi; ++nts; } } while (0)
    PG8_STAMP();
    unsigned voffA[2], voffB[2];
#pragma unroll
    for (int i = 0; i < 2; ++i) { int R, C; stage_rc(tid * 16 + i * 8192, R, C); const int Rb = Epi::PERM ? ((R & ~31) + perm32(R & 31)) : R;
        voffA[i] = (unsigned)(R * g.lda) + (unsigned)C * 2u; voffB[i] = (unsigned)(Rb * g.ldb) + (unsigned)C * 2u; }
    const size_t kstep = (size_t)(BK * 2);
    const size_t hstepA = (size_t)HALF * g.lda, hstepB = (size_t)HALF * g.ldb;
    const size_t tstepA = 2 * hstepA, tstepB = 2 * hstepB;
    const unsigned ldsw = (unsigned)wid * 1024u;
    const int aoff = lds_byte(wr * 64 + fr, fq * 8), boff = lds_byte(wc * 32 + fr, fq * 8);
#define PG8_SA(b, h) (((b) * 2 + (h)) * HTB)
#define PG8_SB(b, h) ((4 + (b) * 2 + (h)) * HTB)
#define PG8_STAGE(bufoff, gbase, voff) do { _Pragma("unroll") for (int _i = 0; _i < 2; ++_i) \
        __builtin_amdgcn_global_load_lds((const unsigned*)((const char*)(gbase) + (voff)[_i]), (PG8_LAS unsigned*)(lds + (bufoff) + ldsw + _i * 8192), 16, 0, 0); } while (0)
#define PG8_LDA(dst, b, h) do { _Pragma("unroll") for (int m = 0; m < 4; ++m) { const bf16x8 lo_ = *(const PG8_LAS bf16x8*)(lds + PG8_SA(b, h) + aoff + m * 2048), hi_ = *(const PG8_LAS bf16x8*)(lds + PG8_SA(b, h) + aoff + m * 2048 + 1024); \
        dst[m] = __builtin_shufflevector(lo_, hi_, 0, 1, 2, 3, 4, 5, 6, 7, 8, 9, 10, 11, 12, 13, 14, 15); } } while (0)
#define PG8_LDB(dst, b, h) do { _Pragma("unroll") for (int n = 0; n < 2; ++n) { const bf16x8 lo_ = *(const PG8_LAS bf16x8*)(lds + PG8_SB(b, h) + boff + n * 2048), hi_ = *(const PG8_LAS bf16x8*)(lds + PG8_SB(b, h) + boff + n * 2048 + 1024); \
        dst[n] = __builtin_shufflevector(lo_, hi_, 0, 1, 2, 3, 4, 5, 6, 7, 8, 9, 10, 11, 12, 13, 14, 15); } } while (0)
#define PG8_MMA(ai, bj, At, Bt) do { __builtin_amdgcn_s_setprio(1); _Pragma("unroll") for (int m = 0; m < 4; ++m) _Pragma("unroll") for (int n = 0; n < 2; ++n) \
        asm volatile("v_mfma_scale_f32_16x16x128_f8f6f4 %0, %1, %2, %0, %3, %4 op_sel_hi:[0,0,0]" : "+v"(acc[ai][bj][m][n]) : "v"(__builtin_bit_cast(v8i, Bt[n])), "v"(__builtin_bit_cast(v8i, At[m])), "v"(sbv), "v"(sav)); \
        __builtin_amdgcn_s_setprio(0); } while (0)
#define PG8_WAIT_V(n) asm volatile("s_waitcnt vmcnt(" #n ")" ::: "memory")
#define PG8_WAIT_L(n) asm volatile("s_waitcnt lgkmcnt(" #n ")" ::: "memory")
#define PG8_BAR __builtin_amdgcn_s_barrier()
#define PG8_SCHED __builtin_amdgcn_sched_barrier(0)
    Unit cur, nxt; int ui = 0;
    if (!S.next(0, cur)) return;
    f32x4 acc[2][2][4][2];
#pragma unroll
    for (int a = 0; a < 2; ++a)
#pragma unroll
        for (int b = 0; b < 2; ++b)
#pragma unroll
            for (int m = 0; m < 4; ++m)
#pragma unroll
                for (int n = 0; n < 2; ++n) acc[a][b][m][n] = (f32x4){0.f, 0.f, 0.f, 0.f};
    bf16x16 At[4], B0[2], B1[2];
    int sav = g.sa, sbv = g.sb;
    const char* cA = (const char*)g.A + (size_t)cur.pm * tstepA + (size_t)(cur.pn >> g.pshift) * g.koff; const char* cB = (const char*)g.Bt + (size_t)(cur.pn & g.pmask) * tstepB + (size_t)(cur.pn >> g.pshift) * g.koff;
    S.a_ready(cur);
    PG8_STAGE(PG8_SB(0, 0), cB, voffB); PG8_STAGE(PG8_SA(0, 0), cA, voffA); PG8_STAGE(PG8_SB(0, 1), cB + hstepB, voffB); PG8_STAGE(PG8_SA(0, 1), cA + hstepA, voffA);
    if (wr == 1) PG8_BAR;
    PG8_WAIT_V(4); PG8_BAR;
    PG8_STAGE(PG8_SB(1, 0), cB + kstep, voffB); PG8_STAGE(PG8_SA(1, 0), cA + kstep, voffA); PG8_STAGE(PG8_SB(1, 1), cB + hstepB + kstep, voffB);
    PG8_WAIT_V(6); PG8_BAR;
    PG8_STAMP();
    for (;;) {
        const bool has_next = S.next(ui + 1, nxt);
        const char* nA = has_next ? (const char*)g.A + (size_t)nxt.pm * tstepA + (size_t)(nxt.pn >> g.pshift) * g.koff : cA; const char* nB = has_next ? (const char*)g.Bt + (size_t)(nxt.pn & g.pmask) * tstepB + (size_t)(nxt.pn >> g.pshift) * g.koff : cB;
        for (int t = 0; t < nt; t += 2) {
            const bool last = (t == nt - 2);
            const char* a1 = cA + (size_t)(t + 1) * kstep;
            const char* a2 = last ? nA : cA + (size_t)(t + 2) * kstep; const char* b2 = last ? nB : cB + (size_t)(t + 2) * kstep;
            const char* a3 = a2 + kstep; const char* b3 = b2 + kstep;
            if (last && has_next) S.a_ready(nxt);
            PG8_LDB(B0, 0, 0); PG8_SCHED; PG8_LDA(At, 0, 0); PG8_STAGE(PG8_SA(1, 1), a1 + hstepA, voffA);
            PG8_WAIT_L(8); PG8_BAR; PG8_WAIT_L(0); PG8_MMA(0, 0, At, B0); PG8_BAR; PG8_SCHED;
            PG8_LDB(B1, 0, 1); PG8_STAGE(PG8_SB(0, 0), b2, voffB);
            PG8_BAR; PG8_WAIT_L(0); PG8_MMA(0, 1, At, B1); PG8_BAR;
            PG8_LDA(At, 0, 1); PG8_STAGE(PG8_SA(0, 0), a2, voffA);
            PG8_BAR; PG8_WAIT_L(0); PG8_MMA(1, 0, At, B0); PG8_BAR; PG8_SCHED;
            PG8_STAGE(PG8_SB(0, 1), b2 + hstepB, voffB);
            PG8_WAIT_V(6); PG8_BAR; PG8_MMA(1, 1, At, B1); PG8_BAR;
            PG8_LDB(B0, 1, 0); PG8_SCHED; PG8_LDA(At, 1, 0); PG8_STAGE(PG8_SA(0, 1), a2 + hstepA, voffA);
            PG8_WAIT_L(8); PG8_BAR; PG8_WAIT_L(0); PG8_MMA(0, 0, At, B0); PG8_BAR; PG8_SCHED;
            PG8_LDB(B1, 1, 1); PG8_STAGE(PG8_SB(1, 0), b3, voffB);
            PG8_BAR; PG8_WAIT_L(0); PG8_MMA(0, 1, At, B1); PG8_BAR;
            PG8_LDA(At, 1, 1); PG8_STAGE(PG8_SA(1, 0), a3, voffA);
            PG8_BAR; PG8_WAIT_L(0); PG8_MMA(1, 0, At, B0); PG8_BAR; PG8_SCHED;
            PG8_STAGE(PG8_SB(1, 1), b3 + hstepB, voffB);
            PG8_WAIT_V(6); PG8_BAR; PG8_MMA(1, 1, At, B1); PG8_BAR;
        }
        asm volatile("s_nop 15\n\ts_nop 7" ::: "memory");
        PG8_STAMP();
        if constexpr (!Epi::AFTER_DRAIN) { E(acc, cur, wr, wc, fr, fq); S.done(cur); }
        PG8_STAMP();
        if (!has_next) break;
#pragma unroll
        for (int a = 0; a < 2; ++a)
#pragma unroll
            for (int b = 0; b < 2; ++b)
#pragma unroll
                for (int m = 0; m < 4; ++m)
#pragma unroll
                    for (int n = 0; n < 2; ++n) acc[a][b][m][n] = (f32x4){0.f, 0.f, 0.f, 0.f};
        cur = nxt; cA = nA; cB = nB; ++ui;
    }
    PG8_WAIT_V(0);
    if (wr == 0) PG8_BAR;
    PG8_BAR;
    if constexpr (Epi::AFTER_DRAIN) { E.fused(acc, cur, wr, wc, fr, fq, lds, wid, lane); S.done(cur); }
    PG8_STAMP();
    if (STAMP && wid == 0) { stamps[lane] = lane < nts ? (((unsigned long long)(unsigned)ts_hi << 32) | (unsigned)ts_lo) : 0ull;
        if (lane == 62) stamps[62] = rt_entry; if (lane == 63) stamps[63] = (unsigned long long)wall_clock64(); }
#undef PG8_STAMP
#undef PG8_SA
#undef PG8_SB
#undef PG8_STAGE
#undef PG8_LDA
#undef PG8_LDB
#undef PG8_MMA
#undef PG8_WAIT_V
#undef PG8_WAIT_L
#undef PG8_BAR
#undef PG8_SCHED
}
}

using pg8::bf16_t; using pg8::f32x4; using pg8::u32x4; using pg8::Unit; using pg8::Gemm; using pg8::cvt_pk_bf16;
typedef float f32x2 __attribute__((ext_vector_type(2)));
typedef unsigned u32x2 __attribute__((ext_vector_type(2)));
#define LAS __attribute__((address_space(3)))

constexpr int DM = 1024, NBATCH = 8, SEQ = 2048, NTOK = NBATCH * SEQ, DEPTH = 4, NMEM = 256, INC = 12288;
constexpr int C_R = 0, C_K = 1024, C_V = 2048, C_DW = 3072, C_WQ = 3328, C_WK = 4352, C_WV = 4608, C_DQ = 4864, C_DK = 5888, C_DV = 6912, C_MQ = 7936, C_GATE = 8192;
constexpr int RWC = 3328, LORA_N = 5120, BRK = 3328;
constexpr float DN_ALPHA = 1.6817928305074290f;
constexpr int NEXP = 16, CAP = 256, DEXP = 2048;

enum { I_X = 0, I_MEM, I_RELB, I_WIN, I_MU, I_W0, I_WUP, I_A0, I_AUP, I_GUP, I_KK, I_KA, I_RK, I_GNG, I_GNB, I_SINK, I_LAM, I_SUBLN, I_WKV, I_WBR, I_WOUT,
       I_LN1G, I_LN1B, I_ROUTER, I_EWG, I_EWU, I_EWD, I_LN2G, I_LN2B, N_IN };

constexpr size_t MiB = 1ull << 20;
constexpr size_t WS_CTL = 0;
constexpr size_t WS_WIN = 1 * MiB;
constexpr size_t WS_WBR = WS_WIN + 96 * MiB;
constexpr size_t WS_WOUT = WS_WBR + 26 * MiB;
constexpr size_t WS_WKV = WS_WOUT + 8 * MiB;
constexpr size_t WS_WGU = WS_WKV + 4 * MiB;
constexpr size_t WS_WDN = WS_WGU + 512 * MiB;
constexpr size_t WS_MBP = WS_WGU + 256 * MiB;
constexpr size_t WS_GATEP = WS_WDN + 128 * MiB;
constexpr size_t WS_WLORA = WS_WDN + 256 * MiB;
constexpr size_t WS_XF = WS_WLORA + 10 * MiB;
constexpr size_t WS_XB = WS_XF + 64 * MiB;
constexpr size_t WS_MEMB = WS_XB + 32 * MiB;
constexpr size_t WS_KVMEM = WS_MEMB + 4 * MiB;
constexpr size_t WS_P = WS_KVMEM + 8 * MiB;
constexpr size_t WS_XE = WS_P, WS_H = WS_P + 64 * MiB, WS_YE = WS_P + 192 * MiB;
constexpr size_t WS_APR = WS_P + 384 * MiB;
constexpr size_t WS_LORA = WS_APR + 8 * MiB;
constexpr size_t WS_YDIR = WS_LORA + 160 * MiB;
constexpr size_t WS_BONUS = WS_YDIR + 128 * MiB;
constexpr size_t WS_YCAT = WS_BONUS + 2 * MiB;
constexpr size_t WS_MF = WS_YCAT + 104 * MiB;
constexpr size_t WS_PRELN = WS_MF + 64 * MiB;
constexpr size_t WS_DTMP = WS_MF;
constexpr size_t WS_MB = WS_PRELN + 64 * MiB;
constexpr size_t WS_AFF = WS_MB + 32 * MiB;
constexpr size_t WS_GROW = WS_AFF + 1 * MiB;
constexpr size_t WS_SLOT = WS_GROW + 1 * MiB;
constexpr size_t WS_END = WS_SLOT + 1 * MiB;

struct Params {
    const float* in[N_IN];
    float* out;
    unsigned char* ws;
    int ph_lo, ph_hi;
    int fused, pad0;
};

#define CAS __attribute__((address_space(4)))
__device__ __forceinline__ const CAS unsigned char* karg_base() { const CAS unsigned char* q = (const CAS unsigned char*)__builtin_amdgcn_kernarg_segment_ptr(); asm volatile("" : "+s"(q)); return q; }
__device__ __forceinline__ const float* kin(int i) { return ((const float* const CAS*)karg_base())[i]; }
__device__ __forceinline__ float* kout() { return *(float* const CAS*)(karg_base() + N_IN * 8); }
__device__ __forceinline__ unsigned char* kws() { return *(unsigned char* const CAS*)(karg_base() + N_IN * 8 + 8); }
constexpr int LDS_BYTES = 145 * 1024;
constexpr int NTHR = 512;

__device__ __forceinline__ float bf2f(unsigned v) { return __uint_as_float(v << 16); }
__device__ __forceinline__ float bflo(unsigned v) { return __uint_as_float(v << 16); }
__device__ __forceinline__ float bfhi(unsigned v) { return __uint_as_float(v & 0xffff0000u); }
__device__ __forceinline__ unsigned short f2bf(float f) { unsigned u = __float_as_uint(f); u += 0x7FFFu + ((u >> 16) & 1u); return (unsigned short)(u >> 16); }
__device__ __forceinline__ int lane_id() { unsigned z = 0u; asm volatile("" : "+v"(z)); return (int)__builtin_amdgcn_mbcnt_hi(~0u, __builtin_amdgcn_mbcnt_lo(~0u, z)); }
__device__ __forceinline__ int otid(int wv) { int t = wv * 64 + lane_id(); asm volatile("" : "+v"(t)); return t; }
__device__ __forceinline__ float shfl_xor_o(float v, int mask) { const int lid = lane_id(); return __builtin_bit_cast(float, __builtin_amdgcn_ds_bpermute((lid ^ mask) << 2, __builtin_bit_cast(int, v))); }
__device__ __forceinline__ float wave_sum(float v) {
    const int lid = lane_id();
#pragma unroll
    for (int o = 1; o < 64; o <<= 1) v += __builtin_bit_cast(float, __builtin_amdgcn_ds_bpermute((lid ^ o) << 2, __builtin_bit_cast(int, v)));
    return v;
}
__device__ __forceinline__ float dpp_xor1(float v) { return __builtin_bit_cast(float, __builtin_amdgcn_update_dpp(0, __builtin_bit_cast(int, v), 0xB1, 0xF, 0xF, true)); }
__device__ __forceinline__ float dpp_xor2(float v) { return __builtin_bit_cast(float, __builtin_amdgcn_update_dpp(0, __builtin_bit_cast(int, v), 0x4E, 0xF, 0xF, true)); }
__device__ __forceinline__ float dpp_hmir(float v) { return __builtin_bit_cast(float, __builtin_amdgcn_update_dpp(0, __builtin_bit_cast(int, v), 0x141, 0xF, 0xF, true)); }
__device__ __forceinline__ float sum8(float v) { v += dpp_xor1(v); v += dpp_xor2(v); v += dpp_hmir(v); return v; }
__device__ __forceinline__ float dpp_mir(float v) { return __builtin_bit_cast(float, __builtin_amdgcn_update_dpp(0, __builtin_bit_cast(int, v), 0x140, 0xF, 0xF, true)); }
__device__ __forceinline__ float sum16(float v) { v = sum8(v); v += dpp_mir(v); return v; }
__device__ __forceinline__ float sigmoidf_(float x) { return __builtin_amdgcn_rcpf(1.0f + __expf(-x)); }
__device__ __forceinline__ int t5_bucket(int rel) {
    const int n = rel < 0 ? -rel : rel;
    int large = 2 + (31 - __clz(n * n));
    large = large > 15 ? 15 : large;
    return (rel > 0 ? 16 : 0) + (n < 8 ? n : large);
}

struct GroupedOrder {
    int nMe, nNe, upe, total, G, c;
    __device__ void init(int nMe_, int nNe_, int E, int G_, int c_) { nMe = nMe_; nNe = nNe_; upe = nMe_ * nNe_; total = upe * E; G = G_; c = c_; }
    __device__ bool next(int i, Unit& u) const {
        const int L = i * G + c; if (L >= total) return false;
        const int e = L / upe, rem = L % upe, x = rem & 7, j = rem >> 3;
        const int am = nMe >> 1, pm_e = (x & 1) * am + (j % am), pn_e = (x >> 1) * (nNe >> 2) + (j / am);
        u.pm = e * nMe + pm_e; u.pn = e * nNe + pn_e; return true;
    }
    __device__ __forceinline__ void a_ready(const Unit&) const {}
    __device__ __forceinline__ void done(const Unit&) const {}
};

__device__ __forceinline__ void st_block_bf16(LAS unsigned char* sw, int woff, int roff, const u32x4& X, const u32x4& Y, bf16_t* rowp, size_t ldc) {
    *(LAS u32x4*)(sw + woff) = X; *(LAS u32x4*)(sw + (woff ^ 64)) = Y;
    const u32x4 r0 = *(const LAS u32x4*)(sw + roff), r1 = *(const LAS u32x4*)(sw + roff + 1024);
    *(u32x4*)rowp = r0; *(u32x4*)(rowp + 8 * ldc) = r1;
}
#define ST_BLOCK_SETUP(st_) LAS unsigned char* sw = (st_) + (wr * 4 + wc) * 2048; const int woff = fr * 128 + ((fq ^ (fr & 7)) << 4), lane_ = fq * 16 + fr, rrow = lane_ >> 3, rp = lane_ & 7, roff = rrow * 128 + ((rp ^ (rrow & 7)) << 4)
struct EpiBf16Store {
    static constexpr bool PERM = true, AFTER_DRAIN = false;
    bf16_t* O; int ldc; LAS unsigned char* st;
    bf16_t* GP;
    __device__ __forceinline__ void operator()(const f32x4 (&acc)[2][2][4][2], const Unit& u, int wr, int wc, int fr, int fq) const {
        typedef float fv8_ __attribute__((ext_vector_type(8))); typedef __bf16 bfv8_ __attribute__((ext_vector_type(8)));
        if (GP != nullptr && u.pn >= 32) {
            u32x4* gp = (u32x4*)GP + ((size_t)((u.pm * 16 + (u.pn - 32)) * 8 + wr * 4 + wc) * 16) * 64 + fq * 16 + fr;
#pragma unroll
            for (int ai = 0; ai < 2; ++ai)
#pragma unroll
                for (int m = 0; m < 4; ++m)
#pragma unroll
                    for (int bj = 0; bj < 2; ++bj) { const f32x4 v0 = acc[ai][bj][m][0], v1 = acc[ai][bj][m][1];
                        const fv8_ x8 = {v0[0], v0[1], v0[2], v0[3], v1[0], v1[1], v1[2], v1[3]};
                        gp[((ai * 4 + m) * 2 + bj) * 64] = __builtin_bit_cast(u32x4, __builtin_convertvector(x8, bfv8_)); }
            return;
        }
        ST_BLOCK_SETUP(st);
        bf16_t* op = O + (size_t)(u.pm * 256 + wr * 64 + rrow) * ldc + u.pn * 256 + wc * 64 + rp * 8;
#pragma unroll
        for (int ai = 0; ai < 2; ++ai)
#pragma unroll
            for (int m = 0; m < 4; ++m) { u32x4 wq[2];
#pragma unroll
                for (int bj = 0; bj < 2; ++bj) { const f32x4 v0 = acc[ai][bj][m][0], v1 = acc[ai][bj][m][1];
                    const fv8_ x8 = {v0[0], v0[1], v0[2], v0[3], v1[0], v1[1], v1[2], v1[3]};
                    wq[bj] = __builtin_bit_cast(u32x4, __builtin_convertvector(x8, bfv8_)); }
                st_block_bf16(sw, woff, roff, wq[0], wq[1], op + (size_t)(ai * 128 + m * 16) * ldc, ldc); }
    }
};
struct EpiLora {
    static constexpr bool PERM = true, AFTER_DRAIN = false;
    bf16_t* O; const float* w0; const float* a0;
    __device__ __forceinline__ void operator()(const f32x4 (&acc)[2][2][4][2], const Unit& u, int wr, int wc, int fr, int fq) const {
        const int row0 = u.pm * 256 + wr * 64 + fr, col0 = u.pn * 256 + wc * 64 + 8 * fq;
        const int region = u.pn >> 3;
        f32x4 bv[2][2];
#pragma unroll
        for (int bj = 0; bj < 2; ++bj)
#pragma unroll
            for (int n = 0; n < 2; ++n) { const int c = col0 + bj * 32 + 4 * n;
                bv[bj][n] = region == 0 ? *(const f32x4*)(w0 + c) : (region == 1 ? *(const f32x4*)(a0 + (c - 2048)) : (f32x4){0.f, 0.f, 0.f, 0.f}); }
#pragma unroll
        for (int ai = 0; ai < 2; ++ai)
#pragma unroll
            for (int m = 0; m < 4; ++m) { bf16_t* rowp = O + (size_t)(row0 + ai * 128 + m * 16) * LORA_N + col0;
#pragma unroll
                for (int bj = 0; bj < 2; ++bj) { f32x4 v0 = acc[ai][bj][m][0] + bv[bj][0], v1 = acc[ai][bj][m][1] + bv[bj][1];
                    if (region < 2) {
                        const float sc = region == 0 ? -0.6065306597126334f : 1.0f;
#pragma unroll
                        for (int j = 0; j < 4; ++j) { v0[j] = sc * sigmoidf_(v0[j]); v1[j] = sc * sigmoidf_(v1[j]); }
                    }
                    u32x4 w; w.x = cvt_pk_bf16(v0[0], v0[1]); w.y = cvt_pk_bf16(v0[2], v0[3]); w.z = cvt_pk_bf16(v1[0], v1[1]); w.w = cvt_pk_bf16(v1[2], v1[3]);
                    *(u32x4*)(rowp + bj * 32) = w; } }
    }
};
struct BranchOrder {
    pg8::StaticOrder S0;
    __device__ __forceinline__ void init(int M, int N, int G_, int c_) { S0.init(M, N, G_, c_); }
    __device__ __forceinline__ bool next(int i, Unit& u) const { if (i >= 4) return false; Unit t; if (!S0.next(0, t)) return false; u.pm = t.pm; u.pn = i * 4 + t.pn; return true; }
    __device__ __forceinline__ void a_ready(const Unit&) const {}
    __device__ __forceinline__ void done(const Unit&) const {}
};
struct EpiBranchAll {
    static constexpr bool PERM = true, AFTER_DRAIN = false;
    const bf16_t* gateP;
    bf16_t* mbP; bf16_t* mb; LAS unsigned char* st;
    __device__ __forceinline__ void operator()(const f32x4 (&acc)[2][2][4][2], const Unit& u, int wr, int wc, int fr, int fq) const {
        const int wv8 = wr * 4 + wc, ln = fq * 16 + fr, br = u.pn >> 2, pn = u.pn & 3, MODE = br == 0 ? 0 : (br == 3 ? 2 : 1);
        const u32x4* gp = (const u32x4*)gateP + ((size_t)((u.pm * 16 + br * 4 + pn) * 8 + wv8) * 16) * 64 + ln;
        u32x4* mp = (u32x4*)mbP + ((size_t)((u.pm * 4 + pn) * 8 + wv8) * 16) * 64 + ln;
        u32x4 gw[2][4][2];
#pragma unroll
        for (int ai = 0; ai < 2; ++ai)
#pragma unroll
            for (int m = 0; m < 4; ++m)
#pragma unroll
                for (int bj = 0; bj < 2; ++bj) gw[ai][m][bj] = gp[((ai * 4 + m) * 2 + bj) * 64];
        asm volatile("" ::: "memory");
        f32x4 v[2][4][2][2];
#pragma unroll
        for (int ai = 0; ai < 2; ++ai)
#pragma unroll
            for (int m = 0; m < 4; ++m)
#pragma unroll
                for (int bj = 0; bj < 2; ++bj) { const u32x4 g = gw[ai][m][bj]; f32x4 g0, g1;
                    g0[0] = sigmoidf_(bflo(g.x)); g0[1] = sigmoidf_(bfhi(g.x)); g0[2] = sigmoidf_(bflo(g.y)); g0[3] = sigmoidf_(bfhi(g.y));
                    g1[0] = sigmoidf_(bflo(g.z)); g1[1] = sigmoidf_(bfhi(g.z)); g1[2] = sigmoidf_(bflo(g.w)); g1[3] = sigmoidf_(bfhi(g.w));
                    v[ai][m][bj][0] = acc[ai][bj][m][0] * g0; v[ai][m][bj][1] = acc[ai][bj][m][1] * g1; }
        if (MODE >= 1) {
#pragma unroll
            for (int ai = 0; ai < 2; ++ai)
#pragma unroll
                for (int m = 0; m < 4; ++m)
#pragma unroll
                    for (int bj = 0; bj < 2; ++bj) gw[ai][m][bj] = mp[((ai * 4 + m) * 2 + bj) * 64];
            asm volatile("" ::: "memory");
#pragma unroll
            for (int ai = 0; ai < 2; ++ai)
#pragma unroll
                for (int m = 0; m < 4; ++m)
#pragma unroll
                    for (int bj = 0; bj < 2; ++bj) { const u32x4 o = gw[ai][m][bj];
                        v[ai][m][bj][0][0] += bflo(o.x); v[ai][m][bj][0][1] += bfhi(o.x); v[ai][m][bj][0][2] += bflo(o.y); v[ai][m][bj][0][3] += bfhi(o.y);
                        v[ai][m][bj][1][0] += bflo(o.z); v[ai][m][bj][1][1] += bfhi(o.z); v[ai][m][bj][1][2] += bflo(o.w); v[ai][m][bj][1][3] += bfhi(o.w); }
        }
        if (MODE < 2) {
#pragma unroll
            for (int ai = 0; ai < 2; ++ai)
#pragma unroll
                for (int m = 0; m < 4; ++m)
#pragma unroll
                    for (int bj = 0; bj < 2; ++bj) { const f32x4 v0 = v[ai][m][bj][0], v1 = v[ai][m][bj][1];
                        u32x4 w; w.x = cvt_pk_bf16(v0[0], v0[1]); w.y = cvt_pk_bf16(v0[2], v0[3]); w.z = cvt_pk_bf16(v1[0], v1[1]); w.w = cvt_pk_bf16(v1[2], v1[3]);
                        mp[((ai * 4 + m) * 2 + bj) * 64] = w; }
        } else {
            ST_BLOCK_SETUP(st);
            bf16_t* op = mb + (size_t)(u.pm * 256 + wr * 64 + rrow) * DM + pn * 256 + wc * 64 + rp * 8;
#pragma unroll
            for (int ai = 0; ai < 2; ++ai)
#pragma unroll
                for (int m = 0; m < 4; ++m) { u32x4 wq[2];
#pragma unroll
                    for (int bj = 0; bj < 2; ++bj) { const f32x4 v0 = v[ai][m][bj][0], v1 = v[ai][m][bj][1];
                        wq[bj].x = cvt_pk_bf16(v0[0], v0[1]); wq[bj].y = cvt_pk_bf16(v0[2], v0[3]); wq[bj].z = cvt_pk_bf16(v1[0], v1[1]); wq[bj].w = cvt_pk_bf16(v1[2], v1[3]); }
                    st_block_bf16(sw, woff, roff, wq[0], wq[1], op + (size_t)(ai * 128 + m * 16) * DM, DM); }
        }
    }
};
struct EpiResid {
    static constexpr bool PERM = true, AFTER_DRAIN = false;
    const float* xf; float* o;
    __device__ __forceinline__ void operator()(const f32x4 (&acc)[2][2][4][2], const Unit& u, int wr, int wc, int fr, int fq) const {
        const int row0 = u.pm * 256 + wr * 64 + fr, col0 = u.pn * 256 + wc * 64 + 8 * fq;
#pragma unroll
        for (int ai = 0; ai < 2; ++ai) {
            f32x4 xv[4][2][2];
#pragma unroll
            for (int m = 0; m < 4; ++m)
#pragma unroll
                for (int bj = 0; bj < 2; ++bj) { const size_t off = (size_t)(row0 + ai * 128 + m * 16) * DM + col0 + bj * 32; xv[m][bj][0] = *(const f32x4*)(xf + off); xv[m][bj][1] = *(const f32x4*)(xf + off + 4); }
            asm volatile("" ::: "memory");
#pragma unroll
            for (int m = 0; m < 4; ++m)
#pragma unroll
                for (int bj = 0; bj < 2; ++bj) { const size_t off = (size_t)(row0 + ai * 128 + m * 16) * DM + col0 + bj * 32;
                    *(f32x4*)(o + off) = xv[m][bj][0] * DN_ALPHA + acc[ai][bj][m][0]; *(f32x4*)(o + off + 4) = xv[m][bj][1] * DN_ALPHA + acc[ai][bj][m][1]; }
            asm volatile("" ::: "memory");
        }
    }
};
constexpr float W8_SCALE = 64.0f, H8_SCALE = 16.0f;
constexpr int E8_ONE = 0x7F7F7F7F, E8_W = 0x79797979  , E8_H = 0x7B7B7B7B  ;
__device__ __forceinline__ unsigned pk_fp8x4(float a, float b, float c, float d) { int w = __builtin_amdgcn_cvt_pk_fp8_f32(a, b, 0, false); w = __builtin_amdgcn_cvt_pk_fp8_f32(c, d, w, true); return (unsigned)w; }
struct EpiSwiGLU {
    static constexpr bool PERM = true, AFTER_DRAIN = false;
    unsigned char* H;
    __device__ __forceinline__ void operator()(const f32x4 (&acc)[2][2][4][2], const Unit& u, int wr, int wc, int fr, int fq) const {
        const int row0 = u.pm * 256 + wr * 64 + fr, col0 = (u.pn & 15) * 128 + wc * 32 + 8 * fq;
#pragma unroll
        for (int ai = 0; ai < 2; ++ai)
#pragma unroll
            for (int m = 0; m < 4; ++m) { unsigned char* rowp = H + (size_t)(row0 + ai * 128 + m * 16) * DEXP + col0;
                f32x4 v[2];
#pragma unroll
                for (int n = 0; n < 2; ++n)
#pragma unroll
                    for (int j = 0; j < 4; ++j) { const float g = acc[ai][0][m][n][j], up = acc[ai][1][m][n][j]; v[n][j] = g * sigmoidf_(g) * up * H8_SCALE; }
                u32x2 w; w.x = pk_fp8x4(v[0][0], v[0][1], v[0][2], v[0][3]); w.y = pk_fp8x4(v[1][0], v[1][1], v[1][2], v[1][3]);
                *(u32x2*)rowp = w; }
    }
};
struct EpiDown {
    static constexpr bool PERM = true, AFTER_DRAIN = false;
    bf16_t* Y;
    __device__ __forceinline__ void operator()(const f32x4 (&acc)[2][2][4][2], const Unit& u, int wr, int wc, int fr, int fq) const {
        const int row0 = u.pm * 256 + wr * 64 + fr, col0 = (u.pn & 3) * 256 + wc * 64 + 8 * fq;
        typedef float fv8_ __attribute__((ext_vector_type(8))); typedef __bf16 bfv8_ __attribute__((ext_vector_type(8)));
#pragma unroll
        for (int ai = 0; ai < 2; ++ai)
#pragma unroll
            for (int m = 0; m < 4; ++m) { bf16_t* rowp = Y + (size_t)(row0 + ai * 128 + m * 16) * DM + col0;
#pragma unroll
                for (int bj = 0; bj < 2; ++bj) { const f32x4 v0 = acc[ai][bj][m][0], v1 = acc[ai][bj][m][1];
                    const fv8_ x8 = {v0[0], v0[1], v0[2], v0[3], v1[0], v1[1], v1[2], v1[3]};
                    *(u32x4*)(rowp + bj * 32) = __builtin_bit_cast(u32x4, __builtin_convertvector(x8, bfv8_)); } }
    }
};

__device__ __forceinline__ int wcont_row(int gn) { return (gn & ~255) | (((gn >> 5) & 1) << 7) | (((gn >> 6) & 3) << 5) | (gn & 31); }
__device__ __forceinline__ void tconv(const float* __restrict__ src, int nb, int K, int N, bf16_t* __restrict__ dst, size_t dst_bs, int ldd, int blk, int bstride, int boff, float* tile, int wv) {
    const int tid = otid(wv), ntn = N >> 8, tpb = (K >> 6) * ntn, nt = nb * tpb;
    f32x4 v[8];
#define TC_LOAD(t_) do { const int bi_ = (t_) / tpb, tr_ = (t_) % tpb, k0_ = (tr_ / ntn) * 64, n0_ = (tr_ % ntn) * 256; const float* sb_ = src + (size_t)bi_ * K * N; \
        _Pragma("unroll") for (int i = 0; i < 8; ++i) { const int kk = i * 8 + (tid >> 6), nn = (tid & 63) * 4; v[i] = *(const f32x4*)(sb_ + (size_t)(k0_ + kk) * N + n0_ + nn); } } while (0)
    int t = blockIdx.x;
    if (t < nt) TC_LOAD(t);
    for (; t < nt; t += gridDim.x) {
        const int bi = t / tpb, tr = t % tpb, k0 = (tr / ntn) * 64, n0 = (tr % ntn) * 256;
#pragma unroll
        for (int i = 0; i < 8; ++i) { const int kk = i * 8 + (tid >> 6), nn = (tid & 63) * 4; float* tp = tile + kk * 257 + nn; tp[0] = v[i][0]; tp[1] = v[i][1]; tp[2] = v[i][2]; tp[3] = v[i][3]; }
        __syncthreads();
        if (t + (int)gridDim.x < nt) TC_LOAD(t + (int)gridDim.x);
        bf16_t* db = dst + (size_t)bi * dst_bs;
#pragma unroll
        for (int j = 0; j < 4; ++j) { const int q = tid + 512 * j, n = q >> 3, kc = q & 7; const float* s = tile + (kc * 8) * 257 + n;
            u32x4 o; o.x = cvt_pk_bf16(s[0], s[257]); o.y = cvt_pk_bf16(s[2 * 257], s[3 * 257]); o.z = cvt_pk_bf16(s[4 * 257], s[5 * 257]); o.w = cvt_pk_bf16(s[6 * 257], s[7 * 257]);
            const int gn = n0 + n, drow = blk == (1 << 30) ? wcont_row(gn) : (gn / blk) * bstride + boff + (gn % blk);
            *(u32x4*)(db + (size_t)drow * ldd + k0 + kc * 8) = o; }
        __syncthreads();
    }
#undef TC_LOAD
}
__device__ __forceinline__ void tconv8(const float* __restrict__ src, int nb, int K, int N, unsigned char* __restrict__ dst, size_t dst_bs, int ldd, int blk, int bstride, int boff, float sc, float* tile, int wv) {
    const int tid = otid(wv), ntn = N >> 7, tpb = (K >> 7) * ntn, nt = nb * tpb;
    f32x4 v[8];
#define TC_LOAD(t_) do { const int bi_ = (t_) / tpb, tr_ = (t_) % tpb, k0_ = (tr_ / ntn) * 128, n0_ = (tr_ % ntn) * 128; const float* sb_ = src + (size_t)bi_ * K * N; \
        _Pragma("unroll") for (int i = 0; i < 8; ++i) { const int kk = i * 16 + (tid >> 5), nn = (tid & 31) * 4; v[i] = *(const f32x4*)(sb_ + (size_t)(k0_ + kk) * N + n0_ + nn); } } while (0)
    int t = blockIdx.x;
    if (t < nt) TC_LOAD(t);
    for (; t < nt; t += gridDim.x) {
        const int bi = t / tpb, tr = t % tpb, k0 = (tr / ntn) * 128, n0 = (tr % ntn) * 128;
#pragma unroll
        for (int i = 0; i < 8; ++i) { const int kk = i * 16 + (tid >> 5), nn = (tid & 31) * 4; float* tp = tile + kk * 129 + nn; tp[0] = v[i][0]; tp[1] = v[i][1]; tp[2] = v[i][2]; tp[3] = v[i][3]; }
        __syncthreads();
        if (t + (int)gridDim.x < nt) TC_LOAD(t + (int)gridDim.x);
        unsigned char* db = dst + (size_t)bi * dst_bs;
#pragma unroll
        for (int j = 0; j < 2; ++j) { const int q = tid + 512 * j, n = q >> 3, kc = q & 7; const float* s = tile + (kc * 16) * 129 + n;
            u32x4 o;
            o.x = pk_fp8x4(s[0] * sc, s[129] * sc, s[2 * 129] * sc, s[3 * 129] * sc); o.y = pk_fp8x4(s[4 * 129] * sc, s[5 * 129] * sc, s[6 * 129] * sc, s[7 * 129] * sc);
            o.z = pk_fp8x4(s[8 * 129] * sc, s[9 * 129] * sc, s[10 * 129] * sc, s[11 * 129] * sc); o.w = pk_fp8x4(s[12 * 129] * sc, s[13 * 129] * sc, s[14 * 129] * sc, s[15 * 129] * sc);
            const int gn = n0 + n, drow = blk == (1 << 30) ? wcont_row(gn) : (gn / blk) * bstride + boff + (gn % blk);
            *(u32x4*)(db + (size_t)drow * ldd + k0 + kc * 16) = o; }
        __syncthreads();
    }
#undef TC_LOAD
}

__device__ __forceinline__ void phase_convert(const Params& P, float* ldsf) {
    unsigned char* ws = kws();
    const int NOBLK = 1 << 30;
    tconv(kin(I_WIN), DEPTH, DM, INC, (bf16_t*)(ws + WS_WIN), (size_t)INC * DM, DM, NOBLK, 0, 0, ldsf, P.pad0);
    tconv(kin(I_WBR), DEPTH, BRK, DM, (bf16_t*)(ws + WS_WBR), (size_t)DM * BRK, BRK, NOBLK, 0, 0, ldsf, P.pad0);
    tconv(kin(I_WOUT), DEPTH, DM, DM, (bf16_t*)(ws + WS_WOUT), (size_t)DM * DM, DM, NOBLK, 0, 0, ldsf, P.pad0);
    tconv(kin(I_WKV), DEPTH, DM, 512, (bf16_t*)(ws + WS_WKV), (size_t)512 * DM, DM, NOBLK, 0, 0, ldsf, P.pad0);
    tconv8(kin(I_EWG), DEPTH * NEXP, DM, DEXP, ws + WS_WGU, (size_t)4096 * DM, DM, 128, 256, 0, W8_SCALE, ldsf, P.pad0);
    tconv8(kin(I_EWU), DEPTH * NEXP, DM, DEXP, ws + WS_WGU, (size_t)4096 * DM, DM, 128, 256, 128, W8_SCALE, ldsf, P.pad0);
    tconv8(kin(I_EWD), DEPTH * NEXP, DEXP, DM, ws + WS_WDN, (size_t)DM * DEXP, DEXP, NOBLK, 0, 0, W8_SCALE, ldsf, P.pad0);
    for (int l = 0; l < DEPTH; ++l) {
        bf16_t* wl = (bf16_t*)(ws + WS_WLORA) + (size_t)l * LORA_N * 256;
        tconv(kin(I_WUP) + (size_t)l * 2 * 64 * 1024, 2, 64, 1024, wl, (size_t)1024 * 256, 256, NOBLK, 0, 0, ldsf, P.pad0);
        tconv(kin(I_AUP) + (size_t)l * 2 * 64 * 1024, 2, 64, 1024, wl + (size_t)2048 * 256 + 64, (size_t)1024 * 256, 256, NOBLK, 0, 0, ldsf, P.pad0);
        tconv(kin(I_GUP) + (size_t)l * 128 * 1024, 1, 128, 1024, wl + (size_t)4096 * 256 + 128, 0, 256, NOBLK, 0, 0, ldsf, P.pad0);
    }
    const size_t gtid = (size_t)blockIdx.x * NTHR + otid(P.pad0), gsz = (size_t)gridDim.x * NTHR;
    { u32x4* wl4 = (u32x4*)(ws + WS_WLORA); const u32x4 zz = {0u, 0u, 0u, 0u};
      for (size_t i = gtid; i < (size_t)DEPTH * LORA_N * 32; i += gsz) { const int k8 = (int)(i & 31), n = (int)((i >> 5) % LORA_N);
          const bool blockpart = n < 2048 ? (k8 < 8) : (n < 4096 ? (k8 >= 8 && k8 < 16) : (k8 >= 16));
          if (!blockpart) wl4[i] = zz; } }
    { const f32x4* x4 = (const f32x4*)kin(I_X); f32x4* xf4 = (f32x4*)(ws + WS_XF); u32x2* xb2 = (u32x2*)(ws + WS_XB);
      for (size_t i0 = gtid; i0 < (size_t)NTOK * DM / 4; i0 += gsz * 8) { f32x4 v[8];
#pragma unroll
          for (int q = 0; q < 8; ++q) { const size_t i = i0 + q * gsz; v[q] = i < (size_t)NTOK * DM / 4 ? x4[i] : (f32x4){0.f, 0.f, 0.f, 0.f}; }
#pragma unroll
          for (int q = 0; q < 8; ++q) { const size_t i = i0 + q * gsz; if (i < (size_t)NTOK * DM / 4) { xf4[i] = v[q]; u32x2 w; w.x = cvt_pk_bf16(v[q][0], v[q][1]); w.y = cvt_pk_bf16(v[q][2], v[q][3]); xb2[i] = w; } } } }
    { const f32x4* m4 = (const f32x4*)kin(I_MEM); u32x2* mb2 = (u32x2*)(ws + WS_MEMB);
      for (size_t i = gtid; i < (size_t)NBATCH * NMEM * DM / 4; i += gsz) { const f32x4 v = m4[i]; u32x2 w; w.x = cvt_pk_bf16(v[0], v[1]); w.y = cvt_pk_bf16(v[2], v[3]); mb2[i] = w; } }
}

__device__ __forceinline__ void phase_prepass(const Params& P, int l) {
    const bf16_t* p = (const bf16_t*)(kws() + WS_P); bf16_t* ap = (bf16_t*)(kws() + WS_APR);
    const float* mu = kin(I_MU) + (size_t)l * 2 * RWC;
    const int gtid = blockIdx.x * NTHR + otid(P.pad0), gsz = gridDim.x * NTHR;
    const int jg = gtid & 63, col = C_DW + jg * 4;
    const f32x4 m0 = *(const f32x4*)(mu + col), m1 = *(const f32x4*)(mu + RWC + col);
    for (int t0 = gtid >> 6; t0 < NTOK; t0 += (gsz >> 6) * 4) {
        u32x2 xc[4], xp[4], xn[4];
#pragma unroll
        for (int q = 0; q < 4; ++q) { const int tok = t0 + q * (gsz >> 6); const int tk = tok < NTOK ? tok : 0; const int s = tk & (SEQ - 1); const bf16_t* pr = p + (size_t)tk * INC + col; const u32x2 zz = {0u, 0u};
            xc[q] = *(const u32x2*)pr; xp[q] = s > 0 ? *(const u32x2*)(pr - INC) : zz; xn[q] = s < SEQ - 1 ? *(const u32x2*)(pr + INC) : zz; }
#pragma unroll
        for (int q = 0; q < 4; ++q) { const int tok = t0 + q * (gsz >> 6);
            f32x4 x, a, b;
            x[0] = bflo(xc[q].x); x[1] = bfhi(xc[q].x); x[2] = bflo(xc[q].y); x[3] = bfhi(xc[q].y);
            a[0] = bflo(xp[q].x); a[1] = bfhi(xp[q].x); a[2] = bflo(xp[q].y); a[3] = bfhi(xp[q].y);
            b[0] = bflo(xn[q].x); b[1] = bfhi(xn[q].x); b[2] = bflo(xn[q].y); b[3] = bfhi(xn[q].y);
            f32x4 v = x + m0 * (a - x) + m1 * (b - x);
            if (jg < 16) {
#pragma unroll
                for (int j = 0; j < 4; ++j) v[j] = 1.0f - 2.0f * __builtin_amdgcn_rcpf(1.0f + __expf(2.0f * v[j]));
            } else if (jg >= 32) {
#pragma unroll
                for (int j = 0; j < 4; ++j) v[j] = sigmoidf_(v[j]);
            }
            if (tok < NTOK) { typedef __bf16 bf4_ __attribute__((ext_vector_type(4)));
                *(bf4_*)(ap + (size_t)tok * 256 + jg * 4) = __builtin_convertvector(v, bf4_); } }
    }
}

__device__ __forceinline__ void phase_post(const Params& P, int l) {
    const bf16_t* p = (const bf16_t*)(kws() + WS_P); const bf16_t* lora = (const bf16_t*)(kws() + WS_LORA);
    const bf16_t* ydir = (const bf16_t*)(kws() + WS_YDIR); const float* bonus = (const float*)(kws() + WS_BONUS);
    bf16_t* ycat = (bf16_t*)(kws() + WS_YCAT);
    const int tid = otid(P.pad0), lane = tid & 63, wid = tid >> 6;
    const float* mu = kin(I_MU) + (size_t)l * 2 * RWC;
    const int gw = blockIdx.x * 8 + wid, ngw = gridDim.x * 8;
    { const int hg = gw & 3, c4 = hg * 256 + lane * 4, h = hg * 4 + (lane >> 4);
      const f32x4 gng = *(const f32x4*)(kin(I_GNG) + l * 1024 + c4), gnb = *(const f32x4*)(kin(I_GNB) + l * 1024 + c4);
      const f32x4 mu0 = *(const f32x4*)(mu + C_V + c4), mu1 = *(const f32x4*)(mu + RWC + C_V + c4);
      for (int t0 = gw >> 2; t0 < NTOK; t0 += (ngw >> 2) * 4) {
          f32x4 y[4]; u32x2 vc[4], vp[4], vn[4], gg[4]; float bon[4]; bool ok[4];
#pragma unroll
          for (int q = 0; q < 4; ++q) { const int tok = t0 + q * (ngw >> 2); ok[q] = tok < NTOK; const int tk = ok[q] ? tok : 0; const int s = tk & (SEQ - 1);
              { const u32x2 y0 = *(const u32x2*)(ydir + (size_t)tk * DM + c4), y1 = *(const u32x2*)(ydir + ((size_t)NTOK + tk) * DM + c4);
                y[q][0] = bflo(y0.x) + bflo(y1.x); y[q][1] = bfhi(y0.x) + bfhi(y1.x); y[q][2] = bflo(y0.y) + bflo(y1.y); y[q][3] = bfhi(y0.y) + bfhi(y1.y); }
              const bf16_t* pv = p + (size_t)tk * INC + C_V + c4; const u32x2 zz = {0u, 0u};
              vc[q] = *(const u32x2*)pv; vp[q] = s > 0 ? *(const u32x2*)(pv - INC) : zz; vn[q] = s < SEQ - 1 ? *(const u32x2*)(pv + INC) : zz;
              gg[q] = *(const u32x2*)(lora + (size_t)tk * LORA_N + 4096 + c4);
              bon[q] = bonus[(size_t)tk * 16 + h] + bonus[((size_t)NTOK + tk) * 16 + h]; }
#pragma unroll
          for (int q = 0; q < 4; ++q) { const int tok = t0 + q * (ngw >> 2);
              const float mean = sum16((y[q][0] + y[q][1]) + (y[q][2] + y[q][3])) * (1.0f / 64.0f); const f32x4 dy = y[q] - mean;
              const float var = sum16((dy[0] * dy[0] + dy[1] * dy[1]) + (dy[2] * dy[2] + dy[3] * dy[3])) * (1.0f / 64.0f);
              const f32x4 yn = dy * rsqrtf(var + 64e-5f) * gng + gnb;
              f32x4 v, vpv, vnx, g;
              v[0] = bflo(vc[q].x); v[1] = bfhi(vc[q].x); v[2] = bflo(vc[q].y); v[3] = bfhi(vc[q].y);
              vpv[0] = bflo(vp[q].x); vpv[1] = bfhi(vp[q].x); vpv[2] = bflo(vp[q].y); vpv[3] = bfhi(vp[q].y);
              vnx[0] = bflo(vn[q].x); vnx[1] = bfhi(vn[q].x); vnx[2] = bflo(vn[q].y); vnx[3] = bfhi(vn[q].y);
              g[0] = bflo(gg[q].x); g[1] = bfhi(gg[q].x); g[2] = bflo(gg[q].y); g[3] = bfhi(gg[q].y);
              const f32x4 vs = v + mu0 * (vpv - v) + mu1 * (vnx - v);
              const f32x4 o = (yn + vs * bon[q]) * g;
              if (ok[q]) { u32x2 w; w.x = cvt_pk_bf16(o[0], o[1]); w.y = cvt_pk_bf16(o[2], o[3]); *(u32x2*)(ycat + (size_t)tok * BRK + c4) = w; } }
      } }
}

__device__ __forceinline__ void phase_ln1(const Params& P, int l, float* ldsf) {
    const float* pre = (const float*)(kws() + WS_PRELN); float* xf = (float*)(kws() + WS_XF); bf16_t* xb = (bf16_t*)(kws() + WS_XB); float* aff = (float*)(kws() + WS_AFF);
    const float* g = kin(I_LN1G) + l * DM; const float* bt = kin(I_LN1B) + l * DM; const float* router = kin(I_ROUTER) + (size_t)l * DM * 16;
    const int tid = otid(P.pad0), lane = tid & 63, wid = tid >> 6;
    { f32x4 tmp[8];
#pragma unroll
      for (int k8 = 0; k8 < 8; ++k8) tmp[k8] = ((const f32x4*)router)[tid + k8 * NTHR];
#pragma unroll
      for (int k8 = 0; k8 < 8; ++k8) { const int i = tid + k8 * NTHR, d = i >> 2, e0 = (i & 3) * 4; ldsf[(e0 + 0) * DM + d] = tmp[k8][0]; ldsf[(e0 + 1) * DM + d] = tmp[k8][1]; ldsf[(e0 + 2) * DM + d] = tmp[k8][2]; ldsf[(e0 + 3) * DM + d] = tmp[k8][3]; } }
    __syncthreads();
    f32x4 gv[4], bv[4];
#pragma unroll
    for (int i = 0; i < 4; ++i) { gv[i] = *(const f32x4*)(g + lane * 4 + 256 * i); bv[i] = *(const f32x4*)(bt + lane * 4 + 256 * i); }
    const int row_first = blockIdx.x * 8 + wid, row_step = gridDim.x * 8;
    f32x4 vnx[4];
    if (row_first < NTOK) {
#pragma unroll
        for (int i = 0; i < 4; ++i) vnx[i] = *(const f32x4*)(pre + (size_t)row_first * DM + lane * 4 + 256 * i);
    }
    for (int row = row_first; row < NTOK; row += row_step) {
        f32x4 v[4]; float s = 0.f;
#pragma unroll
        for (int i = 0; i < 4; ++i) { v[i] = vnx[i]; s += (v[i][0] + v[i][1]) + (v[i][2] + v[i][3]); }
        if (row + row_step < NTOK) {
#pragma unroll
            for (int i = 0; i < 4; ++i) vnx[i] = *(const f32x4*)(pre + (size_t)(row + row_step) * DM + lane * 4 + 256 * i);
        }
        const float mean = wave_sum(s) * (1.0f / DM); float s2 = 0.f;
#pragma unroll
        for (int i = 0; i < 4; ++i) { v[i] = v[i] - mean; s2 += (v[i][0] * v[i][0] + v[i][1] * v[i][1]) + (v[i][2] * v[i][2] + v[i][3] * v[i][3]); }
        const float rstd = rsqrtf(wave_sum(s2) * (1.0f / DM) + 1e-5f);
        float lg[16];
#pragma unroll
        for (int e = 0; e < 16; ++e) lg[e] = 0.f;
#pragma unroll
        for (int i = 0; i < 4; ++i) { v[i] = v[i] * rstd * gv[i] + bv[i];
            *(f32x4*)(xf + (size_t)row * DM + lane * 4 + 256 * i) = v[i];
            u32x2 w; w.x = cvt_pk_bf16(v[i][0], v[i][1]); w.y = cvt_pk_bf16(v[i][2], v[i][3]); *(u32x2*)(xb + (size_t)row * DM + lane * 4 + 256 * i) = w;
#pragma unroll
            for (int e = 0; e < 16; ++e) { const f32x4 r = *(const f32x4*)(ldsf + e * DM + lane * 4 + 256 * i); lg[e] += (v[i][0] * r[0] + v[i][1] * r[1]) + (v[i][2] * r[2] + v[i][3] * r[3]); } }
        const int lid = lane_id();
#define LN_HALVE(M, H) do { const bool up_ = (lid & (M)) != 0; _Pragma("unroll") for (int j = 0; j < (H); ++j) { const float send_ = up_ ? lg[j] : lg[j + (H)], keep_ = up_ ? lg[j + (H)] : lg[j]; \
            lg[j] = keep_ + __builtin_bit_cast(float, __builtin_amdgcn_ds_bpermute((lid ^ (M)) << 2, __builtin_bit_cast(int, send_))); } } while (0)
        LN_HALVE(32, 8); LN_HALVE(16, 4); LN_HALVE(8, 2); LN_HALVE(4, 1);
#undef LN_HALVE
        float tot = lg[0];
        tot += __builtin_bit_cast(float, __builtin_amdgcn_ds_bpermute((lid ^ 2) << 2, __builtin_bit_cast(int, tot)));
        tot += __builtin_bit_cast(float, __builtin_amdgcn_ds_bpermute((lid ^ 1) << 2, __builtin_bit_cast(int, tot)));
        float mx = tot;
#pragma unroll
        for (int M = 4; M < 64; M <<= 1) mx = fmaxf(mx, __builtin_bit_cast(float, __builtin_amdgcn_ds_bpermute((lid ^ M) << 2, __builtin_bit_cast(int, mx))));
        const float ex = expf(tot - mx); float se = ex;
#pragma unroll
        for (int M = 4; M < 64; M <<= 1) se += __builtin_bit_cast(float, __builtin_amdgcn_ds_bpermute((lid ^ M) << 2, __builtin_bit_cast(int, se)));
        const int eidx = ((lid >> 5) & 1) * 8 + ((lid >> 4) & 1) * 4 + ((lid >> 3) & 1) * 2 + ((lid >> 2) & 1);
        if ((lid & 3) == 0) aff[(size_t)row * 16 + eidx] = ex / se;
    }
    __syncthreads();
}
__device__ __forceinline__ void phase_ln2(const Params& P, int l) {
    float* xf = (float*)(kws() + WS_XF); bf16_t* xb = (bf16_t*)(kws() + WS_XB); const bf16_t* ye = (const bf16_t*)(kws() + WS_YE); const int* slot_of = (const int*)(kws() + WS_SLOT); const float* grow = (const float*)(kws() + WS_GROW);
    const float* g = kin(I_LN2G) + l * DM; const float* bt = kin(I_LN2B) + l * DM;
    float* dst = (l == DEPTH - 1) ? kout() : xf;
    const int tid = otid(P.pad0), lane = tid & 63, wid = __builtin_amdgcn_readfirstlane(tid >> 6);
    f32x4 gv[4], bv[4];
#pragma unroll
    for (int i = 0; i < 4; ++i) { gv[i] = *(const f32x4*)(g + lane * 4 + 256 * i); bv[i] = *(const f32x4*)(bt + lane * 4 + 256 * i); }
    const int gw = blockIdx.x * 8 + wid, ngw = gridDim.x * 8;
    for (int r0 = gw; r0 < NTOK; r0 += 4 * ngw) {
        const int rk = r0 + (lane >> 4) * ngw; const int slv = rk < NTOK ? slot_of[(size_t)rk * 16 + (lane & 15)] : -1;
        const unsigned long long m64 = __ballot(slv >= 0);
#pragma unroll
        for (int pr = 0; pr < 2; ++pr) {
            f32x4 v[2][4]; u32x2 tmp[2][4][4]; float gs[2][4]; int nv[2]; bool ok[2];
#pragma unroll
            for (int q = 0; q < 2; ++q) { const int k = pr * 2 + q; const int row = r0 + k * ngw; ok[q] = row < NTOK; const int rw = ok[q] ? row : 0; const int b = rw >> 11;
#pragma unroll
                for (int i = 0; i < 4; ++i) v[q][i] = *(const f32x4*)(xf + (size_t)rw * DM + lane * 4 + 256 * i);
                unsigned bits = ok[q] ? (unsigned)((m64 >> (16 * k)) & 0xFFFFull) : 0u; nv[q] = 0;
#pragma unroll
                for (int j = 0; j < 4; ++j) { if (bits) { const int e = __builtin_ctz(bits); bits &= bits - 1; const int sl = __builtin_amdgcn_readlane(slv, 16 * k + e);
                        const bf16_t* yr = ye + ((size_t)(e * 8 + b) * 256 + sl) * DM + lane * 4; gs[q][j] = grow[(e * 8 + b) * 256 + sl];
#pragma unroll
                        for (int i = 0; i < 4; ++i) tmp[q][j][i] = *(const u32x2*)(yr + 256 * i);
                        nv[q] = j + 1; } }
#pragma unroll
                for (int i = 0; i < 4; ++i) v[q][i] = v[q][i] * DN_ALPHA;
#pragma unroll
                for (int j = 0; j < 4; ++j) if (j < nv[q]) {
#pragma unroll
                    for (int i = 0; i < 4; ++i) { const u32x2 w = tmp[q][j][i]; const float gg = gs[q][j]; v[q][i][0] += gg * bflo(w.x); v[q][i][1] += gg * bfhi(w.x); v[q][i][2] += gg * bflo(w.y); v[q][i][3] += gg * bfhi(w.y); } }
                while (bits) { const int e = __builtin_ctz(bits); bits &= bits - 1; const int sl = __builtin_amdgcn_readlane(slv, 16 * k + e);
                    const bf16_t* yr = ye + ((size_t)(e * 8 + b) * 256 + sl) * DM + lane * 4; const float gg = grow[(e * 8 + b) * 256 + sl];
#pragma unroll
                    for (int i = 0; i < 4; ++i) { const u32x2 w = *(const u32x2*)(yr + 256 * i); v[q][i][0] += gg * bflo(w.x); v[q][i][1] += gg * bfhi(w.x); v[q][i][2] += gg * bflo(w.y); v[q][i][3] += gg * bfhi(w.y); } }
            }
#pragma unroll
            for (int q = 0; q < 2; ++q) { const int row = r0 + (pr * 2 + q) * ngw;
                float s = 0.f;
#pragma unroll
                for (int i = 0; i < 4; ++i) s += (v[q][i][0] + v[q][i][1]) + (v[q][i][2] + v[q][i][3]);
                const float mean = wave_sum(s) * (1.0f / DM); float s2 = 0.f;
#pragma unroll
                for (int i = 0; i < 4; ++i) { v[q][i] = v[q][i] - mean; s2 += (v[q][i][0] * v[q][i][0] + v[q][i][1] * v[q][i][1]) + (v[q][i][2] * v[q][i][2] + v[q][i][3] * v[q][i][3]); }
                const float rstd = rsqrtf(wave_sum(s2) * (1.0f / DM) + 1e-5f);
                if (ok[q]) {
#pragma unroll
                    for (int i = 0; i < 4; ++i) { const f32x4 o = v[q][i] * rstd * gv[i] + bv[i];
                        *(f32x4*)(dst + (size_t)row * DM + lane * 4 + 256 * i) = o;
                        if (l < DEPTH - 1) { u32x2 w; w.x = cvt_pk_bf16(o[0], o[1]); w.y = cvt_pk_bf16(o[2], o[3]); *(u32x2*)(xb + (size_t)row * DM + lane * 4 + 256 * i) = w; } } }
            }
        }
    }
}

__device__ __forceinline__ void phase_topk(const Params& P, unsigned long long* keys  ) {
    const float* aff = (const float*)(kws() + WS_AFF); float* grow = (float*)(kws() + WS_GROW); int* slot_of = (int*)(kws() + WS_SLOT);
    const bf16_t* xb = (const bf16_t*)(kws() + WS_XB); unsigned char* xe = kws() + WS_XE;
    const int tid = otid(P.pad0);
    for (int u = blockIdx.x; u < NBATCH * NEXP; u += gridDim.x) {
        const int b = u >> 4, e = u & 15;
#pragma unroll
        for (int j = 0; j < 4; ++j) { const int i = tid + 512 * j; const float v = aff[((size_t)b * SEQ + i) * 16 + e];
            keys[i] = ((unsigned long long)__float_as_uint(v) << 32) | (unsigned long long)(0xFFFFFFFFu - (unsigned)i); }
        __syncthreads();
        { const int wv_ = tid >> 6, ln_ = tid & 63;
          for (int k = 2; k <= SEQ; k <<= 1)
            for (int j = k >> 1; j > 0; j >>= 1) {
                if (j >= 256) __syncthreads();
#pragma unroll
                for (int t2 = 0; t2 < 2; ++t2) { const int t = wv_ * 128 + ln_ + 64 * t2; const int i = ((t & ~(j - 1)) << 1) | (t & (j - 1)), ixj = i | j;
                    const unsigned long long a = keys[i], c = keys[ixj]; const bool desc = (i & k) == 0;
                    if (desc ? (a < c) : (a > c)) { keys[i] = c; keys[ixj] = a; } }
                if (j >= 256) __syncthreads();
                else asm volatile("s_waitcnt lgkmcnt(0)" ::: "memory");
            }
          __syncthreads(); }
#pragma unroll
        for (int j = 0; j < 4; ++j) { const int r = tid + 512 * j; const unsigned long long kk = keys[r]; const int tl = (int)(0xFFFFFFFFu - (unsigned)(kk & 0xFFFFFFFFull));
            slot_of[((size_t)b * SEQ + tl) * 16 + e] = r < CAP ? r : -1;
            if (r < CAP) grow[(e * 8 + b) * CAP + r] = __uint_as_float((unsigned)(kk >> 32)); }
        for (int q0 = tid; q0 < CAP * 64; q0 += NTHR * 16) { u32x4 tmp[16][2];
#pragma unroll
            for (int k8 = 0; k8 < 16; ++k8) { const int q = q0 + k8 * NTHR, r = q >> 6, ch = q & 63; const int tl = (int)(0xFFFFFFFFu - (unsigned)(keys[r] & 0xFFFFFFFFull));
                const bf16_t* sp = xb + ((size_t)b * SEQ + tl) * DM + ch * 16; tmp[k8][0] = *(const u32x4*)sp; tmp[k8][1] = *(const u32x4*)(sp + 8); }
#pragma unroll
            for (int k8 = 0; k8 < 16; ++k8) { const int q = q0 + k8 * NTHR, r = q >> 6, ch = q & 63; u32x4 o;
#define BLO(w_) __uint_as_float((w_) << 16)
#define BHI(w_) __uint_as_float((w_) & 0xFFFF0000u)
                o.x = pk_fp8x4(BLO(tmp[k8][0].x), BHI(tmp[k8][0].x), BLO(tmp[k8][0].y), BHI(tmp[k8][0].y)); o.y = pk_fp8x4(BLO(tmp[k8][0].z), BHI(tmp[k8][0].z), BLO(tmp[k8][0].w), BHI(tmp[k8][0].w));
                o.z = pk_fp8x4(BLO(tmp[k8][1].x), BHI(tmp[k8][1].x), BLO(tmp[k8][1].y), BHI(tmp[k8][1].y)); o.w = pk_fp8x4(BLO(tmp[k8][1].z), BHI(tmp[k8][1].z), BLO(tmp[k8][1].w), BHI(tmp[k8][1].w));
#undef BLO
#undef BHI
                *(u32x4*)(xe + ((size_t)(e * 8 + b) * CAP + r) * DM + ch * 16) = o; } }
        __syncthreads();
    }
}

typedef float f32x16 __attribute__((ext_vector_type(16)));
__device__ __forceinline__ float xmax32(float v) { float a = v, b = v; asm volatile("s_nop 1\n\tv_permlane32_swap_b32 %0, %1\n\ts_nop 1" : "+v"(a), "+v"(b)); return fmaxf(fmaxf(v, a), b); }
typedef short bf16x8s __attribute__((ext_vector_type(8)));
typedef short s16x4 __attribute__((ext_vector_type(4)));
typedef __bf16 bfv8 __attribute__((ext_vector_type(8)));
typedef float fv8 __attribute__((ext_vector_type(8)));
constexpr int FA_KB = 8192;
constexpr float LOG2E = 1.4426950408889634f;
constexpr int FA_TP = 96, FA_TS = 452;
constexpr int FA_OFF_Q = 3 * 8192 + 2 * 64 * (128 * 2 + 64) + 24 * FA_TS * 4;
constexpr float FA_THR = 8.0f;

template <int DV, int MODE>
__device__ __forceinline__ void fa_core(LAS unsigned char* lds, int tid, const bf16_t* qrow  , const bf16_t* kbase, const bf16_t* vbase, size_t ldk,
                                        int tile0, int ntiles, int qw, int qi, const LAS float* btab, f32x16 (&o)[DV / 32], float& m, float& lsum) {
    constexpr int RSV = DV * 2 + 64;
    constexpr int VB = 64 * RSV;
    constexpr int NDB = DV / 32;
    constexpr int NVC = DV / 64;
    constexpr int OFF_K = 0, OFF_V = 3 * FA_KB;
    const int lane = tid & 63, r = lane & 31, hh = lane >> 5, wid = __builtin_amdgcn_readfirstlane(tid >> 6);
    LAS unsigned char* qlds = lds + FA_OFF_Q + wid * 4096 + lane * 16;
#pragma unroll
    for (int s = 0; s < 4; ++s) *(LAS bf16x8s*)(qlds + s * 1024) = *(const bf16x8s*)(qrow + 16 * s + 8 * hh);
    constexpr float c1 = 0.125f * LOG2E;
    const int krow = tid >> 3, kch = tid & 7;
    const unsigned kst = (unsigned)(krow * 128 + ((kch ^ ((krow >> 1) & 7)) * 16));
    u32x4 kreg; u32x4 vreg[NVC];
#define FA_LOADK(t) do { kreg = *(const u32x4*)(kbase + ((size_t)(t) * 64 + krow) * ldk + kch * 8); } while (0)
#define FA_LOADV(t) do { _Pragma("unroll") for (int i_ = 0; i_ < NVC; ++i_) { const int c_ = tid + 512 * i_; const int vr_ = c_ / (DV / 8), vc_ = c_ % (DV / 8); vreg[i_] = *(const u32x4*)(vbase + ((size_t)(t) * 64 + vr_) * ldk + vc_ * 8); } } while (0)
#define FA_STOREK(buf) do { *(LAS u32x4*)(lds + OFF_K + (buf) * FA_KB + kst) = kreg; } while (0)
#define FA_STOREV(buf) do { _Pragma("unroll") for (int i_ = 0; i_ < NVC; ++i_) { const int c_ = tid + 512 * i_; const int vr_ = c_ / (DV / 8), vc_ = c_ % (DV / 8); *(LAS u32x4*)(lds + OFF_V + (buf) * VB + vr_ * RSV + vc_ * 16) = vreg[i_]; } } while (0)
    const unsigned kread = (unsigned)(r * 128);
    const int ksw = (r >> 1) & 7;
    const unsigned vread = (unsigned)((4 * hh + ((lane & 15) >> 2)) * RSV + (16 * ((lane >> 4) & 1) + 4 * (lane & 3)) * 2);
#define FA_NEED(t) ((MODE != 0) || (((t) * 64 + 63 >= qw - 128) && ((t) * 64 <= qw + 31 + 128)))
    { FA_LOADK(tile0); const u32x4 k0_ = kreg; FA_LOADV(tile0); if (ntiles > 1) FA_LOADK(tile0 + 1);
      *(LAS u32x4*)(lds + OFF_K + kst) = k0_; FA_STOREV(0); if (ntiles > 1) FA_STOREK(1); }
    __syncthreads();
    if (ntiles > 2) FA_LOADK(tile0 + 2);
    if (ntiles > 1) FA_LOADV(tile0 + 1);
    if (wid >= 4) __builtin_amdgcn_s_barrier();
    int kb3 = 0;
    for (int it = 0; it < ntiles; ++it) {
        const int t = tile0 + it, k0 = t * 64;
        const bool need = FA_NEED(t);
        bf16x8s pf[2][2];
        if (need) {
            f32x16 sc0, sc1;
            { const LAS unsigned char* Kb_ = lds + OFF_K + kb3 * FA_KB;
#pragma unroll
              for (int i_ = 0; i_ < 16; ++i_) { sc0[i_] = 0.f; sc1[i_] = 0.f; }
              bf16x8s ka0[4], ka1[4], kq[4];
#pragma unroll
              for (int s_ = 0; s_ < 4; ++s_) { const unsigned co_ = (unsigned)(((2 * s_ + hh) ^ ksw) * 16);
                  ka0[s_] = *(const LAS bf16x8s*)(Kb_ + kread + co_); ka1[s_] = *(const LAS bf16x8s*)(Kb_ + 32 * 128 + kread + co_); kq[s_] = *(const LAS bf16x8s*)(qlds + s_ * 1024); }
              __builtin_amdgcn_sched_barrier(0);
#pragma unroll
              for (int s_ = 0; s_ < 4; ++s_) { sc0 = __builtin_amdgcn_mfma_f32_32x32x16_bf16(ka0[s_], kq[s_], sc0, 0, 0, 0); sc1 = __builtin_amdgcn_mfma_f32_32x32x16_bf16(ka1[s_], kq[s_], sc1, 0, 0, 0); }
              __builtin_amdgcn_sched_barrier(0); }
            if (MODE == 2) {
#pragma unroll
                for (int i = 0; i < 16; ++i) { sc0[i] *= c1; sc1[i] *= c1; }
            } else {
                const int rmin = k0 - (qw + 31), rmax = k0 + 63 - qw;
                if (rmin >= 129 || rmax <= -129) { const float bc = rmin >= 129 ? btab[258] : btab[0];
#pragma unroll
                    for (int i = 0; i < 16; ++i) { sc0[i] = sc0[i] * c1 + bc; sc1[i] = sc1[i] * c1 + bc; }
                } else { int rb = k0 + 4 * hh - qi + 129; asm volatile("" : "+v"(rb));
#pragma unroll
                    for (int g = 0; g < 4; ++g) {
#pragma unroll
                        for (int e = 0; e < 4; ++e) { const int i = 4 * g + e;
                            sc0[i] = sc0[i] * c1 + btab[rb + e + 8 * g]; sc1[i] = sc1[i] * c1 + btab[rb + e + 8 * g + 32]; }
                    }
                }
            }
            float mx = sc0[0];
#pragma unroll
            for (int i = 1; i < 16; ++i) mx = fmaxf(mx, sc0[i]);
#pragma unroll
            for (int i = 0; i < 16; ++i) mx = fmaxf(mx, sc1[i]);
            mx = xmax32(mx);
            if (__any(mx > m + FA_THR)) {
                const float mn = fmaxf(m, mx), corr = __builtin_amdgcn_exp2f(m - mn); m = mn; lsum *= corr;
#pragma unroll
                for (int d = 0; d < NDB; ++d)
#pragma unroll
                    for (int i = 0; i < 16; ++i) o[d][i] *= corr;
            }
            float ps = 0.f;
#pragma unroll
            for (int i = 0; i < 16; ++i) { sc0[i] = __builtin_amdgcn_exp2f(sc0[i] - m); sc1[i] = __builtin_amdgcn_exp2f(sc1[i] - m); ps += sc0[i] + sc1[i]; }
            lsum += ps;
#pragma unroll
            for (int s2 = 0; s2 < 2; ++s2) { fv8 x0, x1;
#pragma unroll
                for (int j = 0; j < 8; ++j) { x0[j] = sc0[8 * s2 + j]; x1[j] = sc1[8 * s2 + j]; }
                pf[0][s2] = __builtin_bit_cast(bf16x8s, __builtin_convertvector(x0, bfv8)); pf[1][s2] = __builtin_bit_cast(bf16x8s, __builtin_convertvector(x1, bfv8)); }
        }
        __builtin_amdgcn_s_waitcnt(0xc07f);
        __builtin_amdgcn_s_barrier();
        if (need) {
            const LAS unsigned char* Vb = lds + OFF_V + (it & 1) * VB;
            s16x4 vt[2][NDB][2];
#define FA_VLOAD(slot, grp) do { _Pragma("unroll") for (int d_ = 0; d_ < NDB; ++d_) { const LAS unsigned char* vp_ = Vb + vread + (((grp) >> 1) * 32 + 16 * ((grp) & 1)) * RSV + d_ * 64; \
                vt[slot][d_][0] = __builtin_amdgcn_ds_read_tr16_b64_v4i16((LAS s16x4*)vp_); vt[slot][d_][1] = __builtin_amdgcn_ds_read_tr16_b64_v4i16((LAS s16x4*)(vp_ + 8 * RSV)); } } while (0)
            FA_VLOAD(0, 0);
            __builtin_amdgcn_sched_barrier(0);
#pragma unroll
            for (int grp = 0; grp < 4; ++grp) {
                if (grp + 1 < 4) FA_VLOAD((grp + 1) & 1, grp + 1);
                __builtin_amdgcn_sched_barrier(0);
#pragma unroll
                for (int d = 0; d < NDB; ++d) { const s16x4 t0 = vt[grp & 1][d][0], t1 = vt[grp & 1][d][1];
                    bf16x8s a; a[0] = t0[0]; a[1] = t0[1]; a[2] = t0[2]; a[3] = t0[3]; a[4] = t1[0]; a[5] = t1[1]; a[6] = t1[2]; a[7] = t1[3];
                    o[d] = __builtin_amdgcn_mfma_f32_32x32x16_bf16(a, pf[grp >> 1][grp & 1], o[d], 0, 0, 0); }
                __builtin_amdgcn_sched_barrier(0);
            }
#undef FA_VLOAD
        }
        { int kb2 = kb3 + 2; if (kb2 >= 3) kb2 -= 3;
          if (it + 2 < ntiles) FA_STOREK(kb2); }
        if (it + 1 < ntiles) FA_STOREV((it + 1) & 1);
        if (it + 3 < ntiles) FA_LOADK(t + 3);
        if (it + 2 < ntiles) FA_LOADV(t + 2);
        __syncthreads();
        kb3 = kb3 == 2 ? 0 : kb3 + 1;
    }
    if (wid < 4) __builtin_amdgcn_s_barrier();
#undef FA_LOADK
#undef FA_LOADV
#undef FA_STOREK
#undef FA_STOREV
#undef FA_NEED
}

constexpr int FA_OFF_T = 3 * FA_KB + 2 * 64 * (128 * 2 + 64);

template <int MODE>
__device__ __forceinline__ void fa_unit64(const Params& P, int l, int unit, LAS unsigned char* lds) {
    const bf16_t* p = (const bf16_t*)(kws() + WS_P);
    const int tid = otid(P.pad0), lane = tid & 63, wid = __builtin_amdgcn_readfirstlane(tid >> 6), r = lane & 31, hh = lane >> 5;
    int b, qblk, head = 0, hd = 0;
    const bf16_t *qbase, *kbase, *vbase; size_t ldk;
    if (MODE == 0) { qblk = unit & 7; head = (unit >> 3) & 15; b = unit >> 7; const int kvh = head >> 2;
        qbase = p + (size_t)(b * SEQ) * INC + C_WQ + head * 64; kbase = p + (size_t)(b * SEQ) * INC + C_WK + kvh * 64; vbase = p + (size_t)(b * SEQ) * INC + C_WV + kvh * 64; ldk = INC;
    } else { qblk = unit & 7; hd = (unit >> 3) & 3; b = unit >> 5; const bf16_t* kv = (const bf16_t*)(kws() + WS_KVMEM);
        qbase = p + (size_t)(b * SEQ) * INC + C_MQ + hd * 64; kbase = kv + (size_t)(b * NMEM) * 2048 + l * 512 + hd * 64; vbase = kbase + 256; ldk = 2048;
    }
    const int q0 = qblk * 256, qw = q0 + wid * 32, qi = qw + r;
    int tile0, ntiles;
    if (MODE == 0) { tile0 = q0 / 64 - 2; int tl = q0 / 64 + 5; if (tile0 < 0) tile0 = 0; if (tl > SEQ / 64 - 1) tl = SEQ / 64 - 1; ntiles = tl - tile0 + 1; }
    else { tile0 = 0; ntiles = NMEM / 64; }
    const LAS float* btab = (const LAS float*)(lds + FA_OFF_T) + head * FA_TS + FA_TP;
    f32x16 o[2];
#pragma unroll
    for (int d = 0; d < 2; ++d)
#pragma unroll
        for (int i = 0; i < 16; ++i) o[d][i] = 0.f;
    float m = -INFINITY, lsum = 0.f;
    if (MODE == 0) { m = kin(I_SINK)[l * 16 + head] * LOG2E; lsum = hh == 0 ? 1.0f : 0.0f; }
    fa_core<64, MODE>(lds, tid, qbase + (size_t)qi * INC, kbase, vbase, ldk, tile0, ntiles, qw, qi, btab, o, m, lsum);
    const float lt = lsum + shfl_xor_o(lsum, 32); const float inv = 1.0f / lt;
    const size_t tok = (size_t)b * SEQ + qi;
    bf16_t* yp = (bf16_t*)(kws() + WS_YCAT) + tok * BRK + (MODE == 0 ? 1024 + head * 64 : 3072 + hd * 64) + 4 * hh;
#pragma unroll
    for (int d = 0; d < 2; ++d)
#pragma unroll
        for (int g = 0; g < 4; ++g) { u32x2 w; w.x = cvt_pk_bf16(o[d][4 * g] * inv, o[d][4 * g + 1] * inv); w.y = cvt_pk_bf16(o[d][4 * g + 2] * inv, o[d][4 * g + 3] * inv); *(u32x2*)(yp + 32 * d + 8 * g) = w; }
}

__device__ __forceinline__ void fa_unit_win(const Params& P, int l, int unit, LAS unsigned char* lds) {
    const bf16_t* p = (const bf16_t*)(kws() + WS_P);
    const int tid = otid(P.pad0), lane = tid & 63, wid = __builtin_amdgcn_readfirstlane(tid >> 6), r = lane & 31, hh = lane >> 5;
    const int qb = unit & 31, kvh = (unit >> 5) & 3, b = unit >> 7;
    const int head = kvh * 4 + (wid >> 1);
    const int q0 = qb * 64, qw = q0 + (wid & 1) * 32, qi = qw + r;
    const bf16_t* qbase = p + (size_t)(b * SEQ) * INC + C_WQ + head * 64; const bf16_t* kbase = p + (size_t)(b * SEQ) * INC + C_WK + kvh * 64; const bf16_t* vbase = p + (size_t)(b * SEQ) * INC + C_WV + kvh * 64;
    int tile0 = q0 / 64 - 2, tl = q0 / 64 + 2; if (tile0 < 0) tile0 = 0; if (tl > SEQ / 64 - 1) tl = SEQ / 64 - 1; const int ntiles = tl - tile0 + 1;
    const LAS float* btab = (const LAS float*)(lds + FA_OFF_T) + head * FA_TS + FA_TP;
    f32x16 o[2];
#pragma unroll
    for (int d = 0; d < 2; ++d)
#pragma unroll
        for (int i = 0; i < 16; ++i) o[d][i] = 0.f;
    float m = kin(I_SINK)[l * 16 + head] * LOG2E, lsum = hh == 0 ? 1.0f : 0.0f;
    fa_core<64, 0>(lds, tid, qbase + (size_t)qi * INC, kbase, vbase, (size_t)INC, tile0, ntiles, qw, qi, btab, o, m, lsum);
    const float lt = lsum + shfl_xor_o(lsum, 32); const float inv = 1.0f / lt;
    const size_t tok = (size_t)b * SEQ + qi;
    bf16_t* yp = (bf16_t*)(kws() + WS_YCAT) + tok * BRK + 1024 + head * 64 + 4 * hh;
#pragma unroll
    for (int d = 0; d < 2; ++d)
#pragma unroll
        for (int g = 0; g < 4; ++g) { u32x2 w; w.x = cvt_pk_bf16(o[d][4 * g] * inv, o[d][4 * g + 1] * inv); w.y = cvt_pk_bf16(o[d][4 * g + 2] * inv, o[d][4 * g + 3] * inv); *(u32x2*)(yp + 32 * d + 8 * g) = w; }
}

__device__ __forceinline__ void fa_unit_diff(const Params& P, int l, int unit, LAS unsigned char* lds, float lam_full, float one_m_li) {
    const bf16_t* p = (const bf16_t*)(kws() + WS_P);
    const int tid = otid(P.pad0), lane = tid & 63, wid = __builtin_amdgcn_readfirstlane(tid >> 6), r = lane & 31, hh = lane >> 5;
    const int qblk = unit & 7, h = (unit >> 3) & 7, b = unit >> 6;
    const int q0 = qblk * 256, qw = q0 + wid * 32, qi = qw + r;
    const LAS float* btab = (const LAS float*)(lds + FA_OFF_T) + (16 + h) * FA_TS + FA_TP;
    const size_t tok = (size_t)b * SEQ + qi;
    const bf16_t* vbase = p + (size_t)(b * SEQ) * INC + C_DV + h * 128;
    float* dp = (float*)(kws() + WS_DTMP) + tok * 1024 + h * 128 + 4 * hh;
    for (int cc = 0; cc < 2; ++cc) {
        const bf16_t* qrow = p + tok * INC + C_DQ + h * 128 + cc * 64;
        const bf16_t* kbase = p + (size_t)(b * SEQ) * INC + C_DK + h * 128 + cc * 64;
        f32x16 o[4];
#pragma unroll
        for (int d = 0; d < 4; ++d)
#pragma unroll
            for (int i = 0; i < 16; ++i) o[d][i] = 0.f;
        float m = -INFINITY, lsum = 0.f;
        fa_core<128, 1>(lds, tid, qrow, kbase, vbase, (size_t)INC, 0, SEQ / 64, qw, qi, btab, o, m, lsum);
        const float lt = lsum + shfl_xor_o(lsum, 32); const float inv = 1.0f / lt;
        if (cc == 0) {
#pragma unroll
            for (int d = 0; d < 4; ++d)
#pragma unroll
                for (int g = 0; g < 4; ++g) { f32x4 v; v[0] = o[d][4 * g] * inv; v[1] = o[d][4 * g + 1] * inv; v[2] = o[d][4 * g + 2] * inv; v[3] = o[d][4 * g + 3] * inv; *(f32x4*)(dp + 32 * d + 8 * g) = v; }
        } else {
            float ssq = 0.f;
#pragma unroll
            for (int d = 0; d < 4; ++d)
#pragma unroll
                for (int g = 0; g < 4; ++g) { const f32x4 a = *(const f32x4*)(dp + 32 * d + 8 * g);
#pragma unroll
                    for (int e = 0; e < 4; ++e) { const float x = a[e] - lam_full * (o[d][4 * g + e] * inv); o[d][4 * g + e] = x; ssq += x * x; } }
            ssq += shfl_xor_o(ssq, 32);
            const float rs = rsqrtf(ssq * (1.0f / 128.0f) + 1e-5f) * one_m_li;
            bf16_t* yp = (bf16_t*)(kws() + WS_YCAT) + tok * BRK + 2048 + h * 128 + 4 * hh;
            const float* sg = kin(I_SUBLN) + l * 128 + 4 * hh;
#pragma unroll
            for (int d = 0; d < 4; ++d)
#pragma unroll
                for (int g = 0; g < 4; ++g) { const f32x4 gv = *(const f32x4*)(sg + 32 * d + 8 * g);
                    u32x2 w; w.x = cvt_pk_bf16(o[d][4 * g] * rs * gv[0], o[d][4 * g + 1] * rs * gv[1]); w.y = cvt_pk_bf16(o[d][4 * g + 2] * rs * gv[2], o[d][4 * g + 3] * rs * gv[3]);
                    *(u32x2*)(yp + 32 * d + 8 * g) = w; }
        }
    }
}
__device__ __forceinline__ void phase_attn_mfma(const Params& P, int l, LAS unsigned char* lds) {
    const int tid0 = otid(P.pad0), lane = tid0 & 63;
    { float* bt = (float*)(lds + FA_OFF_T); const float* relb = kin(I_RELB); constexpr int NE = 259 + 2 * FA_TP;
      for (int i = tid0; i < 24 * NE; i += NTHR) { const int hq = i / NE, j = i - hq * NE, rel = j - FA_TP - 129; const int rc = rel < -128 ? -128 : (rel > 128 ? 128 : rel);
          const float v = relb[t5_bucket(rc) * 24 + hq] * LOG2E; bt[hq * FA_TS + j] = (hq < 16 && (rel < -128 || rel > 128)) ? -INFINITY : v; } }
    __syncthreads();
    const float* lam = kin(I_LAM) + l * 256;
    const float l1 = wave_sum(lam[lane] * lam[64 + lane]), l2 = wave_sum(lam[128 + lane] * lam[192 + lane]);
    const float lambda_init = 0.8f - 0.6f * expf(-0.3f * (float)l);
    const float lam_full = expf(l1) - expf(l2) + lambda_init;
    const int G = gridDim.x, c = blockIdx.x;
    if ((G & 7) == 0 && G >= 8) {
        const int x = c & 7, j = c >> 3, W = G >> 3;
        for (int lu = j; lu < 64; lu += W) { const int pair = x * 8 + (lu >> 3); fa_unit_diff(P, l, (pair << 3) | (lu & 7), lds, lam_full, 1.0f - lambda_init); }
        for (int lu = j; lu < 128; lu += W) { const int grp = x * 4 + (lu >> 5), g = (lu >> 3) & 3, qb = lu & 7; const int b = grp >> 2, kvh = grp & 3;
            fa_unit64<0>(P, l, (b << 7) | ((kvh * 4 + g) << 3) | qb, lds); }
        for (int lu = j; lu < 32; lu += W) { const int grp = x * 4 + (lu >> 3); fa_unit64<2>(P, l, (grp << 3) | (lu & 7), lds); }
    } else {
        for (int u = c; u < 512; u += G) fa_unit_diff(P, l, u, lds, lam_full, 1.0f - lambda_init);
        for (int u = c; u < 1024; u += G) fa_unit_win(P, l, u, lds);
        for (int u = c; u < 256; u += G) fa_unit64<2>(P, l, u, lds);
    }
}

#ifndef STAMP_SCAN
#define STAMP_SCAN 0
#endif
constexpr int CRP = 144, CIMG = 64 * CRP;
enum { SL_KQ = 0, SL_RQ, SL_AK, SL_DK, SL_VV, SL_B, SL_M2, SL_N1, SL_N2, SL_A, SL_C, SL_D, SL_X1, SL_S0, SL_S1, SL_COUNT };
constexpr int CS_GC = SL_COUNT * CIMG;
constexpr int CS_CONST = CS_GC + 256;
constexpr int CS_LD = SL_A * CIMG;
constexpr int CS_SEG = CS_LD + 64 * 64 * 4;

__device__ __forceinline__ int cs_off_row(int tile, int lane) { return (32 * tile + (lane & 31)) * CRP + 16 * (lane >> 5); }
__device__ __forceinline__ int cs_off_tr(int tile, int lane) { return (8 * (lane >> 5) + ((lane & 15) >> 2)) * CRP + (32 * tile + 16 * ((lane >> 4) & 1) + 4 * (lane & 3)) * 2; }
__device__ __forceinline__ int cs_off_cm(int ti, int tj, int lane) { return (32 * tj + (lane & 31)) * CRP + (32 * ti + 4 * (lane >> 5)) * 2; }
__device__ __forceinline__ bf16x8s cs_rowfrag(const LAS unsigned char* img, int off, int s) { return *(const LAS bf16x8s*)(img + off + 32 * s); }
__device__ __forceinline__ bf16x8s cs_trfrag(const LAS unsigned char* img, int off, int s) {
    const LAS unsigned char* a = img + off + 16 * s * CRP;
    const s16x4 t0 = __builtin_amdgcn_ds_read_tr16_b64_v4i16((LAS s16x4*)a), t1 = __builtin_amdgcn_ds_read_tr16_b64_v4i16((LAS s16x4*)(a + 4 * CRP));
    bf16x8s f; f[0] = t0[0]; f[1] = t0[1]; f[2] = t0[2]; f[3] = t0[3]; f[4] = t1[0]; f[5] = t1[1]; f[6] = t1[2]; f[7] = t1[3];
    return f;
}
template <bool ATR, bool BTR>
__device__ __forceinline__ f32x16 cs_mm(f32x16 acc, const LAS unsigned char* Ai, int aoff, const LAS unsigned char* Bi, int boff) {
    bf16x8s a[4], b[4];
#pragma unroll
    for (int s = 0; s < 4; ++s) { a[s] = ATR ? cs_trfrag(Ai, aoff, s) : cs_rowfrag(Ai, aoff, s); b[s] = BTR ? cs_trfrag(Bi, boff, s) : cs_rowfrag(Bi, boff, s); }
    __builtin_amdgcn_sched_barrier(0);
#pragma unroll
    for (int s = 0; s < 4; ++s) acc = __builtin_amdgcn_mfma_f32_32x32x16_bf16(a[s], b[s], acc, 0, 0, 0);
    return acc;
}
__device__ __forceinline__ void cs_store_cm(LAS unsigned char* img, int off, const f32x16& acc) {
#pragma unroll
    for (int g = 0; g < 4; ++g) { fv8 x; x[0] = acc[4 * g]; x[1] = acc[4 * g + 1]; x[2] = acc[4 * g + 2]; x[3] = acc[4 * g + 3]; x[4] = 0.f; x[5] = 0.f; x[6] = 0.f; x[7] = 0.f;
        const bf16x8s y = __builtin_bit_cast(bf16x8s, __builtin_convertvector(x, bfv8)); s16x4 w; w[0] = y[0]; w[1] = y[1]; w[2] = y[2]; w[3] = y[3];
        *(LAS s16x4*)(img + off + 16 * g) = w; }
}
__device__ __forceinline__ f32x16 cs_load_cm(const LAS unsigned char* img, int off) {
    f32x16 v;
#pragma unroll
    for (int g = 0; g < 4; ++g) { const u32x2 w = *(const LAS u32x2*)(img + off + 16 * g);
        v[4 * g] = bflo(w.x); v[4 * g + 1] = bfhi(w.x); v[4 * g + 2] = bflo(w.y); v[4 * g + 3] = bfhi(w.y); }
    return v;
}
__device__ __forceinline__ f32x16 cs_zero() { f32x16 z;
#pragma unroll
    for (int i = 0; i < 16; ++i) z[i] = 0.f;
    return z; }

__device__ __forceinline__ void phase_scan_chunked(const Params& P, int l, LAS unsigned char* lds) {
    const bf16_t* p = (const bf16_t*)(kws() + WS_P); const bf16_t* lora = (const bf16_t*)(kws() + WS_LORA);
    bf16_t* ydir = (bf16_t*)(kws() + WS_YDIR); float* bonus = (float*)(kws() + WS_BONUS);
    const int tid = otid(P.pad0), lane = tid & 63, wid = __builtin_amdgcn_readfirstlane(tid >> 6), r = lane & 31, hh = lane >> 5;
    const int pt = tid >> 3, pc8 = tid & 7;
    const int w4 = wid & 3, ti = w4 >> 1, tj = w4 & 1;
    const bool grpA = wid < 4;
#define IMG(s) (lds + (s) * CIMG)
    LAS float* LD = (LAS float*)(lds + CS_LD); LAS float* SEG = (LAS float*)(lds + CS_SEG); LAS float* GC = (LAS float*)(lds + CS_GC); LAS float* CN = (LAS float*)(lds + CS_CONST);
    for (int u = blockIdx.x; u < 256; u += gridDim.x) {
        const int z = u & 1, h = (u >> 1) & 15, b = u >> 5;
        const int c8 = h * 64 + pc8 * 8;
        const float* mu = kin(I_MU) + (size_t)l * 2 * RWC;
        __syncthreads();
        for (int i = tid; i < 9 * 64; i += NTHR) { const int vq = i >> 6, ch = i & 63, cch = h * 64 + ch; float v;
            if (vq < 3) v = mu[vq * 1024 + cch]; else if (vq < 6) v = mu[RWC + (vq - 3) * 1024 + cch]; else if (vq == 6) v = kin(I_KK)[l * 1024 + cch]; else if (vq == 7) v = kin(I_KA)[l * 1024 + cch]; else v = kin(I_RK)[l * 1024 + cch];
            CN[i] = v; }
        { LAS unsigned char* s0 = IMG(SL_S0); for (int i = tid; i < CIMG / 16; i += NTHR) *(LAS u32x4*)(s0 + i * 16) = (u32x4){0u, 0u, 0u, 0u}; }
        u32x4 rw[3][3], lw[2];
#define CS_LOAD(n) do { const int i_ = (n) * 64 + pt; const int t_ = z ? (SEQ - 1) - i_ : i_; const bf16_t* pr_ = p + (size_t)(b * SEQ + t_) * INC + c8; \
        const bool okp_ = t_ > 0, okn_ = t_ < SEQ - 1; const u32x4 zz_ = {0u, 0u, 0u, 0u}; \
        _Pragma("unroll") for (int x_ = 0; x_ < 3; ++x_) { rw[x_][0] = *(const u32x4*)(pr_ + x_ * 1024); rw[x_][1] = okp_ ? *(const u32x4*)(pr_ - INC + x_ * 1024) : zz_; rw[x_][2] = okn_ ? *(const u32x4*)(pr_ + INC + x_ * 1024) : zz_; } \
        const bf16_t* lr_ = lora + (size_t)(b * SEQ + t_) * LORA_N + z * 1024 + c8; lw[0] = *(const u32x4*)lr_; lw[1] = *(const u32x4*)(lr_ + 2048); } while (0)
        CS_LOAD(0);
        f32x16 accR = cs_zero();
        for (int n = 0; n < SEQ / 64; ++n) {
#if STAMP_SCAN
            const unsigned ts0 = (unsigned)__builtin_readcyclecounter();
#endif
            const int sOld = (n & 1) ? SL_S1 : SL_S0, sNew = (n & 1) ? SL_S0 : SL_S1;
            int rowI = cs_off_row(ti, lane), rowJ = cs_off_row(tj, lane), trI = cs_off_tr(ti, lane), trJ = cs_off_tr(tj, lane), cmO = cs_off_cm(ti, tj, lane);
            asm volatile("" : "+v"(rowI), "+v"(rowJ), "+v"(trI), "+v"(trJ), "+v"(cmO));
            { float ldv[8];
#pragma unroll
              for (int q = 0; q < 2; ++q) { const unsigned l0 = q ? lw[0].z : lw[0].x, l1 = q ? lw[0].w : lw[0].y; ldv[4 * q] = bflo(l0); ldv[4 * q + 1] = bfhi(l0); ldv[4 * q + 2] = bflo(l1); ldv[4 * q + 3] = bfhi(l1); }
              LAS float* ldp = LD + pt * 64 + pc8 * 8;
              *(LAS f32x4*)ldp = (f32x4){ldv[0], ldv[1], ldv[2], ldv[3]}; *(LAS f32x4*)(ldp + 4) = (f32x4){ldv[4], ldv[5], ldv[6], ldv[7]}; }
            __syncthreads();
            { const int k = tid & 63, seg = tid >> 6; float c[8]; float run = 0.f;
#pragma unroll
              for (int j = 0; j < 8; ++j) { run += LD[(seg * 8 + j) * 64 + k]; c[j] = run; }
              SEG[seg * 64 + k] = run;
              __syncthreads();
              float pre = 0.f;
#pragma unroll
              for (int s = 0; s < 7; ++s) pre += (s < seg) ? SEG[s * 64 + k] : 0.f;
#pragma unroll
              for (int j = 0; j < 8; ++j) LD[(seg * 8 + j) * 64 + k] = pre + c[j];
            }
            __syncthreads();
            { const int i = n * 64 + pt, tok = b * SEQ + (z ? (SEQ - 1) - i : i);
              float xs[3][8];
#pragma unroll
              for (int x = 0; x < 3; ++x)
#pragma unroll
                  for (int q = 0; q < 2; ++q) {
                      const unsigned c0 = q ? rw[x][0].z : rw[x][0].x, c1 = q ? rw[x][0].w : rw[x][0].y, p0 = q ? rw[x][1].z : rw[x][1].x, p1 = q ? rw[x][1].w : rw[x][1].y, n0 = q ? rw[x][2].z : rw[x][2].x, n1 = q ? rw[x][2].w : rw[x][2].y;
                      f32x4 c, pv, nx; c[0] = bflo(c0); c[1] = bfhi(c0); c[2] = bflo(c1); c[3] = bfhi(c1); pv[0] = bflo(p0); pv[1] = bfhi(p0); pv[2] = bflo(p1); pv[3] = bfhi(p1); nx[0] = bflo(n0); nx[1] = bfhi(n0); nx[2] = bflo(n1); nx[3] = bfhi(n1);
                      const f32x4 m0 = *(const LAS f32x4*)(CN + x * 64 + pc8 * 8 + 4 * q), m1 = *(const LAS f32x4*)(CN + (3 + x) * 64 + pc8 * 8 + 4 * q);
                      const f32x4 o = c + m0 * (pv - c) + m1 * (nx - c);
                      xs[x][4 * q] = o[0]; xs[x][4 * q + 1] = o[1]; xs[x][4 * q + 2] = o[2]; xs[x][4 * q + 3] = o[3]; }
              float av[8], ckk[8], cka[8], crk[8];
#pragma unroll
              for (int q = 0; q < 2; ++q) { const unsigned a0 = q ? lw[1].z : lw[1].x, a1 = q ? lw[1].w : lw[1].y;
                  av[4 * q] = bflo(a0); av[4 * q + 1] = bfhi(a0); av[4 * q + 2] = bflo(a1); av[4 * q + 3] = bfhi(a1);
                  const f32x4 t6 = *(const LAS f32x4*)(CN + 6 * 64 + pc8 * 8 + 4 * q), t7 = *(const LAS f32x4*)(CN + 7 * 64 + pc8 * 8 + 4 * q), t8 = *(const LAS f32x4*)(CN + 8 * 64 + pc8 * 8 + 4 * q);
#pragma unroll
                  for (int e = 0; e < 4; ++e) { ckk[4 * q + e] = t6[e]; cka[4 * q + e] = t7[e]; crk[4 * q + e] = t8[e]; } }
              float kk[8], kd[8]; float ss = 0.f, bq = 0.f;
#pragma unroll
              for (int j = 0; j < 8; ++j) { const float kx = xs[1][j]; const float kraw = kx * ckk[j]; kk[j] = kraw; ss += kraw * kraw;
                  kd[j] = kx * (1.0f + (av[j] - 1.0f) * cka[j]); bq += xs[0][j] * kd[j] * crk[j]; }
              ss = sum8(ss); bq = sum8(bq);
              const float rn = rsqrtf(fmaxf(ss, 1e-12f));
              if (pc8 == 0) bonus[((size_t)z * NTOK + tok) * 16 + h] = bq;
              const LAS float* cu = LD + pt * 64 + pc8 * 8;
              float cum[8], cup[8];
#pragma unroll
              for (int q = 0; q < 2; ++q) { const f32x4 a = *(const LAS f32x4*)(cu + 4 * q); cum[4 * q] = a[0]; cum[4 * q + 1] = a[1]; cum[4 * q + 2] = a[2]; cum[4 * q + 3] = a[3];
                  f32x4 bpv = {0.f, 0.f, 0.f, 0.f}; if (pt > 0) bpv = *(const LAS f32x4*)(cu - 64 + 4 * q); cup[4 * q] = bpv[0]; cup[4 * q + 1] = bpv[1]; cup[4 * q + 2] = bpv[2]; cup[4 * q + 3] = bpv[3]; }
              fv8 okq, orq, oak, odk, ovv;
#pragma unroll
              for (int j = 0; j < 8; ++j) { const float gt = __expf(cum[j]), gp = __expf(cup[j]), gi = __builtin_amdgcn_rcpf(gt); const float kkn = kk[j] * rn;
                  okq[j] = kkn * gp; orq[j] = xs[0][j] * gt; oak[j] = av[j] * kkn * gi; odk[j] = kd[j] * gi; ovv[j] = xs[2][j];
                  if (pt == 63) GC[pc8 * 8 + j] = gt; }
              const int off = pt * CRP + pc8 * 16;
              *(LAS bfv8*)(IMG(SL_KQ) + off) = __builtin_convertvector(okq, bfv8); *(LAS bfv8*)(IMG(SL_RQ) + off) = __builtin_convertvector(orq, bfv8);
              *(LAS bfv8*)(IMG(SL_AK) + off) = __builtin_convertvector(oak, bfv8); *(LAS bfv8*)(IMG(SL_DK) + off) = __builtin_convertvector(odk, bfv8);
              *(LAS bfv8*)(IMG(SL_VV) + off) = __builtin_convertvector(ovv, bfv8);
            }
            __syncthreads();
            if (n + 1 < SEQ / 64) CS_LOAD(n + 1);
#if STAMP_SCAN
            const unsigned ts1 = (unsigned)__builtin_readcyclecounter();
#endif
            { const int pr = wid >> 1; const LAS unsigned char* Ai = IMG(pr < 2 ? SL_KQ : SL_RQ); const LAS unsigned char* Bi = IMG((pr & 1) ? SL_DK : SL_AK);
              LAS unsigned char* Oi = IMG(pr == 0 ? SL_B : (pr == 1 ? SL_M2 : (pr == 2 ? SL_N1 : SL_N2)));
#pragma unroll
              for (int q = 0; q < 2; ++q) { const int ti1 = wid & 1, tj1 = q;
                  f32x16 acc = cs_mm<false, false>(cs_zero(), Ai, cs_off_row(ti1, lane), Bi, cs_off_row(tj1, lane));
                  f32x16 t1;
#pragma unroll
                  for (int i = 0; i < 16; ++i) { const int m = 32 * ti1 + (i & 3) + 8 * (i >> 2) + 4 * hh, nn = 32 * tj1 + r; const bool keep = pr < 2 ? (nn < m) : (nn <= m);
                      acc[i] = keep ? acc[i] : 0.f; t1[i] = (m == nn ? 1.0f : 0.0f) - acc[i]; }
                  cs_store_cm(Oi, cs_off_cm(ti1, tj1, lane), acc);
                  if (pr == 0) cs_store_cm(IMG(SL_C), cs_off_cm(ti1, tj1, lane), t1); } }
            __syncthreads();
            if (grpA) { const f32x16 acc = cs_mm<true, false>(cs_zero(), IMG(SL_B), trI, IMG(SL_B), rowJ); cs_store_cm(IMG(SL_A), cmO, acc); }
            else { const f32x16 acc = cs_mm<true, true>(cs_zero(), IMG(SL_M2), trI, IMG(SL_VV), trJ); cs_store_cm(IMG(SL_X1), cmO, acc); }
            __syncthreads();
#pragma unroll
            for (int st = 0; st < 5; ++st) {
                const int qs = (st & 1) ? SL_B : SL_A, qd = (st & 1) ? SL_A : SL_B, ts = (st & 1) ? SL_D : SL_C, td = (st & 1) ? SL_C : SL_D;
                if (grpA) { if (st < 4) { const f32x16 acc = cs_mm<true, false>(cs_zero(), IMG(qs), trI, IMG(qs), rowJ); cs_store_cm(IMG(qd), cmO, acc); } }
                else { const f32x16 acc = cs_mm<true, false>(cs_load_cm(IMG(ts), cmO), IMG(ts), trI, IMG(qs), rowJ); cs_store_cm(IMG(td), cmO, acc); }
                __syncthreads();
            }
            if (grpA) { const f32x16 acc = cs_mm<true, true>(cs_zero(), IMG(SL_D), trI, IMG(SL_KQ), trJ); cs_store_cm(IMG(SL_A), cmO, acc); }
            else { const f32x16 acc = cs_mm<true, false>(cs_zero(), IMG(SL_D), trI, IMG(SL_X1), rowJ); cs_store_cm(IMG(SL_B), cmO, acc); }
            __syncthreads();
            if (grpA) { f32x16 acc = cs_mm<false, true>(cs_zero(), IMG(SL_A), rowI, IMG(SL_N1), trJ);
                const f32x16 rq = cs_load_cm(IMG(SL_RQ), cmO);
                acc = rq - acc;
                cs_store_cm(IMG(SL_M2), cmO, acc); }
            else { const f32x16 a1 = cs_mm<true, true>(cs_zero(), IMG(SL_VV), trI, IMG(SL_N2), trJ); const f32x16 a2 = cs_mm<false, true>(cs_zero(), IMG(SL_B), rowI, IMG(SL_N1), trJ); accR = a1 - a2; }
            if (!grpA) { f32x16 acc = cs_mm<false, true>(cs_zero(), IMG(SL_A), rowI, IMG(SL_AK), trJ); const float gc = GC[32 * tj + r];
#pragma unroll
                for (int i = 0; i < 16; ++i) { const int m = 32 * ti + (i & 3) + 8 * (i >> 2) + 4 * hh, nn = 32 * tj + r; acc[i] = ((m == nn ? 1.0f : 0.0f) - acc[i]) * gc; }
                cs_store_cm(IMG(SL_C), cmO, acc); }
            else { const f32x16 a1 = cs_mm<true, true>(cs_zero(), IMG(SL_DK), trI, IMG(SL_VV), trJ); const f32x16 a2 = cs_mm<true, false>(cs_zero(), IMG(SL_AK), trI, IMG(SL_B), rowJ);
#pragma unroll
                for (int g = 0; g < 4; ++g) { const f32x4 gcv = *(const LAS f32x4*)(GC + 32 * ti + 8 * g + 4 * hh);
#pragma unroll
                    for (int e = 0; e < 4; ++e) accR[4 * g + e] = (a1[4 * g + e] - a2[4 * g + e]) * gcv[e]; } }
            __syncthreads();
            if (grpA) { accR = cs_mm<false, false>(accR, IMG(SL_C), rowI, IMG(sOld), rowJ); cs_store_cm(IMG(sNew), cmO, accR); }
            else { accR = cs_mm<false, false>(accR, IMG(sOld), rowI, IMG(SL_M2), rowJ);
                const int t = 32 * tj + r, ii = n * 64 + t; const int tk = z ? (SEQ - 1) - ii : ii;
                bf16_t* yp = ydir + ((size_t)z * NTOK + b * SEQ + tk) * DM + h * 64 + 32 * ti + 4 * hh;
#pragma unroll
                for (int g = 0; g < 4; ++g) { fv8 x; x[0] = accR[4 * g]; x[1] = accR[4 * g + 1]; x[2] = accR[4 * g + 2]; x[3] = accR[4 * g + 3]; x[4] = 0.f; x[5] = 0.f; x[6] = 0.f; x[7] = 0.f;
                    const bf16x8s y8 = __builtin_bit_cast(bf16x8s, __builtin_convertvector(x, bfv8)); s16x4 w; w[0] = y8[0]; w[1] = y8[1]; w[2] = y8[2]; w[3] = y8[3];
                    *(s16x4*)(yp + 8 * g) = w; } }
            __syncthreads();
#if STAMP_SCAN
            { const unsigned ts2 = (unsigned)__builtin_readcyclecounter(); if (blockIdx.x == 0 && tid == 0) { unsigned* acc = (unsigned*)(kws() + 8192);
                acc[0] += (STAMP_SCAN == 1 ? (ts1 - ts0) : (STAMP_SCAN == 2 ? (ts2 - ts1) : (ts2 - ts0))); } }
#endif
        }
#undef CS_LOAD
    }
#undef IMG
}
#define XB_TMO      128
#define XB_XCNT(j)  (256  + 64 * (j))
#define XB_XSUB(j)  (1280 + 64 * (j))
#define XB_XGEN(j)  (2304 + 64 * (j))
#define XB_TOP      3328
#define XB_TOPGEN   3392
#define XCD_BAR_WORDS 3456
#define XB_SPIN_CAP (1u << 20)

__device__ __forceinline__ unsigned xb_ld(unsigned* p)              { return __hip_atomic_load(p, __ATOMIC_RELAXED, __HIP_MEMORY_SCOPE_AGENT); }
__device__ __forceinline__ unsigned xb_add(unsigned* p, unsigned v) { return __hip_atomic_fetch_add(p, v, __ATOMIC_RELAXED, __HIP_MEMORY_SCOPE_AGENT); }
__device__ __forceinline__ unsigned xb_xcc_id() { return (unsigned)__builtin_amdgcn_s_getreg((3 << 11) | 20) & 0xFu; }
#define XB_SPIN(cond, bar) do { unsigned _sp = 0; while (cond) { __builtin_amdgcn_s_sleep(1); \
    if ((++_sp & 255u) == 0u) { if (xb_ld(&(bar)[XB_TMO])) break; if (_sp > XB_SPIN_CAP) { atomicAdd(&(bar)[XB_TMO], 1u); break; } } } } while (0)

struct XcdBarrier {
    unsigned* bar; unsigned x; int wv;
    volatile LAS unsigned* st;
};

__device__ __forceinline__ XcdBarrier xcd_barrier_post(unsigned* bar, volatile LAS unsigned* st) {
    XcdBarrier b; b.bar = bar; b.x = xb_xcc_id(); b.st = st;
    if (threadIdx.x == 0) (void)xb_add(&bar[XB_XCNT(b.x)], 1u);
    return b;
}
__device__ __forceinline__ void xcd_barrier_complete(unsigned* bar, unsigned x, unsigned& nloc, unsigned& nx) {
    const unsigned G = gridDim.x * gridDim.y * gridDim.z;
    unsigned sum, cnt, mine, sp = 0u;
    for (;;) {
        sum = 0u; cnt = 0u; mine = 0u;
#pragma unroll
        for (unsigned j = 0; j < 16; ++j) { const unsigned c = xb_ld(&bar[XB_XCNT(j)]); sum += c; cnt += (c > 0u) ? 1u : 0u; mine = (j == x) ? c : mine; }
        if (sum == G) break;
        __builtin_amdgcn_s_sleep(1);
        if ((++sp & 255u) == 0u) { if (xb_ld(&bar[XB_TMO])) break; if (sp > XB_SPIN_CAP) { atomicAdd(&bar[XB_TMO], 1u); break; } }
    }
    nloc = mine > 0u ? mine : 1u; nx = cnt > 0u ? cnt : 1u;
}

__device__ __forceinline__ void xcd_barrier(const XcdBarrier& b) {
    asm volatile("s_waitcnt vmcnt(0)" ::: "memory");
    __syncthreads();
    unsigned xz_ = 0u; asm volatile("" : "+v"(xz_));
    if (b.wv == 0 && __builtin_amdgcn_mbcnt_hi(~0u, __builtin_amdgcn_mbcnt_lo(~0u, xz_)) == 0u) {
        unsigned* bar = b.bar; asm volatile("" : "+s"(bar));
        __builtin_amdgcn_s_waitcnt(0);
        unsigned nloc = b.st[0], nx = b.st[1];
        if (nloc == 0u) { xcd_barrier_complete(bar, b.x, nloc, nx); b.st[0] = nloc; b.st[1] = nx; }
        const unsigned old = xb_add(&bar[XB_XSUB(b.x)], 1u);
        const unsigned gen = old / nloc;
        if (old + 1u == (gen + 1u) * nloc) {
            __builtin_amdgcn_fence(__ATOMIC_RELEASE, "agent");
            asm volatile("s_waitcnt vmcnt(0)" ::: "memory");
            const unsigned og = xb_add(&bar[XB_TOP], 1u);
            const unsigned tg = og / nx;
            if (og + 1u == (tg + 1u) * nx) xb_add(&bar[XB_TOPGEN], 1u);
            else XB_SPIN(xb_ld(&bar[XB_TOPGEN]) == tg, bar);
            __builtin_amdgcn_fence(__ATOMIC_ACQUIRE, "agent");
            xb_add(&bar[XB_XGEN(b.x)], 1u);
            asm volatile("s_waitcnt vmcnt(0)" ::: "memory");
        } else {
            XB_SPIN(xb_ld(&bar[XB_XGEN(b.x)]) == gen, bar);
            __builtin_amdgcn_fence(__ATOMIC_ACQUIRE, "agent");
            asm volatile("s_waitcnt vmcnt(0)" ::: "memory");
        }
    }
    __syncthreads();
}


template <class Epi, class Sched>
__device__ __forceinline__ void run_gemm(int wv, LAS unsigned char* lds, const bf16_t* A, int lda, const bf16_t* Bt, int ldb, int M, int N, int K, const Sched& S, const Epi& E, int pshift = 30, int pmask = -1, int koff = 0, int alt_from = 1 << 30, int nt_alt = 0) {
    asm volatile("" : "+s"(K));
    Gemm g; g.A = A; g.Bt = Bt; g.M = M; g.N = N; g.K = K; g.lda = lda; g.ldb = ldb; g.wv = wv; g.sa = 0; g.sb = 0; g.pshift = pshift; g.pmask = pmask; g.koff = koff; g.alt_from = alt_from; g.nt_alt = nt_alt;
    pg8::gemm_phase<Epi, Sched, false>(lds, g, S, E, nullptr);
}
template <class Epi, class Sched>
__device__ __forceinline__ void run_gemm_f8(int wv, LAS unsigned char* lds, const unsigned char* A, int lda, const unsigned char* Bt, int ldb, int M, int N, int K, int sa, int sb, const Sched& S, const Epi& E) {
    asm volatile("" : "+s"(K));
    Gemm g; g.A = (const bf16_t*)A; g.Bt = (const bf16_t*)Bt; g.M = M; g.N = N; g.K = K; g.lda = lda; g.ldb = ldb; g.wv = wv; g.sa = sa; g.sb = sb; g.pshift = 30; g.pmask = -1; g.koff = 0; g.alt_from = 1 << 30; g.nt_alt = 0;
    pg8::gemm_phase_f8<Epi, Sched, false>(lds, g, S, E, nullptr);
}

#ifndef EN_MASK
#define EN_MASK 0xFFFFFFFFu
#endif
#define EN_PH(k) ((EN_MASK >> (k)) & 1u)
#ifndef PROBE_REP
#define PROBE_REP (-1)
#endif
#ifndef PROBE_MASK
#define PROBE_MASK 0u
#endif
#define REP(k) for (int rep_ = 0; rep_ < (((PROBE_REP == (k)) || ((k) < 32 && ((PROBE_MASK >> ((k) & 31)) & 1u))) ? 2 : 1); ++rep_)
constexpr int NPH_PRO = 2, NPH_LAYER = 12, NPH_TOTAL = NPH_PRO + DEPTH * NPH_LAYER;

__global__ void __launch_bounds__(512, 2) mega(Params Pk) {
    Params P = Pk; P.pad0 = __builtin_amdgcn_readfirstlane((int)threadIdx.x >> 6);
    extern __shared__ __attribute__((aligned(16))) unsigned char shm[];
    float* ldsf = (float*)shm;
    LAS unsigned char* ldsl = (LAS unsigned char*)shm;
    unsigned char* ws = kws();
    const int G = gridDim.x, c = blockIdx.x;
    XcdBarrier bar;
    if (P.fused) {
        volatile LAS unsigned* st = (volatile LAS unsigned*)(ldsl + LDS_BYTES - 16);
        if (threadIdx.x == 0) { st[0] = 0u; st[1] = 0u; st[2] = 0u; st[3] = 0u; }
        __syncthreads();
        bar = xcd_barrier_post((unsigned*)(ws + WS_CTL), st); bar.wv = P.pad0;
    }
    int ph = 0;
#define PH_BEGIN if (ph >= P.ph_lo && ph < P.ph_hi) {
#ifndef BAR_TWICE
#define BAR_TWICE 0
#endif
#define PH_END_  if (P.fused) { xcd_barrier(bar); if (BAR_TWICE) xcd_barrier(bar); } else __syncthreads(); } ++ph;

    PH_BEGIN
#if EN_PH(0)
REP(0) { if (rep_) __syncthreads();
phase_convert(P, ldsf);
}
#endif
 PH_END_
    PH_BEGIN
#if EN_PH(1)
REP(1) { if (rep_) __syncthreads();
{ pg8::StaticOrder S; S.init(NBATCH * NMEM, DEPTH * 512, G, c); EpiBf16Store E; E.O = (bf16_t*)(ws + WS_KVMEM); E.ldc = DEPTH * 512; E.st = ldsl + 131072; E.GP = nullptr;
        run_gemm(P.pad0, ldsl, (const bf16_t*)(ws + WS_MEMB), DM, (const bf16_t*)(ws + WS_WKV), DM, NBATCH * NMEM, DEPTH * 512, DM, S, E); }
}
#endif
 PH_END_

    for (int l = 0; l < DEPTH; ++l) {
        PH_BEGIN
#if EN_PH(2)
REP(2) { if (rep_) __syncthreads();
{ pg8::StaticOrder S; S.init(NTOK, INC, G, c); EpiBf16Store E; E.O = (bf16_t*)(ws + WS_P); E.ldc = INC; E.st = ldsl + 131072; E.GP = (bf16_t*)(ws + WS_GATEP);
            run_gemm(P.pad0, ldsl, (const bf16_t*)(ws + WS_XB), DM, (const bf16_t*)(ws + WS_WIN) + (size_t)l * INC * DM, DM, NTOK, INC, DM, S, E); }
}
#endif
 PH_END_
        PH_BEGIN
#if EN_PH(3)
REP(3) { if (rep_) __syncthreads();
phase_prepass(P, l);
}
#endif
 PH_END_
        PH_BEGIN
#if EN_PH(4)
REP(4) { if (rep_) __syncthreads();
{ pg8::StaticOrder S; S.init(NTOK, LORA_N, G, c); EpiLora E; E.O = (bf16_t*)(ws + WS_LORA); E.w0 = kin(I_W0) + l * 2048; E.a0 = kin(I_A0) + l * 2048;
            run_gemm(P.pad0, ldsl, (const bf16_t*)(ws + WS_APR), 256, (const bf16_t*)(ws + WS_WLORA) + (size_t)l * LORA_N * 256, 256, NTOK, LORA_N, 128, S, E, 4, -1, 256); }
}
#endif
 PH_END_
        PH_BEGIN
#if EN_PH(5)
REP(5) { if (rep_) __syncthreads();
REP(100) { if (rep_) __syncthreads(); phase_scan_chunked(P, l, ldsl); }
        REP(101) { if (rep_) __syncthreads(); phase_attn_mfma(P, l, ldsl); }
}
#endif
 PH_END_
        PH_BEGIN
#if EN_PH(6)
REP(6) { if (rep_) __syncthreads();
phase_post(P, l);
}
#endif
 PH_END_
        PH_BEGIN
#if EN_PH(7)
REP(7) { if (rep_) __syncthreads();
{ BranchOrder S; S.init(NTOK, DM, G, c);
            const bf16_t* ycat = (const bf16_t*)(ws + WS_YCAT); const bf16_t* wbr = (const bf16_t*)(ws + WS_WBR) + (size_t)l * DM * BRK;
            EpiBranchAll E; E.gateP = (const bf16_t*)(ws + WS_GATEP); E.mbP = (bf16_t*)(ws + WS_MBP); E.mb = (bf16_t*)(ws + WS_MB); E.st = ldsl + 131072;
            run_gemm(P.pad0, ldsl, ycat, BRK, wbr, BRK, NTOK, DM, 1024, S, E, 2, 3, 2048, 3, 4); }
}
#endif
 PH_END_
        PH_BEGIN
#if EN_PH(8)
REP(8) { if (rep_) __syncthreads();
{ pg8::StaticOrder S; S.init(NTOK, DM, G, c); EpiResid E; E.xf = (const float*)(ws + WS_XF); E.o = (float*)(ws + WS_PRELN);
            run_gemm(P.pad0, ldsl, (const bf16_t*)(ws + WS_MB), DM, (const bf16_t*)(ws + WS_WOUT) + (size_t)l * DM * DM, DM, NTOK, DM, DM, S, E); }
}
#endif
 PH_END_
        PH_BEGIN
#if EN_PH(9)
REP(9) { if (rep_) __syncthreads();
phase_ln1(P, l, ldsf);
}
#endif
 PH_END_
        PH_BEGIN
#if EN_PH(10)
REP(10) { if (rep_) __syncthreads();
phase_topk(P, (unsigned long long*)shm);
}
#endif
 PH_END_
        PH_BEGIN
#if EN_PH(11)
REP(11) { if (rep_) __syncthreads();
{ GroupedOrder S; S.init(8, 16, NEXP, G, c); EpiSwiGLU E; E.H = ws + WS_H;
            run_gemm_f8(P.pad0, ldsl, ws + WS_XE, DM, ws + WS_WGU + (size_t)l * NEXP * 4096 * DM, DM, NEXP * 2048, NEXP * 4096, DM, E8_ONE, E8_W, S, E); }
}
#endif
 PH_END_
        PH_BEGIN
#if EN_PH(12)
REP(12) { if (rep_) __syncthreads();
{ GroupedOrder S; S.init(8, 4, NEXP, G, c); EpiDown E; E.Y = (bf16_t*)(ws + WS_YE);
            run_gemm_f8(P.pad0, ldsl, ws + WS_H, DEXP, ws + WS_WDN + (size_t)l * NEXP * DM * DEXP, DEXP, NEXP * 2048, NEXP * DM, DEXP, E8_H, E8_W, S, E); }
}
#endif
 PH_END_
        PH_BEGIN
#if EN_PH(13)
REP(13) { if (rep_) __syncthreads();
phase_ln2(P, l);
}
#endif
 PH_END_
    }
#undef PH_BEGIN
#undef PH_END_
#if STAMP_SCAN
    if (blockIdx.x == 0 && threadIdx.x == 0) { const unsigned long long want = 4ull * *(volatile unsigned*)(kws() + 8192); const long long t0 = clock64(); while ((unsigned long long)(clock64() - t0) < want) __builtin_amdgcn_s_sleep(8); }
#endif
}

#ifndef MK_FUSED
#define MK_FUSED 1
#endif

extern "C" void kernel_launch(void* const* d_in, const int* in_sizes, int n_in, void* d_out, int out_size, void* d_ws, size_t ws_size, hipStream_t stream) {
    static int grid = 0;
    if (grid == 0) {
        if (n_in != N_IN || ws_size < WS_END) { fprintf(stderr, "kernel_launch: unexpected n_in %d or ws_size %zu (< %zu)\n", n_in, ws_size, (size_t)WS_END); grid = -1; return; }
        int dev = 0, cus = 0;
        if (hipGetDevice(&dev) != hipSuccess || hipDeviceGetAttribute(&cus, hipDeviceAttributeMultiprocessorCount, dev) != hipSuccess) { grid = -1; return; }
        if (hipFuncSetAttribute((const void*)mega, hipFuncAttributeMaxDynamicSharedMemorySize, LDS_BYTES) != hipSuccess) { fprintf(stderr, "kernel_launch: hipFuncSetAttribute failed\n"); grid = -1; return; }
        grid = cus > 0 ? cus : 256;
    }
    if (grid < 0) return;
    Params P{};
    for (int i = 0; i < N_IN; ++i) P.in[i] = (const float*)d_in[i];
    P.out = (float*)d_out; P.ws = (unsigned char*)d_ws; P.pad0 = 0;
#if MK_FUSED
    (void)hipMemsetAsync((char*)d_ws + WS_CTL, 0, XCD_BAR_WORDS * sizeof(unsigned), stream);
    P.ph_lo = 0; P.ph_hi = NPH_TOTAL; P.fused = 1;
    hipLaunchKernelGGL(mega, dim3(grid), dim3(NTHR), LDS_BYTES, stream, P);
#else
    for (int ph = 0; ph < NPH_TOTAL; ++ph) {
        P.ph_lo = ph; P.ph_hi = ph + 1; P.fused = 0;
        hipLaunchKernelGGL(mega, dim3(grid), dim3(NTHR), LDS_BYTES, stream, P);
    }
#endif
}
```

```cpp
#include <hip/hip_runtime.h>
#include <stdint.h>
#include <stdio.h>

namespace pg8 {
#define PG8_LAS __attribute__((address_space(3)))
typedef unsigned short bf16_t;
typedef short bf16x8 __attribute__((ext_vector_type(8)));
typedef float f32x4 __attribute__((ext_vector_type(4)));
typedef unsigned u32x4 __attribute__((ext_vector_type(4)));
constexpr int BM = 256, BK = 64, HALF = 128, HTB = HALF * BK * 2  , STAGE_BYTES = 8 * HTB, NXCD = 8, WGM = 8;

__host__ __device__ __forceinline__ int lds_byte(int r, int c) { const int st = (r >> 4) * 2 + (c >> 5), rr = r & 15, cc = c & 31, ob = rr * 64 + cc * 2; return st * 1024 + (ob ^ (((ob >> 9) & 1) << 5)); }
__host__ __device__ __forceinline__ void stage_rc(int b, int& R, int& C) { const int st = b / 1024, sb = b % 1024, swz = sb ^ (((sb >> 9) & 1) << 5); R = (st >> 1) * 16 + swz / 64; C = (st & 1) * 32 + (swz % 64) / 2; }
__host__ __device__ __forceinline__ int perm32(int rho) { const int n = rho >> 4, i = rho & 15; return 8 * (i >> 2) + 4 * n + (i & 3); }

struct Unit { int pm, pn; };
struct Gemm { const bf16_t* A; const bf16_t* Bt; int M, N, K, lda, ldb, wv, sa, sb, pshift, pmask, koff, alt_from, nt_alt; };
struct StaticOrder {
    int nM, nN, nwg, G, c;
    __host__ __device__ void init(int M, int N, int G_, int c_) { nM = M / BM; nN = N / BM; nwg = nM * nN; G = G_; c = c_; }
    __host__ __device__ bool next(int i, Unit& u) const {
        const long L = (long)i * G + c; if (L >= nwg) return false;
        int wgid = (int)L; { const int q = nwg / NXCD, r = nwg % NXCD, xcd = wgid % NXCD, off = wgid / NXCD; wgid = (xcd < r ? xcd * (q + 1) : r * (q + 1) + (xcd - r) * q) + off; }
        const int nig = WGM * nN, gid = wgid / nig, fm = gid * WGM, gsz = (nM - fm) < WGM ? (nM - fm) : WGM;
        u.pm = fm + ((wgid % nig) % gsz); u.pn = (wgid % nig) / gsz; return true;
    }
    __device__ __forceinline__ void a_ready(const Unit&) const {}
    __device__ __forceinline__ void done(const Unit&) const {}
};
__device__ __forceinline__ unsigned cvt_pk_bf16(float lo, float hi) { unsigned r; asm volatile("v_cvt_pk_bf16_f32 %0, %1, %2" : "=v"(r) : "v"(lo), "v"(hi)); return r; }
template <class Epi, class Sched, bool STAMP = false>
__device__ __forceinline__ void gemm_phase(PG8_LAS unsigned char* lds, const Gemm g, const Sched& S, const Epi& E, unsigned long long* stamps) {
    unsigned z_ = 0u; asm volatile("" : "+v"(z_)); int tid_ = g.wv * 64 + (int)__builtin_amdgcn_mbcnt_hi(~0u, __builtin_amdgcn_mbcnt_lo(~0u, z_)); asm volatile("" : "+v"(tid_));
    const int tid = tid_, wid = __builtin_amdgcn_readfirstlane(tid >> 6), lane = tid & 63, wr = wid >> 2, wc = wid & 3, fr = lane & 15, fq = lane >> 4;
    const int K = g.K, nt = K / BK;
    int ts_lo = 0, ts_hi = 0, nts = 0; const unsigned long long rt_entry = STAMP ? (unsigned long long)wall_clock64() : 0ull;
#define PG8_STAMP() do { if (STAMP && wid == 0 && nts < 64) { const unsigned long long _c = (unsigned long long)clock64(); \
        ts_lo = (lane == nts) ? (int)(unsigned)_c : ts_lo; ts_hi = (lane == nts) ? (int)(unsigned)(_c >> 32) : ts_hi; ++nts; } } while (0)
    PG8_STAMP();
    unsigned voffA[2], voffB[2];
#pragma unroll
    for (int i = 0; i < 2; ++i) { int R, C; stage_rc(tid * 16 + i * 8192, R, C); const int Rb = Epi::PERM ? ((R & ~31) + perm32(R & 31)) : R;
        voffA[i] = (unsigned)(R * g.lda + C) * 2u; voffB[i] = (unsigned)(Rb * g.ldb + C) * 2u; }
    const size_t kstep = (size_t)(BK * 2);
    const size_t hstepA = (size_t)HALF * g.lda * 2, hstepB = (size_t)HALF * g.ldb * 2;
    const size_t tstepA = 2 * hstepA, tstepB = 2 * hstepB;
    const unsigned ldsw = (unsigned)wid * 1024u;
    const int aoff = lds_byte(wr * 64 + fr, fq * 8), boff = lds_byte(wc * 32 + fr, fq * 8);
#define PG8_SA(b, h) (((b) * 2 + (h)) * HTB)
#define PG8_SB(b, h) ((4 + (b) * 2 + (h)) * HTB)
#define PG8_STAGE(bufoff, gbase, voff) do { _Pragma("unroll") for (int _i = 0; _i < 2; ++_i) \
        __builtin_amdgcn_global_load_lds((const unsigned*)((const char*)(gbase) + (voff)[_i]), (PG8_LAS unsigned*)(lds + (bufoff) + ldsw + _i * 8192), 16, 0, 0); } while (0)
#define PG8_LDA(dst, b, h) do { _Pragma("unroll") for (int m = 0; m < 4; ++m) _Pragma("unroll") for (int k = 0; k < 2; ++k) dst[m][k] = *(const PG8_LAS bf16x8*)(lds + PG8_SA(b, h) + aoff + m * 2048 + k * 1024); } while (0)
#define PG8_LDB(dst, b, h) do { _Pragma("unroll") for (int n = 0; n < 2; ++n) _Pragma("unroll") for (int k = 0; k < 2; ++k) dst[n][k] = *(const PG8_LAS bf16x8*)(lds + PG8_SB(b, h) + boff + n * 2048 + k * 1024); } while (0)
#define PG8_MMA(ai, bj, At, Bt) do { __builtin_amdgcn_s_setprio(1); _Pragma("unroll") for (int m = 0; m < 4; ++m) _Pragma("unroll") for (int n = 0; n < 2; ++n) _Pragma("unroll") for (int k = 0; k < 2; ++k) \
        acc[ai][bj][m][n] = __builtin_amdgcn_mfma_f32_16x16x32_bf16(Bt[n][k], At[m][k], acc[ai][bj][m][n], 0, 0, 0); __builtin_amdgcn_s_setprio(0); } while (0)
#define PG8_WAIT_V(n) asm volatile("s_waitcnt vmcnt(" #n ")" ::: "memory")
#define PG8_WAIT_L(n) asm volatile("s_waitcnt lgkmcnt(" #n ")" ::: "memory")
#define PG8_BAR __builtin_amdgcn_s_barrier()
#define PG8_SCHED __builtin_amdgcn_sched_barrier(0)
    Unit cur, nxt; int ui = 0;
    if (!S.next(0, cur)) return;
    f32x4 acc[2][2][4][2];
#pragma unroll
    for (int a = 0; a < 2; ++a)
#pragma unroll
        for (int b = 0; b < 2; ++b)
#pragma unroll
            for (int m = 0; m < 4; ++m)
#pragma unroll
                for (int n = 0; n < 2; ++n) acc[a][b][m][n] = (f32x4){0.f, 0.f, 0.f, 0.f};
    bf16x8 At[4][2], B0[2][2], B1[2][2];
    const char* cA = (const char*)g.A + (size_t)cur.pm * tstepA + (size_t)(cur.pn >> g.pshift) * g.koff; const char* cB = (const char*)g.Bt + (size_t)(cur.pn & g.pmask) * tstepB + (size_t)(cur.pn >> g.pshift) * g.koff;
    S.a_ready(cur);
    PG8_STAGE(PG8_SB(0, 0), cB, voffB); PG8_STAGE(PG8_SA(0, 0), cA, voffA); PG8_STAGE(PG8_SB(0, 1), cB + hstepB, voffB); PG8_STAGE(PG8_SA(0, 1), cA + hstepA, voffA);
    if (wr == 1) PG8_BAR;
    PG8_WAIT_V(4); PG8_BAR;
    PG8_STAGE(PG8_SB(1, 0), cB + kstep, voffB); PG8_STAGE(PG8_SA(1, 0), cA + kstep, voffA); PG8_STAGE(PG8_SB(1, 1), cB + hstepB + kstep, voffB);
    PG8_WAIT_V(6); PG8_BAR;
    PG8_STAMP();
    for (;;) {
        const bool has_next = S.next(ui + 1, nxt);
        const char* nA = has_next ? (const char*)g.A + (size_t)nxt.pm * tstepA + (size_t)(nxt.pn >> g.pshift) * g.koff : cA; const char* nB = has_next ? (const char*)g.Bt + (size_t)(nxt.pn & g.pmask) * tstepB + (size_t)(nxt.pn >> g.pshift) * g.koff : cB;
        const int ntu = ((cur.pn >> g.pshift) >= g.alt_from) ? g.nt_alt : nt;
        for (int t = 0; t < ntu; t += 2) {
            const bool last = (t == ntu - 2);
            const char* a1 = cA + (size_t)(t + 1) * kstep;
            const char* a2 = last ? nA : cA + (size_t)(t + 2) * kstep; const char* b2 = last ? nB : cB + (size_t)(t + 2) * kstep;
            const char* a3 = a2 + kstep; const char* b3 = b2 + kstep;
            if (last && has_next) S.a_ready(nxt);
            PG8_LDB(B0, 0, 0); PG8_SCHED; PG8_LDA(At, 0, 0); PG8_STAGE(PG8_SA(1, 1), a1 + hstepA, voffA);
            PG8_WAIT_L(8); PG8_BAR; PG8_WAIT_L(0); PG8_MMA(0, 0, At, B0); PG8_BAR; PG8_SCHED;
            PG8_LDB(B1, 0, 1); PG8_STAGE(PG8_SB(0, 0), b2, voffB);
            PG8_BAR; PG8_WAIT_L(0); PG8_MMA(0, 1, At, B1); PG8_BAR;
            PG8_LDA(At, 0, 1); PG8_STAGE(PG8_SA(0, 0), a2, voffA);
            PG8_BAR; PG8_WAIT_L(0); PG8_MMA(1, 0, At, B0); PG8_BAR; PG8_SCHED;
            PG8_STAGE(PG8_SB(0, 1), b2 + hstepB, voffB);
            PG8_WAIT_V(6); PG8_BAR; PG8_MMA(1, 1, At, B1); PG8_BAR;
            PG8_LDB(B0, 1, 0); PG8_SCHED; PG8_LDA(At, 1, 0); PG8_STAGE(PG8_SA(0, 1), a2 + hstepA, voffA);
            PG8_WAIT_L(8); PG8_BAR; PG8_WAIT_L(0); PG8_MMA(0, 0, At, B0); PG8_BAR; PG8_SCHED;
            PG8_LDB(B1, 1, 1); PG8_STAGE(PG8_SB(1, 0), b3, voffB);
            PG8_BAR; PG8_WAIT_L(0); PG8_MMA(0, 1, At, B1); PG8_BAR;
            PG8_LDA(At, 1, 1); PG8_STAGE(PG8_SA(1, 0), a3, voffA);
            PG8_BAR; PG8_WAIT_L(0); PG8_MMA(1, 0, At, B0); PG8_BAR; PG8_SCHED;
            PG8_STAGE(PG8_SB(1, 1), b3 + hstepB, voffB);
            PG8_WAIT_V(6); PG8_BAR; PG8_MMA(1, 1, At, B1); PG8_BAR;
        }
        PG8_STAMP();
        if constexpr (!Epi::AFTER_DRAIN) { E(acc, cur, wr, wc, fr, fq); S.done(cur); }
        PG8_STAMP();
        if (!has_next) break;
#pragma unroll
        for (int a = 0; a < 2; ++a)
#pragma unroll
            for (int b = 0; b < 2; ++b)
#pragma unroll
                for (int m = 0; m < 4; ++m)
#pragma unroll
                    for (int n = 0; n < 2; ++n) acc[a][b][m][n] = (f32x4){0.f, 0.f, 0.f, 0.f};
        cur = nxt; cA = nA; cB = nB; ++ui;
    }
    PG8_WAIT_V(0);
    if (wr == 0) PG8_BAR;
    PG8_BAR;
    if constexpr (Epi::AFTER_DRAIN) { E.fused(acc, cur, wr, wc, fr, fq, lds, wid, lane); S.done(cur); }
    PG8_STAMP();
    if (STAMP && wid == 0) { stamps[lane] = lane < nts ? (((unsigned long long)(unsigned)ts_hi << 32) | (unsigned)ts_lo) : 0ull;
        if (lane == 62) stamps[62] = rt_entry; if (lane == 63) stamps[63] = (unsigned long long)wall_clock64(); }
#undef PG8_STAMP
#undef PG8_SA
#undef PG8_SB
#undef PG8_STAGE
#undef PG8_LDA
#undef PG8_LDB
#undef PG8_MMA
#undef PG8_WAIT_V
#undef PG8_WAIT_L
#undef PG8_BAR
#undef PG8_SCHED
}

typedef short bf16x16 __attribute__((ext_vector_type(16)));
typedef int v8i __attribute__((ext_vector_type(8)));
template <class Epi, class Sched, bool STAMP = false>
__device__ __forceinline__ void gemm_phase_f8(PG8_LAS unsigned char* lds, const Gemm g, const Sched& S, const Epi& E, unsigned long long* stamps) {
    unsigned z_ = 0u; asm volatile("" : "+v"(z_)); int tid_ = g.wv * 64 + (int)__builtin_amdgcn_mbcnt_hi(~0u, __builtin_amdgcn_mbcnt_lo(~0u, z_)); asm volatile("" : "+v"(tid_));
    const int tid = tid_, wid = __builtin_amdgcn_readfirstlane(tid >> 6), lane = tid & 63, wr = wid >> 2, wc = wid & 3, fr = lane & 15, fq = lane >> 4;
    const int K = g.K, nt = K / 128;
    int ts_lo = 0, ts_hi = 0, nts = 0; const unsigned long long rt_entry = STAMP ? (unsigned long long)wall_clock64() : 0ull;
#define PG8_STAMP() do { if (STAMP && wid == 0 && nts < 64) { const unsigned long long _c = (unsigned long long)clock64(); \
        ts_lo = (lane == nts) ? (int)(unsigned)_c : ts_lo; ts_hi = (lane == nts) ? (int)(unsigned)(_c >> 32) : ts_hi; ++nts; } } while (0)
    PG8_STAMP();
    unsigned voffA[2], voffB[2];
#pragma unroll
    for (int i = 0; i < 2; ++i) { int R, C; stage_rc(tid * 16 + i * 8192, R, C); const int Rb = Epi::PERM ? ((R & ~31) + perm32(R & 31)) : R;
        voffA[i] = (unsigned)(R * g.lda) + (unsigned)C * 2u; voffB[i] = (unsigned)(Rb * g.ldb) + (unsigned)C * 2u; }
    const size_t kstep = (size_t)(BK * 2);
    const size_t hstepA = (size_t)HALF * g.lda, hstepB = (size_t)HALF * g.ldb;
    const size_t tstepA = 2 * hstepA, tstepB = 2 * hstepB;
    const unsigned ldsw = (unsigned)wid * 1024u;
    const int aoff = lds_byte(wr * 64 + fr, fq * 8), boff = lds_byte(wc * 32 + fr, fq * 8);
#define PG8_SA(b, h) (((b) * 2 + (h)) * HTB)
#define PG8_SB(b, h) ((4 + (b) * 2 + (h)) * HTB)
#define PG8_STAGE(bufoff, gbase, voff) do { _Pragma("unroll") for (int _i = 0; _i < 2; ++_i) \
        __builtin_amdgcn_global_load_lds((const unsigned*)((const char*)(gbase) + (voff)[_i]), (PG8_LAS unsigned*)(lds + (bufoff) + ldsw + _i * 8192), 16, 0, 0); } while (0)
#define PG8_LDA(dst, b, h) do { _Pragma("unroll") for (int m = 0; m < 4; ++m) { const bf16x8 lo_ = *(const PG8_LAS bf16x8*)(lds + PG8_SA(b, h) + aoff + m * 2048), hi_ = *(const PG8_LAS bf16x8*)(lds + PG8_SA(b, h) + aoff + m * 2048 + 1024); \
        dst[m] = __builtin_shufflevector(lo_, hi_, 0, 1, 2, 3, 4, 5, 6, 7, 8, 9, 10, 11, 12, 13, 14, 15); } } while (0)
#define PG8_LDB(dst, b, h) do { _Pragma("unroll") for (int n = 0; n < 2; ++n) { const bf16x8 lo_ = *(const PG8_LAS bf16x8*)(lds + PG8_SB(b, h) + boff + n * 2048), hi_ = *(const PG8_LAS bf16x8*)(lds + PG8_SB(b, h) + boff + n * 2048 + 1024); \
        dst[n] = __builtin_shufflevector(lo_, hi_, 0, 1, 2, 3, 4, 5, 6, 7, 8, 9, 10, 11, 12, 13, 14, 15); } } while (0)
#define PG8_MMA(ai, bj, At, Bt) do { __builtin_amdgcn_s_setprio(1); _Pragma("unroll") for (int m = 0; m < 4; ++m) _Pragma("unroll") for (int n = 0; n < 2; ++n) \
        asm volatile("v_mfma_scale_f32_16x16x128_f8f6f4 %0, %1, %2, %0, %3, %4 op_sel_hi:[0,0,0]" : "+v"(acc[ai][bj][m][n]) : "v"(__builtin_bit_cast(v8i, Bt[n])), "v"(__builtin_bit_cast(v8i, At[m])), "v"(sbv), "v"(sav)); \
        __builtin_amdgcn_s_setprio(0); } while (0)
#define PG8_WAIT_V(n) asm volatile("s_waitcnt vmcnt(" #n ")" ::: "memory")
#define PG8_WAIT_L(n) asm volatile("s_waitcnt lgkmcnt(" #n ")" ::: "memory")
#define PG8_BAR __builtin_amdgcn_s_barrier()
#define PG8_SCHED __builtin_amdgcn_sched_barrier(0)
    Unit cur, nxt; int ui = 0;
    if (!S.next(0, cur)) return;
    f32x4 acc[2][2][4][2];
#pragma unroll
    for (int a = 0; a < 2; ++a)
#pragma unroll
        for (int b = 0; b < 2; ++b)
#pragma unroll
            for (int m = 0; m < 4; ++m)
#pragma unroll
                for (int n = 0; n < 2; ++n) acc[a][b][m][n] = (f32x4){0.f, 0.f, 0.f, 0.f};
    bf16x16 At[4], B0[2], B1[2];
    int sav = g.sa, sbv = g.sb;
    const char* cA = (const char*)g.A + (size_t)cur.pm * tstepA + (size_t)(cur.pn >> g.pshift) * g.koff; const char* cB = (const char*)g.Bt + (size_t)(cur.pn & g.pmask) * tstepB + (size_t)(cur.pn >> g.pshift) * g.koff;
    S.a_ready(cur);
    PG8_STAGE(PG8_SB(0, 0), cB, voffB); PG8_STAGE(PG8_SA(0, 0), cA, voffA); PG8_STAGE(PG8_SB(0, 1), cB + hstepB, voffB); PG8_STAGE(PG8_SA(0, 1), cA + hstepA, voffA);
    if (wr == 1) PG8_BAR;
    PG8_WAIT_V(4); PG8_BAR;
    PG8_STAGE(PG8_SB(1, 0), cB + kstep, voffB); PG8_STAGE(PG8_SA(1, 0), cA + kstep, voffA); PG8_STAGE(PG8_SB(1, 1), cB + hstepB + kstep, voffB);
    PG8_WAIT_V(6); PG8_BAR;
    PG8_STAMP();
    for (;;) {
        const bool has_next = S.next(ui + 1, nxt);
        const char* nA = has_next ? (const char*)g.A + (size_t)nxt.pm * tstepA + (size_t)(nxt.pn >> g.pshift) * g.koff : cA; const char* nB = has_next ? (const char*)g.Bt + (size_t)(nxt.pn & g.pmask) * tstepB + (size_t)(nxt.pn >> g.pshift) * g.koff : cB;
        for (int t = 0; t < nt; t += 2) {
            const bool last = (t == nt - 2);
            const char* a1 = cA + (size_t)(t + 1) * kstep;
            const char* a2 = last ? nA : cA + (size_t)(t + 2) * kstep; const char* b2 = last ? nB : cB + (size_t)(t + 2) * kstep;
            const char* a3 = a2 + kstep; const char* b3 = b2 + kstep;
            if (last && has_next) S.a_ready(nxt);
            PG8_LDB(B0, 0, 0); PG8_SCHED; PG8_LDA(At, 0, 0); PG8_STAGE(PG8_SA(1, 1), a1 + hstepA, voffA);
            PG8_WAIT_L(8); PG8_BAR; PG8_WAIT_L(0); PG8_MMA(0, 0, At, B0); PG8_BAR; PG8_SCHED;
            PG8_LDB(B1, 0, 1); PG8_STAGE(PG8_SB(0, 0), b2, voffB);
            PG8_BAR; PG8_WAIT_L(0); PG8_MMA(0, 1, At, B1); PG8_BAR;
            PG8_LDA(At, 0, 1); PG8_STAGE(PG8_SA(0, 0), a2, voffA);
            PG8_BAR; PG8_WAIT_L(0); PG8_MMA(1, 0, At, B0); PG8_BAR; PG8_SCHED;
            PG8_STAGE(PG8_SB(0, 1), b2 + hstepB, voffB);
            PG8_WAIT_V(6); PG8_BAR; PG8_MMA(1, 1, At, B1); PG8_BAR;
            PG8_LDB(B0, 1, 0); PG8_SCHED; PG8_LDA(At, 1, 0); PG8_STAGE(PG8_SA(0, 1), a2 + hstepA, voffA);
            PG8_WAIT_L(8); PG8_BAR; PG8_WAIT_L(0); PG8_MMA(0, 0, At, B0); PG8_BAR; PG8_SCHED;
            PG8_LDB(B1, 1, 1); PG8_STAGE(PG8_SB(1, 0), b3, voffB);
            PG8_BAR; PG8_WAIT_L(0); PG8_MMA(0, 1, At, B1); PG8_BAR;
            PG8_LDA(At, 1, 1); PG8_STAGE(PG8_SA(1, 0), a3, voffA);
            PG8_BAR; PG8_WAIT_L(0); PG8_MMA(1, 0, At, B0); PG8_BAR; PG8_SCHED;
            PG8_STAGE(PG8_SB(1, 1), b3 + hstepB, voffB);
            PG8_WAIT_V(6); PG8_BAR; PG8_MMA(1, 1, At, B1); PG8_BAR;
        }
        asm volatile("s_nop 15\n\ts_nop 7" ::: "memory");
        PG8_STAMP();
        if constexpr (!Epi::AFTER_DRAIN) { E(acc, cur, wr, wc, fr, fq); S.done(cur); }
        PG8_STAMP();
        if (!has_next) break;
#pragma unroll
        for (int a = 0; a < 2; ++a)
#pragma unroll
            for (int b = 0; b < 2; ++b)
#pragma unroll
                for (int m = 0; m < 4; ++m)
#pragma unroll
                    for (int n = 0; n < 2; ++n) acc[a][b][m][n] = (f32x4){0.f, 0.f, 0.f, 0.f};
        cur = nxt; cA = nA; cB = nB; ++ui;
    }
    PG8_WAIT_V(0);
    if (wr == 0) PG8_BAR;
    PG8_BAR;
    if constexpr (Epi::AFTER_DRAIN) { E.fused(acc, cur, wr, wc, fr, fq, lds, wid, lane); S.done(cur); }
    PG8_STAMP();
    if (STAMP && wid == 0) { stamps[lane] = lane < nts ? (((unsigned long long)(unsigned)ts_hi << 32) | (unsigned)ts_lo) : 0ull;
        if (lane == 62) stamps[62] = rt_entry; if (lane == 63) stamps[63] = (unsigned long long)wall_clock64(); }
#undef PG8_STAMP
#undef PG8_SA
#undef PG8_SB
#undef PG8_STAGE
#undef PG8_LDA
#undef PG8_LDB
#undef PG8_MMA
#undef PG8_WAIT_V
#undef PG8_WAIT_L
#undef PG8_BAR
#undef PG8_SCHED
}
}

using pg8::bf16_t; using pg8::f32x4; using pg8::u32x4; using pg8::Unit; using pg8::Gemm; using pg8::cvt_pk_bf16;
typedef float f32x2 __attribute__((ext_vector_type(2)));
typedef unsigned u32x2 __attribute__((ext_vector_type(2)));
#define LAS __attribute__((address_space(3)))

constexpr int DM = 1024, NBATCH = 8, SEQ = 2048, NTOK = NBATCH * SEQ, DEPTH = 4, NMEM = 256, INC = 12288;
constexpr int C_R = 0, C_K = 1024, C_V = 2048, C_DW = 3072, C_WQ = 3328, C_WK = 4352, C_WV = 4608, C_DQ = 4864, C_DK = 5888, C_DV = 6912, C_MQ = 7936, C_GATE = 8192;
constexpr int RWC = 3328, LORA_N = 5120, BRK = 3328;
constexpr float DN_ALPHA = 1.6817928305074290f;
constexpr int NEXP = 16, CAP = 256, DEXP = 2048;

enum { I_X = 0, I_MEM, I_RELB, I_WIN, I_MU, I_W0, I_WUP, I_A0, I_AUP, I_GUP, I_KK, I_KA, I_RK, I_GNG, I_GNB, I_SINK, I_LAM, I_SUBLN, I_WKV, I_WBR, I_WOUT,
       I_LN1G, I_LN1B, I_ROUTER, I_EWG, I_EWU, I_EWD, I_LN2G, I_LN2B, N_IN };

constexpr size_t MiB = 1ull << 20;
constexpr size_t WS_CTL = 0;
constexpr size_t WS_WIN = 1 * MiB;
constexpr size_t WS_WBR = WS_WIN + 96 * MiB;
constexpr size_t WS_WOUT = WS_WBR + 26 * MiB;
constexpr size_t WS_WKV = WS_WOUT + 8 * MiB;
constexpr size_t WS_WGU = WS_WKV + 4 * MiB;
constexpr size_t WS_WDN = WS_WGU + 512 * MiB;
constexpr size_t WS_MBP = WS_WGU + 256 * MiB;
constexpr size_t WS_GATEP = WS_WDN + 128 * MiB;
constexpr size_t WS_WLORA = WS_WDN + 256 * MiB;
constexpr size_t WS_XF = WS_WLORA + 10 * MiB;
constexpr size_t WS_XB = WS_XF + 64 * MiB;
constexpr size_t WS_MEMB = WS_XB + 32 * MiB;
constexpr size_t WS_KVMEM = WS_MEMB + 4 * MiB;
constexpr size_t WS_P = WS_KVMEM + 8 * MiB;
constexpr size_t WS_XE = WS_P, WS_H = WS_P + 64 * MiB, WS_YE = WS_P + 192 * MiB;
constexpr size_t WS_APR = WS_P + 384 * MiB;
constexpr size_t WS_LORA = WS_APR + 8 * MiB;
constexpr size_t WS_YDIR = WS_LORA + 160 * MiB;
constexpr size_t WS_BONUS = WS_YDIR + 128 * MiB;
constexpr size_t WS_YCAT = WS_BONUS + 2 * MiB;
constexpr size_t WS_MF = WS_YCAT + 104 * MiB;
constexpr size_t WS_PRELN = WS_MF + 64 * MiB;
constexpr size_t WS_DTMP = WS_MF;
constexpr size_t WS_MB = WS_PRELN + 64 * MiB;
constexpr size_t WS_AFF = WS_MB + 32 * MiB;
constexpr size_t WS_GROW = WS_AFF + 1 * MiB;
constexpr size_t WS_SLOT = WS_GROW + 1 * MiB;
constexpr size_t WS_END = WS_SLOT + 1 * MiB;

struct Params {
    const float* in[N_IN];
    float* out;
    unsigned char* ws;
    int ph_lo, ph_hi;
    int fused, pad0;
};

#define CAS __attribute__((address_space(4)))
__device__ __forceinline__ const CAS unsigned char* karg_base() { const CAS unsigned char* q = (const CAS unsigned char*)__builtin_amdgcn_kernarg_segment_ptr(); asm volatile("" : "+s"(q)); return q; }
__device__ __forceinline__ const float* kin(int i) { return ((const float* const CAS*)karg_base())[i]; }
__device__ __forceinline__ float* kout() { return *(float* const CAS*)(karg_base() + N_IN * 8); }
__device__ __forceinline__ unsigned char* kws() { return *(unsigned char* const CAS*)(karg_base() + N_IN * 8 + 8); }
constexpr int LDS_BYTES = 145 * 1024;
constexpr int NTHR = 512;

__device__ __forceinline__ float bf2f(unsigned v) { return __uint_as_float(v << 16); }
__device__ __forceinline__ float bflo(unsigned v) { return __uint_as_float(v << 16); }
__device__ __forceinline__ float bfhi(unsigned v) { return __uint_as_float(v & 0xffff0000u); }
__device__ __forceinline__ unsigned short f2bf(float f) { unsigned u = __float_as_uint(f); u += 0x7FFFu + ((u >> 16) & 1u); return (unsigned short)(u >> 16); }
__device__ __forceinline__ int lane_id() { unsigned z = 0u; asm volatile("" : "+v"(z)); return (int)__builtin_amdgcn_mbcnt_hi(~0u, __builtin_amdgcn_mbcnt_lo(~0u, z)); }
__device__ __forceinline__ int otid(int wv) { int t = wv * 64 + lane_id(); asm volatile("" : "+v"(t)); return t; }
__device__ __forceinline__ float shfl_xor_o(float v, int mask) { const int lid = lane_id(); return __builtin_bit_cast(float, __builtin_amdgcn_ds_bpermute((lid ^ mask) << 2, __builtin_bit_cast(int, v))); }
__device__ __forceinline__ float wave_sum(float v) {
    const int lid = lane_id();
#pragma unroll
    for (int o = 1; o < 64; o <<= 1) v += __builtin_bit_cast(float, __builtin_amdgcn_ds_bpermute((lid ^ o) << 2, __builtin_bit_cast(int, v)));
    return v;
}
__device__ __forceinline__ float dpp_xor1(float v) { return __builtin_bit_cast(float, __builtin_amdgcn_update_dpp(0, __builtin_bit_cast(int, v), 0xB1, 0xF, 0xF, true)); }
__device__ __forceinline__ float dpp_xor2(float v) { return __builtin_bit_cast(float, __builtin_amdgcn_update_dpp(0, __builtin_bit_cast(int, v), 0x4E, 0xF, 0xF, true)); }
__device__ __forceinline__ float dpp_hmir(float v) { return __builtin_bit_cast(float, __builtin_amdgcn_update_dpp(0, __builtin_bit_cast(int, v), 0x141, 0xF, 0xF, true)); }
__device__ __forceinline__ float sum8(float v) { v += dpp_xor1(v); v += dpp_xor2(v); v += dpp_hmir(v); return v; }
__device__ __forceinline__ float dpp_mir(float v) { return __builtin_bit_cast(float, __builtin_amdgcn_update_dpp(0, __builtin_bit_cast(int, v), 0x140, 0xF, 0xF, true)); }
__device__ __forceinline__ float sum16(float v) { v = sum8(v); v += dpp_mir(v); return v; }
__device__ __forceinline__ float sigmoidf_(float x) { return __builtin_amdgcn_rcpf(1.0f + __expf(-x)); }
__device__ __forceinline__ int t5_bucket(int rel) {
    const int n = rel < 0 ? -rel : rel;
    int large = 2 + (31 - __clz(n * n));
    large = large > 15 ? 15 : large;
    return (rel > 0 ? 16 : 0) + (n < 8 ? n : large);
}

struct GroupedOrder {
    int nMe, nNe, upe, total, G, c;
    __device__ void init(int nMe_, int nNe_, int E, int G_, int c_) { nMe = nMe_; nNe = nNe_; upe = nMe_ * nNe_; total = upe * E; G = G_; c = c_; }
    __device__ bool next(int i, Unit& u) const {
        const int L = i * G + c; if (L >= total) return false;
        const int e = L / upe, rem = L % upe, x = rem & 7, j = rem >> 3;
        const int am = nMe >> 1, pm_e = (x & 1) * am + (j % am), pn_e = (x >> 1) * (nNe >> 2) + (j / am);
        u.pm = e * nMe + pm_e; u.pn = e * nNe + pn_e; return true;
    }
    __device__ __forceinline__ void a_ready(const Unit&) const {}
    __device__ __forceinline__ void done(const Unit&) const {}
};

__device__ __forceinline__ void st_block_bf16(LAS unsigned char* sw, int woff, int roff, const u32x4& X, const u32x4& Y, bf16_t* rowp, size_t ldc) {
    *(LAS u32x4*)(sw + woff) = X; *(LAS u32x4*)(sw + (woff ^ 64)) = Y;
    const u32x4 r0 = *(const LAS u32x4*)(sw + roff), r1 = *(const LAS u32x4*)(sw + roff + 1024);
    *(u32x4*)rowp = r0; *(u32x4*)(rowp + 8 * ldc) = r1;
}
#define ST_BLOCK_SETUP(st_) LAS unsigned char* sw = (st_) + (wr * 4 + wc) * 2048; const int woff = fr * 128 + ((fq ^ (fr & 7)) << 4), lane_ = fq * 16 + fr, rrow = lane_ >> 3, rp = lane_ & 7, roff = rrow * 128 + ((rp ^ (rrow & 7)) << 4)
struct EpiBf16Store {
    static constexpr bool PERM = true, AFTER_DRAIN = false;
    bf16_t* O; int ldc; LAS unsigned char* st;
    bf16_t* GP;
    __device__ __forceinline__ void operator()(const f32x4 (&acc)[2][2][4][2], const Unit& u, int wr, int wc, int fr, int fq) const {
        typedef float fv8_ __attribute__((ext_vector_type(8))); typedef __bf16 bfv8_ __attribute__((ext_vector_type(8)));
        if (GP != nullptr && u.pn >= 32) {
            u32x4* gp = (u32x4*)GP + ((size_t)((u.pm * 16 + (u.pn - 32)) * 8 + wr * 4 + wc) * 16) * 64 + fq * 16 + fr;
#pragma unroll
            for (int ai = 0; ai < 2; ++ai)
#pragma unroll
                for (int m = 0; m < 4; ++m)
#pragma unroll
                    for (int bj = 0; bj < 2; ++bj) { const f32x4 v0 = acc[ai][bj][m][0], v1 = acc[ai][bj][m][1];
                        const fv8_ x8 = {v0[0], v0[1], v0[2], v0[3], v1[0], v1[1], v1[2], v1[3]};
                        gp[((ai * 4 + m) * 2 + bj) * 64] = __builtin_bit_cast(u32x4, __builtin_convertvector(x8, bfv8_)); }
            return;
        }
        ST_BLOCK_SETUP(st);
        bf16_t* op = O + (size_t)(u.pm * 256 + wr * 64 + rrow) * ldc + u.pn * 256 + wc * 64 + rp * 8;
#pragma unroll
        for (int ai = 0; ai < 2; ++ai)
#pragma unroll
            for (int m = 0; m < 4; ++m) { u32x4 wq[2];
#pragma unroll
                for (int bj = 0; bj < 2; ++bj) { const f32x4 v0 = acc[ai][bj][m][0], v1 = acc[ai][bj][m][1];
                    const fv8_ x8 = {v0[0], v0[1], v0[2], v0[3], v1[0], v1[1], v1[2], v1[3]};
                    wq[bj] = __builtin_bit_cast(u32x4, __builtin_convertvector(x8, bfv8_)); }
                st_block_bf16(sw, woff, roff, wq[0], wq[1], op + (size_t)(ai * 128 + m * 16) * ldc, ldc); }
    }
};
struct EpiLora {
    static constexpr bool PERM = true, AFTER_DRAIN = false;
    bf16_t* O; const float* w0; const float* a0;
    __device__ __forceinline__ void operator()(const f32x4 (&acc)[2][2][4][2], const Unit& u, int wr, int wc, int fr, int fq) const {
        const int row0 = u.pm * 256 + wr * 64 + fr, col0 = u.pn * 256 + wc * 64 + 8 * fq;
        const int region = u.pn >> 3;
        f32x4 bv[2][2];
#pragma unroll
        for (int bj = 0; bj < 2; ++bj)
#pragma unroll
            for (int n = 0; n < 2; ++n) { const int c = col0 + bj * 32 + 4 * n;
                bv[bj][n] = region == 0 ? *(const f32x4*)(w0 + c) : (region == 1 ? *(const f32x4*)(a0 + (c - 2048)) : (f32x4){0.f, 0.f, 0.f, 0.f}); }
#pragma unroll
        for (int ai = 0; ai < 2; ++ai)
#pragma unroll
            for (int m = 0; m < 4; ++m) { bf16_t* rowp = O + (size_t)(row0 + ai * 128 + m * 16) * LORA_N + col0;
#pragma unroll
                for (int bj = 0; bj < 2; ++bj) { f32x4 v0 = acc[ai][bj][m][0] + bv[bj][0], v1 = acc[ai][bj][m][1] + bv[bj][1];
                    if (region < 2) {
                        const float sc = region == 0 ? -0.6065306597126334f : 1.0f;
#pragma unroll
                        for (int j = 0; j < 4; ++j) { v0[j] = sc * sigmoidf_(v0[j]); v1[j] = sc * sigmoidf_(v1[j]); }
                    }
                    u32x4 w; w.x = cvt_pk_bf16(v0[0], v0[1]); w.y = cvt_pk_bf16(v0[2], v0[3]); w.z = cvt_pk_bf16(v1[0], v1[1]); w.w = cvt_pk_bf16(v1[2], v1[3]);
                    *(u32x4*)(rowp + bj * 32) = w; } }
    }
};
struct BranchOrder {
    pg8::StaticOrder S0;
    __device__ __forceinline__ void init(int M, int N, int G_, int c_) { S0.init(M, N, G_, c_); }
    __device__ __forceinline__ bool next(int i, Unit& u) const { if (i >= 4) return false; Unit t; if (!S0.next(0, t)) return false; u.pm = t.pm; u.pn = i * 4 + t.pn; return true; }
    __device__ __forceinline__ void a_ready(const Unit&) const {}
    __device__ __forceinline__ void done(const Unit&) const {}
};
struct EpiBranchAll {
    static constexpr bool PERM = true, AFTER_DRAIN = false;
    const bf16_t* gateP;
    bf16_t* mbP; bf16_t* mb; LAS unsigned char* st;
    __device__ __forceinline__ void operator()(const f32x4 (&acc)[2][2][4][2], const Unit& u, int wr, int wc, int fr, int fq) const {
        const int wv8 = wr * 4 + wc, ln = fq * 16 + fr, br = u.pn >> 2, pn = u.pn & 3, MODE = br == 0 ? 0 : (br == 3 ? 2 : 1);
        const u32x4* gp = (const u32x4*)gateP + ((size_t)((u.pm * 16 + br * 4 + pn) * 8 + wv8) * 16) * 64 + ln;
        u32x4* mp = (u32x4*)mbP + ((size_t)((u.pm * 4 + pn) * 8 + wv8) * 16) * 64 + ln;
        u32x4 gw[2][4][2];
#pragma unroll
        for (int ai = 0; ai < 2; ++ai)
#pragma unroll
            for (int m = 0; m < 4; ++m)
#pragma unroll
                for (int bj = 0; bj < 2; ++bj) gw[ai][m][bj] = gp[((ai * 4 + m) * 2 + bj) * 64];
        asm volatile("" ::: "memory");
        f32x4 v[2][4][2][2];
#pragma unroll
        for (int ai = 0; ai < 2; ++ai)
#pragma unroll
            for (int m = 0; m < 4; ++m)
#pragma unroll
                for (int bj = 0; bj < 2; ++bj) { const u32x4 g = gw[ai][m][bj]; f32x4 g0, g1;
                    g0[0] = sigmoidf_(bflo(g.x)); g0[1] = sigmoidf_(bfhi(g.x)); g0[2] = sigmoidf_(bflo(g.y)); g0[3] = sigmoidf_(bfhi(g.y));
                    g1[0] = sigmoidf_(bflo(g.z)); g1[1] = sigmoidf_(bfhi(g.z)); g1[2] = sigmoidf_(bflo(g.w)); g1[3] = sigmoidf_(bfhi(g.w));
                    v[ai][m][bj][0] = acc[ai][bj][m][0] * g0; v[ai][m][bj][1] = acc[ai][bj][m][1] * g1; }
        if (MODE >= 1) {
#pragma unroll
            for (int ai = 0; ai < 2; ++ai)
#pragma unroll
                for (int m = 0; m < 4; ++m)
#pragma unroll
                    for (int bj = 0; bj < 2; ++bj) gw[ai][m][bj] = mp[((ai * 4 + m) * 2 + bj) * 64];
            asm volatile("" ::: "memory");
#pragma unroll
            for (int ai = 0; ai < 2; ++ai)
#pragma unroll
                for (int m = 0; m < 4; ++m)
#pragma unroll
                    for (int bj = 0; bj < 2; ++bj) { const u32x4 o = gw[ai][m][bj];
                        v[ai][m][bj][0][0] += bflo(o.x); v[ai][m][bj][0][1] += bfhi(o.x); v[ai][m][bj][0][2] += bflo(o.y); v[ai][m][bj][0][3] += bfhi(o.y);
                        v[ai][m][bj][1][0] += bflo(o.z); v[ai][m][bj][1][1] += bfhi(o.z); v[ai][m][bj][1][2] += bflo(o.w); v[ai][m][bj][1][3] += bfhi(o.w); }
        }
        if (MODE < 2) {
#pragma unroll
            for (int ai = 0; ai < 2; ++ai)
#pragma unroll
                for (int m = 0; m < 4; ++m)
#pragma unroll
                    for (int bj = 0; bj < 2; ++bj) { const f32x4 v0 = v[ai][m][bj][0], v1 = v[ai][m][bj][1];
                        u32x4 w; w.x = cvt_pk_bf16(v0[0], v0[1]); w.y = cvt_pk_bf16(v0[2], v0[3]); w.z = cvt_pk_bf16(v1[0], v1[1]); w.w = cvt_pk_bf16(v1[2], v1[3]);
                        mp[((ai * 4 + m) * 2 + bj) * 64] = w; }
        } else {
            ST_BLOCK_SETUP(st);
            bf16_t* op = mb + (size_t)(u.pm * 256 + wr * 64 + rrow) * DM + pn * 256 + wc * 64 + rp * 8;
#pragma unroll
            for (int ai = 0; ai < 2; ++ai)
#pragma unroll
                for (int m = 0; m < 4; ++m) { u32x4 wq[2];
#pragma unroll
                    for (int bj = 0; bj < 2; ++bj) { const f32x4 v0 = v[ai][m][bj][0], v1 = v[ai][m][bj][1];
                        wq[bj].x = cvt_pk_bf16(v0[0], v0[1]); wq[bj].y = cvt_pk_bf16(v0[2], v0[3]); wq[bj].z = cvt_pk_bf16(v1[0], v1[1]); wq[bj].w = cvt_pk_bf16(v1[2], v1[3]); }
                    st_block_bf16(sw, woff, roff, wq[0], wq[1], op + (size_t)(ai * 128 + m * 16) * DM, DM); }
        }
    }
};
struct EpiResid {
    static constexpr bool PERM = true, AFTER_DRAIN = false;
    const float* xf; float* o;
    __device__ __forceinline__ void operator()(const f32x4 (&acc)[2][2][4][2], const Unit& u, int wr, int wc, int fr, int fq) const {
        const int row0 = u.pm * 256 + wr * 64 + fr, col0 = u.pn * 256 + wc * 64 + 8 * fq;
#pragma unroll
        for (int ai = 0; ai < 2; ++ai) {
            f32x4 xv[4][2][2];
#pragma unroll
            for (int m = 0; m < 4; ++m)
#pragma unroll
                for (int bj = 0; bj < 2; ++bj) { const size_t off = (size_t)(row0 + ai * 128 + m * 16) * DM + col0 + bj * 32; xv[m][bj][0] = *(const f32x4*)(xf + off); xv[m][bj][1] = *(const f32x4*)(xf + off + 4); }
            asm volatile("" ::: "memory");
#pragma unroll
            for (int m = 0; m < 4; ++m)
#pragma unroll
                for (int bj = 0; bj < 2; ++bj) { const size_t off = (size_t)(row0 + ai * 128 + m * 16) * DM + col0 + bj * 32;
                    *(f32x4*)(o + off) = xv[m][bj][0] * DN_ALPHA + acc[ai][bj][m][0]; *(f32x4*)(o + off + 4) = xv[m][bj][1] * DN_ALPHA + acc[ai][bj][m][1]; }
            asm volatile("" ::: "memory");
        }
    }
};
constexpr float W8_SCALE = 64.0f, H8_SCALE = 16.0f;
constexpr int E8_ONE = 0x7F7F7F7F, E8_W = 0x79797979  , E8_H = 0x7B7B7B7B  ;
__device__ __forceinline__ unsigned pk_fp8x4(float a, float b, float c, float d) { int w = __builtin_amdgcn_cvt_pk_fp8_f32(a, b, 0, false); w = __builtin_amdgcn_cvt_pk_fp8_f32(c, d, w, true); return (unsigned)w; }
struct EpiSwiGLU {
    static constexpr bool PERM = true, AFTER_DRAIN = false;
    unsigned char* H;
    __device__ __forceinline__ void operator()(const f32x4 (&acc)[2][2][4][2], const Unit& u, int wr, int wc, int fr, int fq) const {
        const int row0 = u.pm * 256 + wr * 64 + fr, col0 = (u.pn & 15) * 128 + wc * 32 + 8 * fq;
#pragma unroll
        for (int ai = 0; ai < 2; ++ai)
#pragma unroll
            for (int m = 0; m < 4; ++m) { unsigned char* rowp = H + (size_t)(row0 + ai * 128 + m * 16) * DEXP + col0;
                f32x4 v[2];
#pragma unroll
                for (int n = 0; n < 2; ++n)
#pragma unroll
                    for (int j = 0; j < 4; ++j) { const float g = acc[ai][0][m][n][j], up = acc[ai][1][m][n][j]; v[n][j] = g * sigmoidf_(g) * up * H8_SCALE; }
                u32x2 w; w.x = pk_fp8x4(v[0][0], v[0][1], v[0][2], v[0][3]); w.y = pk_fp8x4(v[1][0], v[1][1], v[1][2], v[1][3]);
                *(u32x2*)rowp = w; }
    }
};
struct EpiDown {
    static constexpr bool PERM = true, AFTER_DRAIN = false;
    bf16_t* Y; const float* grow;
    __device__ __forceinline__ void operator()(const f32x4 (&acc)[2][2][4][2], const Unit& u, int wr, int wc, int fr, int fq) const {
        const int row0 = u.pm * 256 + wr * 64 + fr, col0 = (u.pn & 3) * 256 + wc * 64 + 8 * fq;
        float gr[2][4];
#pragma unroll
        for (int ai = 0; ai < 2; ++ai)
#pragma unroll
            for (int m = 0; m < 4; ++m) gr[ai][m] = grow[row0 + ai * 128 + m * 16];
#pragma unroll
        for (int ai = 0; ai < 2; ++ai)
#pragma unroll
            for (int m = 0; m < 4; ++m) { const int row = row0 + ai * 128 + m * 16; const float g = gr[ai][m]; bf16_t* rowp = Y + (size_t)row * DM + col0;
#pragma unroll
                for (int bj = 0; bj < 2; ++bj) { const f32x4 v0 = acc[ai][bj][m][0] * g, v1 = acc[ai][bj][m][1] * g;
                    u32x4 w; w.x = cvt_pk_bf16(v0[0], v0[1]); w.y = cvt_pk_bf16(v0[2], v0[3]); w.z = cvt_pk_bf16(v1[0], v1[1]); w.w = cvt_pk_bf16(v1[2], v1[3]);
                    *(u32x4*)(rowp + bj * 32) = w; } }
    }
};

__device__ __forceinline__ int wcont_row(int gn) { return (gn & ~255) | (((gn >> 5) & 1) << 7) | (((gn >> 6) & 3) << 5) | (gn & 31); }
__device__ __forceinline__ void tconv(const float* __restrict__ src, int nb, int K, int N, bf16_t* __restrict__ dst, size_t dst_bs, int ldd, int blk, int bstride, int boff, float* tile, int wv) {
    const int tid = otid(wv), ntn = N >> 8, tpb = (K >> 6) * ntn, nt = nb * tpb;
    f32x4 v[8];
#define TC_LOAD(t_) do { const int bi_ = (t_) / tpb, tr_ = (t_) % tpb, k0_ = (tr_ / ntn) * 64, n0_ = (tr_ % ntn) * 256; const float* sb_ = src + (size_t)bi_ * K * N; \
        _Pragma("unroll") for (int i = 0; i < 8; ++i) { const int kk = i * 8 + (tid >> 6), nn = (tid & 63) * 4; v[i] = *(const f32x4*)(sb_ + (size_t)(k0_ + kk) * N + n0_ + nn); } } while (0)
    int t = blockIdx.x;
    if (t < nt) TC_LOAD(t);
    for (; t < nt; t += gridDim.x) {
        const int bi = t / tpb, tr = t % tpb, k0 = (tr / ntn) * 64, n0 = (tr % ntn) * 256;
#pragma unroll
        for (int i = 0; i < 8; ++i) { const int kk = i * 8 + (tid >> 6), nn = (tid & 63) * 4; float* tp = tile + kk * 257 + nn; tp[0] = v[i][0]; tp[1] = v[i][1]; tp[2] = v[i][2]; tp[3] = v[i][3]; }
        __syncthreads();
        if (t + (int)gridDim.x < nt) TC_LOAD(t + (int)gridDim.x);
        bf16_t* db = dst + (size_t)bi * dst_bs;
#pragma unroll
        for (int j = 0; j < 4; ++j) { const int q = tid + 512 * j, n = q >> 3, kc = q & 7; const float* s = tile + (kc * 8) * 257 + n;
            u32x4 o; o.x = cvt_pk_bf16(s[0], s[257]); o.y = cvt_pk_bf16(s[2 * 257], s[3 * 257]); o.z = cvt_pk_bf16(s[4 * 257], s[5 * 257]); o.w = cvt_pk_bf16(s[6 * 257], s[7 * 257]);
            const int gn = n0 + n, drow = blk == (1 << 30) ? wcont_row(gn) : (gn / blk) * bstride + boff + (gn % blk);
            *(u32x4*)(db + (size_t)drow * ldd + k0 + kc * 8) = o; }
        __syncthreads();
    }
#undef TC_LOAD
}
__device__ __forceinline__ void tconv8(const float* __restrict__ src, int nb, int K, int N, unsigned char* __restrict__ dst, size_t dst_bs, int ldd, int blk, int bstride, int boff, float sc, float* tile, int wv) {
    const int tid = otid(wv), ntn = N >> 7, tpb = (K >> 7) * ntn, nt = nb * tpb;
    f32x4 v[8];
#define TC_LOAD(t_) do { const int bi_ = (t_) / tpb, tr_ = (t_) % tpb, k0_ = (tr_ / ntn) * 128, n0_ = (tr_ % ntn) * 128; const float* sb_ = src + (size_t)bi_ * K * N; \
        _Pragma("unroll") for (int i = 0; i < 8; ++i) { const int kk = i * 16 + (tid >> 5), nn = (tid & 31) * 4; v[i] = *(const f32x4*)(sb_ + (size_t)(k0_ + kk) * N + n0_ + nn); } } while (0)
    int t = blockIdx.x;
    if (t < nt) TC_LOAD(t);
    for (; t < nt; t += gridDim.x) {
        const int bi = t / tpb, tr = t % tpb, k0 = (tr / ntn) * 128, n0 = (tr % ntn) * 128;
#pragma unroll
        for (int i = 0; i < 8; ++i) { const int kk = i * 16 + (tid >> 5), nn = (tid & 31) * 4; float* tp = tile + kk * 129 + nn; tp[0] = v[i][0]; tp[1] = v[i][1]; tp[2] = v[i][2]; tp[3] = v[i][3]; }
        __syncthreads();
        if (t + (int)gridDim.x < nt) TC_LOAD(t + (int)gridDim.x);
        unsigned char* db = dst + (size_t)bi * dst_bs;
#pragma unroll
        for (int j = 0; j < 2; ++j) { const int q = tid + 512 * j, n = q >> 3, kc = q & 7; const float* s = tile + (kc * 16) * 129 + n;
            u32x4 o;
            o.x = pk_fp8x4(s[0] * sc, s[129] * sc, s[2 * 129] * sc, s[3 * 129] * sc); o.y = pk_fp8x4(s[4 * 129] * sc, s[5 * 129] * sc, s[6 * 129] * sc, s[7 * 129] * sc);
            o.z = pk_fp8x4(s[8 * 129] * sc, s[9 * 129] * sc, s[10 * 129] * sc, s[11 * 129] * sc); o.w = pk_fp8x4(s[12 * 129] * sc, s[13 * 129] * sc, s[14 * 129] * sc, s[15 * 129] * sc);
            const int gn = n0 + n, drow = blk == (1 << 30) ? wcont_row(gn) : (gn / blk) * bstride + boff + (gn % blk);
            *(u32x4*)(db + (size_t)drow * ldd + k0 + kc * 16) = o; }
        __syncthreads();
    }
#undef TC_LOAD
}

__device__ __forceinline__ void phase_convert(const Params& P, float* ldsf) {
    unsigned char* ws = kws();
    const int NOBLK = 1 << 30;
    tconv(kin(I_WIN), DEPTH, DM, INC, (bf16_t*)(ws + WS_WIN), (size_t)INC * DM, DM, NOBLK, 0, 0, ldsf, P.pad0);
    tconv(kin(I_WBR), DEPTH, BRK, DM, (bf16_t*)(ws + WS_WBR), (size_t)DM * BRK, BRK, NOBLK, 0, 0, ldsf, P.pad0);
    tconv(kin(I_WOUT), DEPTH, DM, DM, (bf16_t*)(ws + WS_WOUT), (size_t)DM * DM, DM, NOBLK, 0, 0, ldsf, P.pad0);
    tconv(kin(I_WKV), DEPTH, DM, 512, (bf16_t*)(ws + WS_WKV), (size_t)512 * DM, DM, NOBLK, 0, 0, ldsf, P.pad0);
    tconv8(kin(I_EWG), DEPTH * NEXP, DM, DEXP, ws + WS_WGU, (size_t)4096 * DM, DM, 128, 256, 0, W8_SCALE, ldsf, P.pad0);
    tconv8(kin(I_EWU), DEPTH * NEXP, DM, DEXP, ws + WS_WGU, (size_t)4096 * DM, DM, 128, 256, 128, W8_SCALE, ldsf, P.pad0);
    tconv8(kin(I_EWD), DEPTH * NEXP, DEXP, DM, ws + WS_WDN, (size_t)DM * DEXP, DEXP, NOBLK, 0, 0, W8_SCALE, ldsf, P.pad0);
    for (int l = 0; l < DEPTH; ++l) {
        bf16_t* wl = (bf16_t*)(ws + WS_WLORA) + (size_t)l * LORA_N * 256;
        tconv(kin(I_WUP) + (size_t)l * 2 * 64 * 1024, 2, 64, 1024, wl, (size_t)1024 * 256, 256, NOBLK, 0, 0, ldsf, P.pad0);
        tconv(kin(I_AUP) + (size_t)l * 2 * 64 * 1024, 2, 64, 1024, wl + (size_t)2048 * 256 + 64, (size_t)1024 * 256, 256, NOBLK, 0, 0, ldsf, P.pad0);
        tconv(kin(I_GUP) + (size_t)l * 128 * 1024, 1, 128, 1024, wl + (size_t)4096 * 256 + 128, 0, 256, NOBLK, 0, 0, ldsf, P.pad0);
    }
    const size_t gtid = (size_t)blockIdx.x * NTHR + otid(P.pad0), gsz = (size_t)gridDim.x * NTHR;
    { u32x4* wl4 = (u32x4*)(ws + WS_WLORA); const u32x4 zz = {0u, 0u, 0u, 0u};
      for (size_t i = gtid; i < (size_t)DEPTH * LORA_N * 32; i += gsz) { const int k8 = (int)(i & 31), n = (int)((i >> 5) % LORA_N);
          const bool blockpart = n < 2048 ? (k8 < 8) : (n < 4096 ? (k8 >= 8 && k8 < 16) : (k8 >= 16));
          if (!blockpart) wl4[i] = zz; } }
    { const f32x4* x4 = (const f32x4*)kin(I_X); f32x4* xf4 = (f32x4*)(ws + WS_XF); u32x2* xb2 = (u32x2*)(ws + WS_XB);
      for (size_t i0 = gtid; i0 < (size_t)NTOK * DM / 4; i0 += gsz * 8) { f32x4 v[8];
#pragma unroll
          for (int q = 0; q < 8; ++q) { const size_t i = i0 + q * gsz; v[q] = i < (size_t)NTOK * DM / 4 ? x4[i] : (f32x4){0.f, 0.f, 0.f, 0.f}; }
#pragma unroll
          for (int q = 0; q < 8; ++q) { const size_t i = i0 + q * gsz; if (i < (size_t)NTOK * DM / 4) { xf4[i] = v[q]; u32x2 w; w.x = cvt_pk_bf16(v[q][0], v[q][1]); w.y = cvt_pk_bf16(v[q][2], v[q][3]); xb2[i] = w; } } } }
    { const f32x4* m4 = (const f32x4*)kin(I_MEM); u32x2* mb2 = (u32x2*)(ws + WS_MEMB);
      for (size_t i = gtid; i < (size_t)NBATCH * NMEM * DM / 4; i += gsz) { const f32x4 v = m4[i]; u32x2 w; w.x = cvt_pk_bf16(v[0], v[1]); w.y = cvt_pk_bf16(v[2], v[3]); mb2[i] = w; } }
}

__device__ __forceinline__ void phase_prepass(const Params& P, int l) {
    const bf16_t* p = (const bf16_t*)(kws() + WS_P); bf16_t* ap = (bf16_t*)(kws() + WS_APR);
    const float* mu = kin(I_MU) + (size_t)l * 2 * RWC;
    const int gtid = blockIdx.x * NTHR + otid(P.pad0), gsz = gridDim.x * NTHR;
    const int jg = gtid & 63, col = C_DW + jg * 4;
    const f32x4 m0 = *(const f32x4*)(mu + col), m1 = *(const f32x4*)(mu + RWC + col);
    for (int t0 = gtid >> 6; t0 < NTOK; t0 += (gsz >> 6) * 4) {
        u32x2 xc[4], xp[4], xn[4];
#pragma unroll
        for (int q = 0; q < 4; ++q) { const int tok = t0 + q * (gsz >> 6); const int tk = tok < NTOK ? tok : 0; const int s = tk & (SEQ - 1); const bf16_t* pr = p + (size_t)tk * INC + col; const u32x2 zz = {0u, 0u};
            xc[q] = *(const u32x2*)pr; xp[q] = s > 0 ? *(const u32x2*)(pr - INC) : zz; xn[q] = s < SEQ - 1 ? *(const u32x2*)(pr + INC) : zz; }
#pragma unroll
        for (int q = 0; q < 4; ++q) { const int tok = t0 + q * (gsz >> 6);
            f32x4 x, a, b;
            x[0] = bflo(xc[q].x); x[1] = bfhi(xc[q].x); x[2] = bflo(xc[q].y); x[3] = bfhi(xc[q].y);
            a[0] = bflo(xp[q].x); a[1] = bfhi(xp[q].x); a[2] = bflo(xp[q].y); a[3] = bfhi(xp[q].y);
            b[0] = bflo(xn[q].x); b[1] = bfhi(xn[q].x); b[2] = bflo(xn[q].y); b[3] = bfhi(xn[q].y);
            f32x4 v = x + m0 * (a - x) + m1 * (b - x);
            if (jg < 16) {
#pragma unroll
                for (int j = 0; j < 4; ++j) v[j] = 1.0f - 2.0f * __builtin_amdgcn_rcpf(1.0f + __expf(2.0f * v[j]));
            } else if (jg >= 32) {
#pragma unroll
                for (int j = 0; j < 4; ++j) v[j] = sigmoidf_(v[j]);
            }
            if (tok < NTOK) { typedef __bf16 bf4_ __attribute__((ext_vector_type(4)));
                *(bf4_*)(ap + (size_t)tok * 256 + jg * 4) = __builtin_convertvector(v, bf4_); } }
    }
}

__device__ __forceinline__ void phase_post(const Params& P, int l) {
    const bf16_t* p = (const bf16_t*)(kws() + WS_P); const bf16_t* lora = (const bf16_t*)(kws() + WS_LORA);
    const bf16_t* ydir = (const bf16_t*)(kws() + WS_YDIR); const float* bonus = (const float*)(kws() + WS_BONUS);
    bf16_t* ycat = (bf16_t*)(kws() + WS_YCAT);
    const int tid = otid(P.pad0), lane = tid & 63, wid = tid >> 6;
    const float* mu = kin(I_MU) + (size_t)l * 2 * RWC;
    const int gw = blockIdx.x * 8 + wid, ngw = gridDim.x * 8;
    { const int hg = gw & 3, c4 = hg * 256 + lane * 4, h = hg * 4 + (lane >> 4);
      const f32x4 gng = *(const f32x4*)(kin(I_GNG) + l * 1024 + c4), gnb = *(const f32x4*)(kin(I_GNB) + l * 1024 + c4);
      const f32x4 mu0 = *(const f32x4*)(mu + C_V + c4), mu1 = *(const f32x4*)(mu + RWC + C_V + c4);
      for (int t0 = gw >> 2; t0 < NTOK; t0 += (ngw >> 2) * 4) {
          f32x4 y[4]; u32x2 vc[4], vp[4], vn[4], gg[4]; float bon[4]; bool ok[4];
#pragma unroll
          for (int q = 0; q < 4; ++q) { const int tok = t0 + q * (ngw >> 2); ok[q] = tok < NTOK; const int tk = ok[q] ? tok : 0; const int s = tk & (SEQ - 1);
              { const u32x2 y0 = *(const u32x2*)(ydir + (size_t)tk * DM + c4), y1 = *(const u32x2*)(ydir + ((size_t)NTOK + tk) * DM + c4);
                y[q][0] = bflo(y0.x) + bflo(y1.x); y[q][1] = bfhi(y0.x) + bfhi(y1.x); y[q][2] = bflo(y0.y) + bflo(y1.y); y[q][3] = bfhi(y0.y) + bfhi(y1.y); }
              const bf16_t* pv = p + (size_t)tk * INC + C_V + c4; const u32x2 zz = {0u, 0u};
              vc[q] = *(const u32x2*)pv; vp[q] = s > 0 ? *(const u32x2*)(pv - INC) : zz; vn[q] = s < SEQ - 1 ? *(const u32x2*)(pv + INC) : zz;
              gg[q] = *(const u32x2*)(lora + (size_t)tk * LORA_N + 4096 + c4);
              bon[q] = bonus[(size_t)tk * 16 + h] + bonus[((size_t)NTOK + tk) * 16 + h]; }
#pragma unroll
          for (int q = 0; q < 4; ++q) { const int tok = t0 + q * (ngw >> 2);
              const float mean = sum16((y[q][0] + y[q][1]) + (y[q][2] + y[q][3])) * (1.0f / 64.0f); const f32x4 dy = y[q] - mean;
              const float var = sum16((dy[0] * dy[0] + dy[1] * dy[1]) + (dy[2] * dy[2] + dy[3] * dy[3])) * (1.0f / 64.0f);
              const f32x4 yn = dy * rsqrtf(var + 64e-5f) * gng + gnb;
              f32x4 v, vpv, vnx, g;
              v[0] = bflo(vc[q].x); v[1] = bfhi(vc[q].x); v[2] = bflo(vc[q].y); v[3] = bfhi(vc[q].y);
              vpv[0] = bflo(vp[q].x); vpv[1] = bfhi(vp[q].x); vpv[2] = bflo(vp[q].y); vpv[3] = bfhi(vp[q].y);
              vnx[0] = bflo(vn[q].x); vnx[1] = bfhi(vn[q].x); vnx[2] = bflo(vn[q].y); vnx[3] = bfhi(vn[q].y);
              g[0] = bflo(gg[q].x); g[1] = bfhi(gg[q].x); g[2] = bflo(gg[q].y); g[3] = bfhi(gg[q].y);
              const f32x4 vs = v + mu0 * (vpv - v) + mu1 * (vnx - v);
              const f32x4 o = (yn + vs * bon[q]) * g;
              if (ok[q]) { u32x2 w; w.x = cvt_pk_bf16(o[0], o[1]); w.y = cvt_pk_bf16(o[2], o[3]); *(u32x2*)(ycat + (size_t)tok * BRK + c4) = w; } }
      } }
}

__device__ __forceinline__ void phase_ln1(const Params& P, int l, float* ldsf) {
    const float* pre = (const float*)(kws() + WS_PRELN); float* xf = (float*)(kws() + WS_XF); bf16_t* xb = (bf16_t*)(kws() + WS_XB); float* aff = (float*)(kws() + WS_AFF);
    const float* g = kin(I_LN1G) + l * DM; const float* bt = kin(I_LN1B) + l * DM; const float* router = kin(I_ROUTER) + (size_t)l * DM * 16;
    const int tid = otid(P.pad0), lane = tid & 63, wid = tid >> 6;
    { f32x4 tmp[8];
#pragma unroll
      for (int k8 = 0; k8 < 8; ++k8) tmp[k8] = ((const f32x4*)router)[tid + k8 * NTHR];
#pragma unroll
      for (int k8 = 0; k8 < 8; ++k8) { const int i = tid + k8 * NTHR, d = i >> 2, e0 = (i & 3) * 4; ldsf[(e0 + 0) * DM + d] = tmp[k8][0]; ldsf[(e0 + 1) * DM + d] = tmp[k8][1]; ldsf[(e0 + 2) * DM + d] = tmp[k8][2]; ldsf[(e0 + 3) * DM + d] = tmp[k8][3]; } }
    __syncthreads();
    f32x4 gv[4], bv[4];
#pragma unroll
    for (int i = 0; i < 4; ++i) { gv[i] = *(const f32x4*)(g + lane * 4 + 256 * i); bv[i] = *(const f32x4*)(bt + lane * 4 + 256 * i); }
    const int row_first = blockIdx.x * 8 + wid, row_step = gridDim.x * 8;
    f32x4 vnx[4];
    if (row_first < NTOK) {
#pragma unroll
        for (int i = 0; i < 4; ++i) vnx[i] = *(const f32x4*)(pre + (size_t)row_first * DM + lane * 4 + 256 * i);
    }
    for (int row = row_first; row < NTOK; row += row_step) {
        f32x4 v[4]; float s = 0.f;
#pragma unroll
        for (int i = 0; i < 4; ++i) { v[i] = vnx[i]; s += (v[i][0] + v[i][1]) + (v[i][2] + v[i][3]); }
        if (row + row_step < NTOK) {
#pragma unroll
            for (int i = 0; i < 4; ++i) vnx[i] = *(const f32x4*)(pre + (size_t)(row + row_step) * DM + lane * 4 + 256 * i);
        }
        const float mean = wave_sum(s) * (1.0f / DM); float s2 = 0.f;
#pragma unroll
        for (int i = 0; i < 4; ++i) { v[i] = v[i] - mean; s2 += (v[i][0] * v[i][0] + v[i][1] * v[i][1]) + (v[i][2] * v[i][2] + v[i][3] * v[i][3]); }
        const float rstd = rsqrtf(wave_sum(s2) * (1.0f / DM) + 1e-5f);
        float lg[16];
#pragma unroll
        for (int e = 0; e < 16; ++e) lg[e] = 0.f;
#pragma unroll
        for (int i = 0; i < 4; ++i) { v[i] = v[i] * rstd * gv[i] + bv[i];
            *(f32x4*)(xf + (size_t)row * DM + lane * 4 + 256 * i) = v[i];
            u32x2 w; w.x = cvt_pk_bf16(v[i][0], v[i][1]); w.y = cvt_pk_bf16(v[i][2], v[i][3]); *(u32x2*)(xb + (size_t)row * DM + lane * 4 + 256 * i) = w;
#pragma unroll
            for (int e = 0; e < 16; ++e) { const f32x4 r = *(const f32x4*)(ldsf + e * DM + lane * 4 + 256 * i); lg[e] += (v[i][0] * r[0] + v[i][1] * r[1]) + (v[i][2] * r[2] + v[i][3] * r[3]); } }
        const int lid = lane_id();
#define LN_HALVE(M, H) do { const bool up_ = (lid & (M)) != 0; _Pragma("unroll") for (int j = 0; j < (H); ++j) { const float send_ = up_ ? lg[j] : lg[j + (H)], keep_ = up_ ? lg[j + (H)] : lg[j]; \
            lg[j] = keep_ + __builtin_bit_cast(float, __builtin_amdgcn_ds_bpermute((lid ^ (M)) << 2, __builtin_bit_cast(int, send_))); } } while (0)
        LN_HALVE(32, 8); LN_HALVE(16, 4); LN_HALVE(8, 2); LN_HALVE(4, 1);
#undef LN_HALVE
        float tot = lg[0];
        tot += __builtin_bit_cast(float, __builtin_amdgcn_ds_bpermute((lid ^ 2) << 2, __builtin_bit_cast(int, tot)));
        tot += __builtin_bit_cast(float, __builtin_amdgcn_ds_bpermute((lid ^ 1) << 2, __builtin_bit_cast(int, tot)));
        float mx = tot;
#pragma unroll
        for (int M = 4; M < 64; M <<= 1) mx = fmaxf(mx, __builtin_bit_cast(float, __builtin_amdgcn_ds_bpermute((lid ^ M) << 2, __builtin_bit_cast(int, mx))));
        const float ex = expf(tot - mx); float se = ex;
#pragma unroll
        for (int M = 4; M < 64; M <<= 1) se += __builtin_bit_cast(float, __builtin_amdgcn_ds_bpermute((lid ^ M) << 2, __builtin_bit_cast(int, se)));
        const int eidx = ((lid >> 5) & 1) * 8 + ((lid >> 4) & 1) * 4 + ((lid >> 3) & 1) * 2 + ((lid >> 2) & 1);
        if ((lid & 3) == 0) aff[(size_t)row * 16 + eidx] = ex / se;
    }
    __syncthreads();
}
__device__ __forceinline__ void phase_ln2(const Params& P, int l) {
    float* xf = (float*)(kws() + WS_XF); bf16_t* xb = (bf16_t*)(kws() + WS_XB); const bf16_t* ye = (const bf16_t*)(kws() + WS_YE); const int* slot_of = (const int*)(kws() + WS_SLOT);
    const float* g = kin(I_LN2G) + l * DM; const float* bt = kin(I_LN2B) + l * DM;
    float* dst = (l == DEPTH - 1) ? kout() : xf;
    const int tid = otid(P.pad0), lane = tid & 63, wid = __builtin_amdgcn_readfirstlane(tid >> 6);
    f32x4 gv[4], bv[4];
#pragma unroll
    for (int i = 0; i < 4; ++i) { gv[i] = *(const f32x4*)(g + lane * 4 + 256 * i); bv[i] = *(const f32x4*)(bt + lane * 4 + 256 * i); }
    const int gw = blockIdx.x * 8 + wid, ngw = gridDim.x * 8;
    for (int r0 = gw; r0 < NTOK; r0 += 4 * ngw) {
        const int rk = r0 + (lane >> 4) * ngw; const int slv = rk < NTOK ? slot_of[(size_t)rk * 16 + (lane & 15)] : -1;
        const unsigned long long m64 = __ballot(slv >= 0);
#pragma unroll
        for (int pr = 0; pr < 2; ++pr) {
            f32x4 v[2][4]; u32x2 tmp[2][4][4]; int nv[2]; bool ok[2];
#pragma unroll
            for (int q = 0; q < 2; ++q) { const int k = pr * 2 + q; const int row = r0 + k * ngw; ok[q] = row < NTOK; const int rw = ok[q] ? row : 0; const int b = rw >> 11;
#pragma unroll
                for (int i = 0; i < 4; ++i) v[q][i] = *(const f32x4*)(xf + (size_t)rw * DM + lane * 4 + 256 * i);
                unsigned bits = ok[q] ? (unsigned)((m64 >> (16 * k)) & 0xFFFFull) : 0u; nv[q] = 0;
#pragma unroll
                for (int j = 0; j < 4; ++j) { if (bits) { const int e = __builtin_ctz(bits); bits &= bits - 1; const int sl = __builtin_amdgcn_readlane(slv, 16 * k + e);
                        const bf16_t* yr = ye + ((size_t)(e * 8 + b) * 256 + sl) * DM + lane * 4;
#pragma unroll
                        for (int i = 0; i < 4; ++i) tmp[q][j][i] = *(const u32x2*)(yr + 256 * i);
                        nv[q] = j + 1; } }
#pragma unroll
                for (int i = 0; i < 4; ++i) v[q][i] = v[q][i] * DN_ALPHA;
#pragma unroll
                for (int j = 0; j < 4; ++j) if (j < nv[q]) {
#pragma unroll
                    for (int i = 0; i < 4; ++i) { const u32x2 w = tmp[q][j][i]; v[q][i][0] += bflo(w.x); v[q][i][1] += bfhi(w.x); v[q][i][2] += bflo(w.y); v[q][i][3] += bfhi(w.y); } }
                while (bits) { const int e = __builtin_ctz(bits); bits &= bits - 1; const int sl = __builtin_amdgcn_readlane(slv, 16 * k + e);
                    const bf16_t* yr = ye + ((size_t)(e * 8 + b) * 256 + sl) * DM + lane * 4;
#pragma unroll
                    for (int i = 0; i < 4; ++i) { const u32x2 w = *(const u32x2*)(yr + 256 * i); v[q][i][0] += bflo(w.x); v[q][i][1] += bfhi(w.x); v[q][i][2] += bflo(w.y); v[q][i][3] += bfhi(w.y); } }
            }
#pragma unroll
            for (int q = 0; q < 2; ++q) { const int row = r0 + (pr * 2 + q) * ngw;
                float s = 0.f;
#pragma unroll
                for (int i = 0; i < 4; ++i) s += (v[q][i][0] + v[q][i][1]) + (v[q][i][2] + v[q][i][3]);
                const float mean = wave_sum(s) * (1.0f / DM); float s2 = 0.f;
#pragma unroll
                for (int i = 0; i < 4; ++i) { v[q][i] = v[q][i] - mean; s2 += (v[q][i][0] * v[q][i][0] + v[q][i][1] * v[q][i][1]) + (v[q][i][2] * v[q][i][2] + v[q][i][3] * v[q][i][3]); }
                const float rstd = rsqrtf(wave_sum(s2) * (1.0f / DM) + 1e-5f);
                if (ok[q]) {
#pragma unroll
                    for (int i = 0; i < 4; ++i) { const f32x4 o = v[q][i] * rstd * gv[i] + bv[i];
                        *(f32x4*)(dst + (size_t)row * DM + lane * 4 + 256 * i) = o;
                        if (l < DEPTH - 1) { u32x2 w; w.x = cvt_pk_bf16(o[0], o[1]); w.y = cvt_pk_bf16(o[2], o[3]); *(u32x2*)(xb + (size_t)row * DM + lane * 4 + 256 * i) = w; } } }
            }
        }
    }
}

__device__ __forceinline__ void phase_topk(const Params& P, unsigned long long* keys  ) {
    const float* aff = (const float*)(kws() + WS_AFF); float* grow = (float*)(kws() + WS_GROW); int* slot_of = (int*)(kws() + WS_SLOT);
    const bf16_t* xb = (const bf16_t*)(kws() + WS_XB); unsigned char* xe = kws() + WS_XE;
    const int tid = otid(P.pad0);
    for (int u = blockIdx.x; u < NBATCH * NEXP; u += gridDim.x) {
        const int b = u >> 4, e = u & 15;
#pragma unroll
        for (int j = 0; j < 4; ++j) { const int i = tid + 512 * j; const float v = aff[((size_t)b * SEQ + i) * 16 + e];
            keys[i] = ((unsigned long long)__float_as_uint(v) << 32) | (unsigned long long)(0xFFFFFFFFu - (unsigned)i); }
        __syncthreads();
        { const int wv_ = tid >> 6, ln_ = tid & 63;
          for (int k = 2; k <= SEQ; k <<= 1)
            for (int j = k >> 1; j > 0; j >>= 1) {
                if (j >= 256) __syncthreads();
#pragma unroll
                for (int t2 = 0; t2 < 2; ++t2) { const int t = wv_ * 128 + ln_ + 64 * t2; const int i = ((t & ~(j - 1)) << 1) | (t & (j - 1)), ixj = i | j;
                    const unsigned long long a = keys[i], c = keys[ixj]; const bool desc = (i & k) == 0;
                    if (desc ? (a < c) : (a > c)) { keys[i] = c; keys[ixj] = a; } }
                if (j >= 256) __syncthreads();
                else asm volatile("s_waitcnt lgkmcnt(0)" ::: "memory");
            }
          __syncthreads(); }
#pragma unroll
        for (int j = 0; j < 4; ++j) { const int r = tid + 512 * j; const unsigned long long kk = keys[r]; const int tl = (int)(0xFFFFFFFFu - (unsigned)(kk & 0xFFFFFFFFull));
            slot_of[((size_t)b * SEQ + tl) * 16 + e] = r < CAP ? r : -1;
            if (r < CAP) grow[(e * 8 + b) * CAP + r] = __uint_as_float((unsigned)(kk >> 32)); }
        for (int q0 = tid; q0 < CAP * 64; q0 += NTHR * 16) { u32x4 tmp[16][2];
#pragma unroll
            for (int k8 = 0; k8 < 16; ++k8) { const int q = q0 + k8 * NTHR, r = q >> 6, ch = q & 63; const int tl = (int)(0xFFFFFFFFu - (unsigned)(keys[r] & 0xFFFFFFFFull));
                const bf16_t* sp = xb + ((size_t)b * SEQ + tl) * DM + ch * 16; tmp[k8][0] = *(const u32x4*)sp; tmp[k8][1] = *(const u32x4*)(sp + 8); }
#pragma unroll
            for (int k8 = 0; k8 < 16; ++k8) { const int q = q0 + k8 * NTHR, r = q >> 6, ch = q & 63; u32x4 o;
#define BLO(w_) __uint_as_float((w_) << 16)
#define BHI(w_) __uint_as_float((w_) & 0xFFFF0000u)
                o.x = pk_fp8x4(BLO(tmp[k8][0].x), BHI(tmp[k8][0].x), BLO(tmp[k8][0].y), BHI(tmp[k8][0].y)); o.y = pk_fp8x4(BLO(tmp[k8][0].z), BHI(tmp[k8][0].z), BLO(tmp[k8][0].w), BHI(tmp[k8][0].w));
                o.z = pk_fp8x4(BLO(tmp[k8][1].x), BHI(tmp[k8][1].x), BLO(tmp[k8][1].y), BHI(tmp[k8][1].y)); o.w = pk_fp8x4(BLO(tmp[k8][1].z), BHI(tmp[k8][1].z), BLO(tmp[k8][1].w), BHI(tmp[k8][1].w));
#undef BLO
#undef BHI
                *(u32x4*)(xe + ((size_t)(e * 8 + b) * CAP + r) * DM + ch * 16) = o; } }
        __syncthreads();
    }
}

typedef float f32x16 __attribute__((ext_vector_type(16)));
__device__ __forceinline__ float xmax32(float v) { float a = v, b = v; asm volatile("s_nop 1\n\tv_permlane32_swap_b32 %0, %1\n\ts_nop 1" : "+v"(a), "+v"(b)); return fmaxf(fmaxf(v, a), b); }
typedef short bf16x8s __attribute__((ext_vector_type(8)));
typedef short s16x4 __attribute__((ext_vector_type(4)));
typedef __bf16 bfv8 __attribute__((ext_vector_type(8)));
typedef float fv8 __attribute__((ext_vector_type(8)));
constexpr int FA_KB = 8192;
constexpr float LOG2E = 1.4426950408889634f;
constexpr int FA_TP = 96, FA_TS = 452;
constexpr int FA_OFF_Q = 3 * 8192 + 2 * 64 * (128 * 2 + 64) + 24 * FA_TS * 4;
constexpr float FA_THR = 8.0f;

template <int DV, int MODE>
__device__ __forceinline__ void fa_core(LAS unsigned char* lds, int tid, const bf16_t* qrow  , const bf16_t* kbase, const bf16_t* vbase, size_t ldk,
                                        int tile0, int ntiles, int qw, int qi, const LAS float* btab, f32x16 (&o)[DV / 32], float& m, float& lsum) {
    constexpr int RSV = DV * 2 + 64;
    constexpr int VB = 64 * RSV;
    constexpr int NDB = DV / 32;
    constexpr int NVC = DV / 64;
    constexpr int OFF_K = 0, OFF_V = 3 * FA_KB;
    const int lane = tid & 63, r = lane & 31, hh = lane >> 5, wid = __builtin_amdgcn_readfirstlane(tid >> 6);
    LAS unsigned char* qlds = lds + FA_OFF_Q + wid * 4096 + lane * 16;
#pragma unroll
    for (int s = 0; s < 4; ++s) *(LAS bf16x8s*)(qlds + s * 1024) = *(const bf16x8s*)(qrow + 16 * s + 8 * hh);
    constexpr float c1 = 0.125f * LOG2E;
    const int krow = tid >> 3, kch = tid & 7;
    const unsigned kst = (unsigned)(krow * 128 + ((kch ^ ((krow >> 1) & 7)) * 16));
    u32x4 kreg; u32x4 vreg[NVC];
#define FA_LOADK(t) do { kreg = *(const u32x4*)(kbase + ((size_t)(t) * 64 + krow) * ldk + kch * 8); } while (0)
#define FA_LOADV(t) do { _Pragma("unroll") for (int i_ = 0; i_ < NVC; ++i_) { const int c_ = tid + 512 * i_; const int vr_ = c_ / (DV / 8), vc_ = c_ % (DV / 8); vreg[i_] = *(const u32x4*)(vbase + ((size_t)(t) * 64 + vr_) * ldk + vc_ * 8); } } while (0)
#define FA_STOREK(buf) do { *(LAS u32x4*)(lds + OFF_K + (buf) * FA_KB + kst) = kreg; } while (0)
#define FA_STOREV(buf) do { _Pragma("unroll") for (int i_ = 0; i_ < NVC; ++i_) { const int c_ = tid + 512 * i_; const int vr_ = c_ / (DV / 8), vc_ = c_ % (DV / 8); *(LAS u32x4*)(lds + OFF_V + (buf) * VB + vr_ * RSV + vc_ * 16) = vreg[i_]; } } while (0)
    const unsigned kread = (unsigned)(r * 128);
    const int ksw = (r >> 1) & 7;
    const unsigned vread = (unsigned)((4 * hh + ((lane & 15) >> 2)) * RSV + (16 * ((lane >> 4) & 1) + 4 * (lane & 3)) * 2);
#define FA_NEED(t) ((MODE != 0) || (((t) * 64 + 63 >= qw - 128) && ((t) * 64 <= qw + 31 + 128)))
    { FA_LOADK(tile0); const u32x4 k0_ = kreg; FA_LOADV(tile0); if (ntiles > 1) FA_LOADK(tile0 + 1);
      *(LAS u32x4*)(lds + OFF_K + kst) = k0_; FA_STOREV(0); if (ntiles > 1) FA_STOREK(1); }
    __syncthreads();
    if (ntiles > 2) FA_LOADK(tile0 + 2);
    if (ntiles > 1) FA_LOADV(tile0 + 1);
    if (wid >= 4) __builtin_amdgcn_s_barrier();
    int kb3 = 0;
    for (int it = 0; it < ntiles; ++it) {
        const int t = tile0 + it, k0 = t * 64;
        const bool need = FA_NEED(t);
        bf16x8s pf[2][2];
        if (need) {
            f32x16 sc0, sc1;
            { const LAS unsigned char* Kb_ = lds + OFF_K + kb3 * FA_KB;
#pragma unroll
              for (int i_ = 0; i_ < 16; ++i_) { sc0[i_] = 0.f; sc1[i_] = 0.f; }
              bf16x8s ka0[4], ka1[4], kq[4];
#pragma unroll
              for (int s_ = 0; s_ < 4; ++s_) { const unsigned co_ = (unsigned)(((2 * s_ + hh) ^ ksw) * 16);
                  ka0[s_] = *(const LAS bf16x8s*)(Kb_ + kread + co_); ka1[s_] = *(const LAS bf16x8s*)(Kb_ + 32 * 128 + kread + co_); kq[s_] = *(const LAS bf16x8s*)(qlds + s_ * 1024); }
              __builtin_amdgcn_sched_barrier(0);
#pragma unroll
              for (int s_ = 0; s_ < 4; ++s_) { sc0 = __builtin_amdgcn_mfma_f32_32x32x16_bf16(ka0[s_], kq[s_], sc0, 0, 0, 0); sc1 = __builtin_amdgcn_mfma_f32_32x32x16_bf16(ka1[s_], kq[s_], sc1, 0, 0, 0); }
              __builtin_amdgcn_sched_barrier(0); }
            if (MODE == 2) {
#pragma unroll
                for (int i = 0; i < 16; ++i) { sc0[i] *= c1; sc1[i] *= c1; }
            } else {
                const int rmin = k0 - (qw + 31), rmax = k0 + 63 - qw;
                if (rmin >= 129 || rmax <= -129) { const float bc = rmin >= 129 ? btab[258] : btab[0];
#pragma unroll
                    for (int i = 0; i < 16; ++i) { sc0[i] = sc0[i] * c1 + bc; sc1[i] = sc1[i] * c1 + bc; }
                } else { int rb = k0 + 4 * hh - qi + 129; asm volatile("" : "+v"(rb));
#pragma unroll
                    for (int g = 0; g < 4; ++g) {
#pragma unroll
                        for (int e = 0; e < 4; ++e) { const int i = 4 * g + e;
                            sc0[i] = sc0[i] * c1 + btab[rb + e + 8 * g]; sc1[i] = sc1[i] * c1 + btab[rb + e + 8 * g + 32]; }
                    }
                }
            }
            float mx = sc0[0];
#pragma unroll
            for (int i = 1; i < 16; ++i) mx = fmaxf(mx, sc0[i]);
#pragma unroll
            for (int i = 0; i < 16; ++i) mx = fmaxf(mx, sc1[i]);
            mx = xmax32(mx);
            if (__any(mx > m + FA_THR)) {
                const float mn = fmaxf(m, mx), corr = __builtin_amdgcn_exp2f(m - mn); m = mn; lsum *= corr;
#pragma unroll
                for (int d = 0; d < NDB; ++d)
#pragma unroll
                    for (int i = 0; i < 16; ++i) o[d][i] *= corr;
            }
            float ps = 0.f;
#pragma unroll
            for (int i = 0; i < 16; ++i) { sc0[i] = __builtin_amdgcn_exp2f(sc0[i] - m); sc1[i] = __builtin_amdgcn_exp2f(sc1[i] - m); ps += sc0[i] + sc1[i]; }
            lsum += ps;
#pragma unroll
            for (int s2 = 0; s2 < 2; ++s2) { fv8 x0, x1;
#pragma unroll
                for (int j = 0; j < 8; ++j) { x0[j] = sc0[8 * s2 + j]; x1[j] = sc1[8 * s2 + j]; }
                pf[0][s2] = __builtin_bit_cast(bf16x8s, __builtin_convertvector(x0, bfv8)); pf[1][s2] = __builtin_bit_cast(bf16x8s, __builtin_convertvector(x1, bfv8)); }
        }
        __builtin_amdgcn_s_waitcnt(0xc07f);
        __builtin_amdgcn_s_barrier();
        if (need) {
            const LAS unsigned char* Vb = lds + OFF_V + (it & 1) * VB;
            s16x4 vt[2][NDB][2];
#define FA_VLOAD(slot, grp) do { _Pragma("unroll") for (int d_ = 0; d_ < NDB; ++d_) { const LAS unsigned char* vp_ = Vb + vread + (((grp) >> 1) * 32 + 16 * ((grp) & 1)) * RSV + d_ * 64; \
                vt[slot][d_][0] = __builtin_amdgcn_ds_read_tr16_b64_v4i16((LAS s16x4*)vp_); vt[slot][d_][1] = __builtin_amdgcn_ds_read_tr16_b64_v4i16((LAS s16x4*)(vp_ + 8 * RSV)); } } while (0)
            FA_VLOAD(0, 0);
            __builtin_amdgcn_sched_barrier(0);
#pragma unroll
            for (int grp = 0; grp < 4; ++grp) {
                if (grp + 1 < 4) FA_VLOAD((grp + 1) & 1, grp + 1);
                __builtin_amdgcn_sched_barrier(0);
#pragma unroll
                for (int d = 0; d < NDB; ++d) { const s16x4 t0 = vt[grp & 1][d][0], t1 = vt[grp & 1][d][1];
                    bf16x8s a; a[0] = t0[0]; a[1] = t0[1]; a[2] = t0[2]; a[3] = t0[3]; a[4] = t1[0]; a[5] = t1[1]; a[6] = t1[2]; a[7] = t1[3];
                    o[d] = __builtin_amdgcn_mfma_f32_32x32x16_bf16(a, pf[grp >> 1][grp & 1], o[d], 0, 0, 0); }
                __builtin_amdgcn_sched_barrier(0);
            }
#undef FA_VLOAD
        }
        { int kb2 = kb3 + 2; if (kb2 >= 3) kb2 -= 3;
          if (it + 2 < ntiles) FA_STOREK(kb2); }
        if (it + 1 < ntiles) FA_STOREV((it + 1) & 1);
        if (it + 3 < ntiles) FA_LOADK(t + 3);
        if (it + 2 < ntiles) FA_LOADV(t + 2);
        __syncthreads();
        kb3 = kb3 == 2 ? 0 : kb3 + 1;
    }
    if (wid < 4) __builtin_amdgcn_s_barrier();
#undef FA_LOADK
#undef FA_LOADV
#undef FA_STOREK
#undef FA_STOREV
#undef FA_NEED
}

constexpr int FA_OFF_T = 3 * FA_KB + 2 * 64 * (128 * 2 + 64);

template <int MODE>
__device__ __forceinline__ void fa_unit64(const Params& P, int l, int unit, LAS unsigned char* lds) {
    const bf16_t* p = (const bf16_t*)(kws() + WS_P);
    const int tid = otid(P.pad0), lane = tid & 63, wid = __builtin_amdgcn_readfirstlane(tid >> 6), r = lane & 31, hh = lane >> 5;
    int b, qblk, head = 0, hd = 0;
    const bf16_t *qbase, *kbase, *vbase; size_t ldk;
    if (MODE == 0) { qblk = unit & 7; head = (unit >> 3) & 15; b = unit >> 7; const int kvh = head >> 2;
        qbase = p + (size_t)(b * SEQ) * INC + C_WQ + head * 64; kbase = p + (size_t)(b * SEQ) * INC + C_WK + kvh * 64; vbase = p + (size_t)(b * SEQ) * INC + C_WV + kvh * 64; ldk = INC;
    } else { qblk = unit & 7; hd = (unit >> 3) & 3; b = unit >> 5; const bf16_t* kv = (const bf16_t*)(kws() + WS_KVMEM);
        qbase = p + (size_t)(b * SEQ) * INC + C_MQ + hd * 64; kbase = kv + (size_t)(b * NMEM) * 2048 + l * 512 + hd * 64; vbase = kbase + 256; ldk = 2048;
    }
    const int q0 = qblk * 256, qw = q0 + wid * 32, qi = qw + r;
    int tile0, ntiles;
    if (MODE == 0) { tile0 = q0 / 64 - 2; int tl = q0 / 64 + 5; if (tile0 < 0) tile0 = 0; if (tl > SEQ / 64 - 1) tl = SEQ / 64 - 1; ntiles = tl - tile0 + 1; }
    else { tile0 = 0; ntiles = NMEM / 64; }
    const LAS float* btab = (const LAS float*)(lds + FA_OFF_T) + head * FA_TS + FA_TP;
    f32x16 o[2];
#pragma unroll
    for (int d = 0; d < 2; ++d)
#pragma unroll
        for (int i = 0; i < 16; ++i) o[d][i] = 0.f;
    float m = -INFINITY, lsum = 0.f;
    if (MODE == 0) { m = kin(I_SINK)[l * 16 + head] * LOG2E; lsum = hh == 0 ? 1.0f : 0.0f; }
    fa_core<64, MODE>(lds, tid, qbase + (size_t)qi * INC, kbase, vbase, ldk, tile0, ntiles, qw, qi, btab, o, m, lsum);
    const float lt = lsum + shfl_xor_o(lsum, 32); const float inv = 1.0f / lt;
    const size_t tok = (size_t)b * SEQ + qi;
    bf16_t* yp = (bf16_t*)(kws() + WS_YCAT) + tok * BRK + (MODE == 0 ? 1024 + head * 64 : 3072 + hd * 64) + 4 * hh;
#pragma unroll
    for (int d = 0; d < 2; ++d)
#pragma unroll
        for (int g = 0; g < 4; ++g) { u32x2 w; w.x = cvt_pk_bf16(o[d][4 * g] * inv, o[d][4 * g + 1] * inv); w.y = cvt_pk_bf16(o[d][4 * g + 2] * inv, o[d][4 * g + 3] * inv); *(u32x2*)(yp + 32 * d + 8 * g) = w; }
}

__device__ __forceinline__ void fa_unit_win(const Params& P, int l, int unit, LAS unsigned char* lds) {
    const bf16_t* p = (const bf16_t*)(kws() + WS_P);
    const int tid = otid(P.pad0), lane = tid & 63, wid = __builtin_amdgcn_readfirstlane(tid >> 6), r = lane & 31, hh = lane >> 5;
    const int qb = unit & 31, kvh = (unit >> 5) & 3, b = unit >> 7;
    const int head = kvh * 4 + (wid >> 1);
    const int q0 = qb * 64, qw = q0 + (wid & 1) * 32, qi = qw + r;
    const bf16_t* qbase = p + (size_t)(b * SEQ) * INC + C_WQ + head * 64; const bf16_t* kbase = p + (size_t)(b * SEQ) * INC + C_WK + kvh * 64; const bf16_t* vbase = p + (size_t)(b * SEQ) * INC + C_WV + kvh * 64;
    int tile0 = q0 / 64 - 2, tl = q0 / 64 + 2; if (tile0 < 0) tile0 = 0; if (tl > SEQ / 64 - 1) tl = SEQ / 64 - 1; const int ntiles = tl - tile0 + 1;
    const LAS float* btab = (const LAS float*)(lds + FA_OFF_T) + head * FA_TS + FA_TP;
    f32x16 o[2];
#pragma unroll
    for (int d = 0; d < 2; ++d)
#pragma unroll
        for (int i = 0; i < 16; ++i) o[d][i] = 0.f;
    float m = kin(I_SINK)[l * 16 + head] * LOG2E, lsum = hh == 0 ? 1.0f : 0.0f;
    fa_core<64, 0>(lds, tid, qbase + (size_t)qi * INC, kbase, vbase, (size_t)INC, tile0, ntiles, qw, qi, btab, o, m, lsum);
    const float lt = lsum + shfl_xor_o(lsum, 32); const float inv = 1.0f / lt;
    const size_t tok = (size_t)b * SEQ + qi;
    bf16_t* yp = (bf16_t*)(kws() + WS_YCAT) + tok * BRK + 1024 + head * 64 + 4 * hh;
#pragma unroll
    for (int d = 0; d < 2; ++d)
#pragma unroll
        for (int g = 0; g < 4; ++g) { u32x2 w; w.x = cvt_pk_bf16(o[d][4 * g] * inv, o[d][4 * g + 1] * inv); w.y = cvt_pk_bf16(o[d][4 * g + 2] * inv, o[d][4 * g + 3] * inv); *(u32x2*)(yp + 32 * d + 8 * g) = w; }
}

__device__ __forceinline__ void fa_unit_diff(const Params& P, int l, int unit, LAS unsigned char* lds, float lam_full, float one_m_li) {
    const bf16_t* p = (const bf16_t*)(kws() + WS_P);
    const int tid = otid(P.pad0), lane = tid & 63, wid = __builtin_amdgcn_readfirstlane(tid >> 6), r = lane & 31, hh = lane >> 5;
    const int qblk = unit & 7, h = (unit >> 3) & 7, b = unit >> 6;
    const int q0 = qblk * 256, qw = q0 + wid * 32, qi = qw + r;
    const LAS float* btab = (const LAS float*)(lds + FA_OFF_T) + (16 + h) * FA_TS + FA_TP;
    const size_t tok = (size_t)b * SEQ + qi;
    const bf16_t* vbase = p + (size_t)(b * SEQ) * INC + C_DV + h * 128;
    float* dp = (float*)(kws() + WS_DTMP) + tok * 1024 + h * 128 + 4 * hh;
    for (int cc = 0; cc < 2; ++cc) {
        const bf16_t* qrow = p + tok * INC + C_DQ + h * 128 + cc * 64;
        const bf16_t* kbase = p + (size_t)(b * SEQ) * INC + C_DK + h * 128 + cc * 64;
        f32x16 o[4];
#pragma unroll
        for (int d = 0; d < 4; ++d)
#pragma unroll
            for (int i = 0; i < 16; ++i) o[d][i] = 0.f;
        float m = -INFINITY, lsum = 0.f;
        fa_core<128, 1>(lds, tid, qrow, kbase, vbase, (size_t)INC, 0, SEQ / 64, qw, qi, btab, o, m, lsum);
        const float lt = lsum + shfl_xor_o(lsum, 32); const float inv = 1.0f / lt;
        if (cc == 0) {
#pragma unroll
            for (int d = 0; d < 4; ++d)
#pragma unroll
                for (int g = 0; g < 4; ++g) { f32x4 v; v[0] = o[d][4 * g] * inv; v[1] = o[d][4 * g + 1] * inv; v[2] = o[d][4 * g + 2] * inv; v[3] = o[d][4 * g + 3] * inv; *(f32x4*)(dp + 32 * d + 8 * g) = v; }
        } else {
            float ssq = 0.f;
#pragma unroll
            for (int d = 0; d < 4; ++d)
#pragma unroll
                for (int g = 0; g < 4; ++g) { const f32x4 a = *(const f32x4*)(dp + 32 * d + 8 * g);
#pragma unroll
                    for (int e = 0; e < 4; ++e) { const float x = a[e] - lam_full * (o[d][4 * g + e] * inv); o[d][4 * g + e] = x; ssq += x * x; } }
            ssq += shfl_xor_o(ssq, 32);
            const float rs = rsqrtf(ssq * (1.0f / 128.0f) + 1e-5f) * one_m_li;
            bf16_t* yp = (bf16_t*)(kws() + WS_YCAT) + tok * BRK + 2048 + h * 128 + 4 * hh;
            const float* sg = kin(I_SUBLN) + l * 128 + 4 * hh;
#pragma unroll
            for (int d = 0; d < 4; ++d)
#pragma unroll
                for (int g = 0; g < 4; ++g) { const f32x4 gv = *(const f32x4*)(sg + 32 * d + 8 * g);
                    u32x2 w; w.x = cvt_pk_bf16(o[d][4 * g] * rs * gv[0], o[d][4 * g + 1] * rs * gv[1]); w.y = cvt_pk_bf16(o[d][4 * g + 2] * rs * gv[2], o[d][4 * g + 3] * rs * gv[3]);
                    *(u32x2*)(yp + 32 * d + 8 * g) = w; }
        }
    }
}
__device__ __forceinline__ void phase_attn_mfma(const Params& P, int l, LAS unsigned char* lds) {
    const int tid0 = otid(P.pad0), lane = tid0 & 63;
    { float* bt = (float*)(lds + FA_OFF_T); const float* relb = kin(I_RELB); constexpr int NE = 259 + 2 * FA_TP;
      for (int i = tid0; i < 24 * NE; i += NTHR) { const int hq = i / NE, j = i - hq * NE, rel = j - FA_TP - 129; const int rc = rel < -128 ? -128 : (rel > 128 ? 128 : rel);
          const float v = relb[t5_bucket(rc) * 24 + hq] * LOG2E; bt[hq * FA_TS + j] = (hq < 16 && (rel < -128 || rel > 128)) ? -INFINITY : v; } }
    __syncthreads();
    const float* lam = kin(I_LAM) + l * 256;
    const float l1 = wave_sum(lam[lane] * lam[64 + lane]), l2 = wave_sum(lam[128 + lane] * lam[192 + lane]);
    const float lambda_init = 0.8f - 0.6f * expf(-0.3f * (float)l);
    const float lam_full = expf(l1) - expf(l2) + lambda_init;
    const int G = gridDim.x, c = blockIdx.x;
    if ((G & 7) == 0 && G >= 8) {
        const int x = c & 7, j = c >> 3, W = G >> 3;
        for (int lu = j; lu < 64; lu += W) { const int pair = x * 8 + (lu >> 3); fa_unit_diff(P, l, (pair << 3) | (lu & 7), lds, lam_full, 1.0f - lambda_init); }
        for (int lu = j, it = 0; lu < 128; lu += W, ++it) { const bool same = W == 32; const int grp = x * 4 + (same ? (j >> 3) : (lu >> 5)), g = same ? it : ((lu >> 3) & 3), qb = same ? (j & 7) : (lu & 7); const int b = grp >> 2, kvh = grp & 3;
            fa_unit64<0>(P, l, (b << 7) | ((kvh * 4 + g) << 3) | qb, lds); }
        for (int lu = j; lu < 32; lu += W) { const int grp = x * 4 + (lu >> 3); fa_unit64<2>(P, l, (grp << 3) | (lu & 7), lds); }
    } else {
        for (int u = c; u < 512; u += G) fa_unit_diff(P, l, u, lds, lam_full, 1.0f - lambda_init);
        for (int u = c; u < 1024; u += G) fa_unit_win(P, l, u, lds);
        for (int u = c; u < 256; u += G) fa_unit64<2>(P, l, u, lds);
    }
}

#ifndef STAMP_SCAN
#define STAMP_SCAN 0
#endif
constexpr int CRP = 144, CIMG = 64 * CRP;
enum { SL_KQ = 0, SL_RQ, SL_AK, SL_DK, SL_VV, SL_B, SL_M2, SL_N1, SL_N2, SL_A, SL_C, SL_D, SL_X1, SL_S0, SL_S1, SL_COUNT };
constexpr int CS_GC = SL_COUNT * CIMG;
constexpr int CS_CONST = CS_GC + 256;
constexpr int CS_LD = SL_A * CIMG;
constexpr int CS_SEG = CS_LD + 64 * 64 * 4;

__device__ __forceinline__ int cs_off_row(int tile, int lane) { return (32 * tile + (lane & 31)) * CRP + 16 * (lane >> 5); }
__device__ __forceinline__ int cs_off_tr(int tile, int lane) { return (8 * (lane >> 5) + ((lane & 15) >> 2)) * CRP + (32 * tile + 16 * ((lane >> 4) & 1) + 4 * (lane & 3)) * 2; }
__device__ __forceinline__ int cs_off_cm(int ti, int tj, int lane) { return (32 * tj + (lane & 31)) * CRP + (32 * ti + 4 * (lane >> 5)) * 2; }
__device__ __forceinline__ bf16x8s cs_rowfrag(const LAS unsigned char* img, int off, int s) { return *(const LAS bf16x8s*)(img + off + 32 * s); }
__device__ __forceinline__ bf16x8s cs_trfrag(const LAS unsigned char* img, int off, int s) {
    const LAS unsigned char* a = img + off + 16 * s * CRP;
    const s16x4 t0 = __builtin_amdgcn_ds_read_tr16_b64_v4i16((LAS s16x4*)a), t1 = __builtin_amdgcn_ds_read_tr16_b64_v4i16((LAS s16x4*)(a + 4 * CRP));
    bf16x8s f; f[0] = t0[0]; f[1] = t0[1]; f[2] = t0[2]; f[3] = t0[3]; f[4] = t1[0]; f[5] = t1[1]; f[6] = t1[2]; f[7] = t1[3];
    return f;
}
template <bool ATR, bool BTR>
__device__ __forceinline__ f32x16 cs_mm(f32x16 acc, const LAS unsigned char* Ai, int aoff, const LAS unsigned char* Bi, int boff) {
    bf16x8s a[4], b[4];
#pragma unroll
    for (int s = 0; s < 4; ++s) { a[s] = ATR ? cs_trfrag(Ai, aoff, s) : cs_rowfrag(Ai, aoff, s); b[s] = BTR ? cs_trfrag(Bi, boff, s) : cs_rowfrag(Bi, boff, s); }
    __builtin_amdgcn_sched_barrier(0);
#pragma unroll
    for (int s = 0; s < 4; ++s) acc = __builtin_amdgcn_mfma_f32_32x32x16_bf16(a[s], b[s], acc, 0, 0, 0);
    return acc;
}
__device__ __forceinline__ void cs_store_cm(LAS unsigned char* img, int off, const f32x16& acc) {
#pragma unroll
    for (int g = 0; g < 4; ++g) { fv8 x; x[0] = acc[4 * g]; x[1] = acc[4 * g + 1]; x[2] = acc[4 * g + 2]; x[3] = acc[4 * g + 3]; x[4] = 0.f; x[5] = 0.f; x[6] = 0.f; x[7] = 0.f;
        const bf16x8s y = __builtin_bit_cast(bf16x8s, __builtin_convertvector(x, bfv8)); s16x4 w; w[0] = y[0]; w[1] = y[1]; w[2] = y[2]; w[3] = y[3];
        *(LAS s16x4*)(img + off + 16 * g) = w; }
}
__device__ __forceinline__ f32x16 cs_load_cm(const LAS unsigned char* img, int off) {
    f32x16 v;
#pragma unroll
    for (int g = 0; g < 4; ++g) { const u32x2 w = *(const LAS u32x2*)(img + off + 16 * g);
        v[4 * g] = bflo(w.x); v[4 * g + 1] = bfhi(w.x); v[4 * g + 2] = bflo(w.y); v[4 * g + 3] = bfhi(w.y); }
    return v;
}
__device__ __forceinline__ f32x16 cs_zero() { f32x16 z;
#pragma unroll
    for (int i = 0; i < 16; ++i) z[i] = 0.f;
    return z; }

__device__ __forceinline__ void phase_scan_chunked(const Params& P, int l, LAS unsigned char* lds) {
    const bf16_t* p = (const bf16_t*)(kws() + WS_P); const bf16_t* lora = (const bf16_t*)(kws() + WS_LORA);
    bf16_t* ydir = (bf16_t*)(kws() + WS_YDIR); float* bonus = (float*)(kws() + WS_BONUS);
    const int tid = otid(P.pad0), lane = tid & 63, wid = __builtin_amdgcn_readfirstlane(tid >> 6), r = lane & 31, hh = lane >> 5;
    const int pt = tid >> 3, pc8 = tid & 7;
    const int w4 = wid & 3, ti = w4 >> 1, tj = w4 & 1;
    const bool grpA = wid < 4;
#define IMG(s) (lds + (s) * CIMG)
    LAS float* LD = (LAS float*)(lds + CS_LD); LAS float* SEG = (LAS float*)(lds + CS_SEG); LAS float* GC = (LAS float*)(lds + CS_GC); LAS float* CN = (LAS float*)(lds + CS_CONST);
    for (int u = blockIdx.x; u < 256; u += gridDim.x) {
        const int z = u & 1, h = (u >> 1) & 15, b = u >> 5;
        const int c8 = h * 64 + pc8 * 8;
        const float* mu = kin(I_MU) + (size_t)l * 2 * RWC;
        __syncthreads();
        for (int i = tid; i < 9 * 64; i += NTHR) { const int vq = i >> 6, ch = i & 63, cch = h * 64 + ch; float v;
            if (vq < 3) v = mu[vq * 1024 + cch]; else if (vq < 6) v = mu[RWC + (vq - 3) * 1024 + cch]; else if (vq == 6) v = kin(I_KK)[l * 1024 + cch]; else if (vq == 7) v = kin(I_KA)[l * 1024 + cch]; else v = kin(I_RK)[l * 1024 + cch];
            CN[i] = v; }
        { LAS unsigned char* s0 = IMG(SL_S0); for (int i = tid; i < CIMG / 16; i += NTHR) *(LAS u32x4*)(s0 + i * 16) = (u32x4){0u, 0u, 0u, 0u}; }
        u32x4 rw[3][3], lw[2];
#define CS_LOAD(n) do { const int i_ = (n) * 64 + pt; const int t_ = z ? (SEQ - 1) - i_ : i_; const bf16_t* pr_ = p + (size_t)(b * SEQ + t_) * INC + c8; \
        const bool okp_ = t_ > 0, okn_ = t_ < SEQ - 1; const u32x4 zz_ = {0u, 0u, 0u, 0u}; \
        _Pragma("unroll") for (int x_ = 0; x_ < 3; ++x_) { rw[x_][0] = *(const u32x4*)(pr_ + x_ * 1024); rw[x_][1] = okp_ ? *(const u32x4*)(pr_ - INC + x_ * 1024) : zz_; rw[x_][2] = okn_ ? *(const u32x4*)(pr_ + INC + x_ * 1024) : zz_; } \
        const bf16_t* lr_ = lora + (size_t)(b * SEQ + t_) * LORA_N + z * 1024 + c8; lw[0] = *(const u32x4*)lr_; lw[1] = *(const u32x4*)(lr_ + 2048); } while (0)
        CS_LOAD(0);
        f32x16 accR = cs_zero();
        for (int n = 0; n < SEQ / 64; ++n) {
#if STAMP_SCAN
            const unsigned ts0 = (unsigned)__builtin_readcyclecounter();
#endif
            const int sOld = (n & 1) ? SL_S1 : SL_S0, sNew = (n & 1) ? SL_S0 : SL_S1;
            int rowI = cs_off_row(ti, lane), rowJ = cs_off_row(tj, lane), trI = cs_off_tr(ti, lane), trJ = cs_off_tr(tj, lane), cmO = cs_off_cm(ti, tj, lane);
            asm volatile("" : "+v"(rowI), "+v"(rowJ), "+v"(trI), "+v"(trJ), "+v"(cmO));
            { float ldv[8];
#pragma unroll
              for (int q = 0; q < 2; ++q) { const unsigned l0 = q ? lw[0].z : lw[0].x, l1 = q ? lw[0].w : lw[0].y; ldv[4 * q] = bflo(l0); ldv[4 * q + 1] = bfhi(l0); ldv[4 * q + 2] = bflo(l1); ldv[4 * q + 3] = bfhi(l1); }
              LAS float* ldp = LD + pt * 64 + pc8 * 8;
              *(LAS f32x4*)ldp = (f32x4){ldv[0], ldv[1], ldv[2], ldv[3]}; *(LAS f32x4*)(ldp + 4) = (f32x4){ldv[4], ldv[5], ldv[6], ldv[7]}; }
            __syncthreads();
            { const int k = tid & 63, seg = tid >> 6; float c[8]; float run = 0.f;
#pragma unroll
              for (int j = 0; j < 8; ++j) { run += LD[(seg * 8 + j) * 64 + k]; c[j] = run; }
              SEG[seg * 64 + k] = run;
              __syncthreads();
              float pre = 0.f;
#pragma unroll
              for (int s = 0; s < 7; ++s) pre += (s < seg) ? SEG[s * 64 + k] : 0.f;
#pragma unroll
              for (int j = 0; j < 8; ++j) LD[(seg * 8 + j) * 64 + k] = pre + c[j];
            }
            __syncthreads();
            { const int i = n * 64 + pt, tok = b * SEQ + (z ? (SEQ - 1) - i : i);
              float xs[3][8];
#pragma unroll
              for (int x = 0; x < 3; ++x)
#pragma unroll
                  for (int q = 0; q < 2; ++q) {
                      const unsigned c0 = q ? rw[x][0].z : rw[x][0].x, c1 = q ? rw[x][0].w : rw[x][0].y, p0 = q ? rw[x][1].z : rw[x][1].x, p1 = q ? rw[x][1].w : rw[x][1].y, n0 = q ? rw[x][2].z : rw[x][2].x, n1 = q ? rw[x][2].w : rw[x][2].y;
                      f32x4 c, pv, nx; c[0] = bflo(c0); c[1] = bfhi(c0); c[2] = bflo(c1); c[3] = bfhi(c1); pv[0] = bflo(p0); pv[1] = bfhi(p0); pv[2] = bflo(p1); pv[3] = bfhi(p1); nx[0] = bflo(n0); nx[1] = bfhi(n0); nx[2] = bflo(n1); nx[3] = bfhi(n1);
                      const f32x4 m0 = *(const LAS f32x4*)(CN + x * 64 + pc8 * 8 + 4 * q), m1 = *(const LAS f32x4*)(CN + (3 + x) * 64 + pc8 * 8 + 4 * q);
                      const f32x4 o = c + m0 * (pv - c) + m1 * (nx - c);
                      xs[x][4 * q] = o[0]; xs[x][4 * q + 1] = o[1]; xs[x][4 * q + 2] = o[2]; xs[x][4 * q + 3] = o[3]; }
              float av[8], ckk[8], cka[8], crk[8];
#pragma unroll
              for (int q = 0; q < 2; ++q) { const unsigned a0 = q ? lw[1].z : lw[1].x, a1 = q ? lw[1].w : lw[1].y;
                  av[4 * q] = bflo(a0); av[4 * q + 1] = bfhi(a0); av[4 * q + 2] = bflo(a1); av[4 * q + 3] = bfhi(a1);
                  const f32x4 t6 = *(const LAS f32x4*)(CN + 6 * 64 + pc8 * 8 + 4 * q), t7 = *(const LAS f32x4*)(CN + 7 * 64 + pc8 * 8 + 4 * q), t8 = *(const LAS f32x4*)(CN + 8 * 64 + pc8 * 8 + 4 * q);
#pragma unroll
                  for (int e = 0; e < 4; ++e) { ckk[4 * q + e] = t6[e]; cka[4 * q + e] = t7[e]; crk[4 * q + e] = t8[e]; } }
              float kk[8], kd[8]; float ss = 0.f, bq = 0.f;
#pragma unroll
              for (int j = 0; j < 8; ++j) { const float kx = xs[1][j]; const float kraw = kx * ckk[j]; kk[j] = kraw; ss += kraw * kraw;
                  kd[j] = kx * (1.0f + (av[j] - 1.0f) * cka[j]); bq += xs[0][j] * kd[j] * crk[j]; }
              ss = sum8(ss); bq = sum8(bq);
              const float rn = rsqrtf(fmaxf(ss, 1e-12f));
              if (pc8 == 0) bonus[((size_t)z * NTOK + tok) * 16 + h] = bq;
              const LAS float* cu = LD + pt * 64 + pc8 * 8;
              float cum[8], cup[8];
#pragma unroll
              for (int q = 0; q < 2; ++q) { const f32x4 a = *(const LAS f32x4*)(cu + 4 * q); cum[4 * q] = a[0]; cum[4 * q + 1] = a[1]; cum[4 * q + 2] = a[2]; cum[4 * q + 3] = a[3];
                  f32x4 bpv = {0.f, 0.f, 0.f, 0.f}; if (pt > 0) bpv = *(const LAS f32x4*)(cu - 64 + 4 * q); cup[4 * q] = bpv[0]; cup[4 * q + 1] = bpv[1]; cup[4 * q + 2] = bpv[2]; cup[4 * q + 3] = bpv[3]; }
              fv8 okq, orq, oak, odk, ovv;
#pragma unroll
              for (int j = 0; j < 8; ++j) { const float gt = __expf(cum[j]), gp = __expf(cup[j]), gi = __builtin_amdgcn_rcpf(gt); const float kkn = kk[j] * rn;
                  okq[j] = kkn * gp; orq[j] = xs[0][j] * gt; oak[j] = av[j] * kkn * gi; odk[j] = kd[j] * gi; ovv[j] = xs[2][j];
                  if (pt == 63) GC[pc8 * 8 + j] = gt; }
              const int off = pt * CRP + pc8 * 16;
              *(LAS bfv8*)(IMG(SL_KQ) + off) = __builtin_convertvector(okq, bfv8); *(LAS bfv8*)(IMG(SL_RQ) + off) = __builtin_convertvector(orq, bfv8);
              *(LAS bfv8*)(IMG(SL_AK) + off) = __builtin_convertvector(oak, bfv8); *(LAS bfv8*)(IMG(SL_DK) + off) = __builtin_convertvector(odk, bfv8);
              *(LAS bfv8*)(IMG(SL_VV) + off) = __builtin_convertvector(ovv, bfv8);
            }
            __syncthreads();
            if (n + 1 < SEQ / 64) CS_LOAD(n + 1);
#if STAMP_SCAN
            const unsigned ts1 = (unsigned)__builtin_readcyclecounter();
#endif
            { const int pr = wid >> 1; const LAS unsigned char* Ai = IMG(pr < 2 ? SL_KQ : SL_RQ); const LAS unsigned char* Bi = IMG((pr & 1) ? SL_DK : SL_AK);
              LAS unsigned char* Oi = IMG(pr == 0 ? SL_B : (pr == 1 ? SL_M2 : (pr == 2 ? SL_N1 : SL_N2)));
#pragma unroll
              for (int q = 0; q < 2; ++q) { const int ti1 = wid & 1, tj1 = q;
                  f32x16 acc = cs_mm<false, false>(cs_zero(), Ai, cs_off_row(ti1, lane), Bi, cs_off_row(tj1, lane));
                  f32x16 t1;
#pragma unroll
                  for (int i = 0; i < 16; ++i) { const int m = 32 * ti1 + (i & 3) + 8 * (i >> 2) + 4 * hh, nn = 32 * tj1 + r; const bool keep = pr < 2 ? (nn < m) : (nn <= m);
                      acc[i] = keep ? acc[i] : 0.f; t1[i] = (m == nn ? 1.0f : 0.0f) - acc[i]; }
                  cs_store_cm(Oi, cs_off_cm(ti1, tj1, lane), acc);
                  if (pr == 0) cs_store_cm(IMG(SL_C), cs_off_cm(ti1, tj1, lane), t1); } }
            __syncthreads();
            if (grpA) { const f32x16 acc = cs_mm<true, false>(cs_zero(), IMG(SL_B), trI, IMG(SL_B), rowJ); cs_store_cm(IMG(SL_A), cmO, acc); }
            else { const f32x16 acc = cs_mm<true, true>(cs_zero(), IMG(SL_M2), trI, IMG(SL_VV), trJ); cs_store_cm(IMG(SL_X1), cmO, acc); }
            __syncthreads();
#pragma unroll
            for (int st = 0; st < 5; ++st) {
                const int qs = (st & 1) ? SL_B : SL_A, qd = (st & 1) ? SL_A : SL_B, ts = (st & 1) ? SL_D : SL_C, td = (st & 1) ? SL_C : SL_D;
                if (grpA) { if (st < 4) { const f32x16 acc = cs_mm<true, false>(cs_zero(), IMG(qs), trI, IMG(qs), rowJ); cs_store_cm(IMG(qd), cmO, acc); } }
                else { const f32x16 acc = cs_mm<true, false>(cs_load_cm(IMG(ts), cmO), IMG(ts), trI, IMG(qs), rowJ); cs_store_cm(IMG(td), cmO, acc); }
                __syncthreads();
            }
            if (grpA) { const f32x16 acc = cs_mm<true, true>(cs_zero(), IMG(SL_D), trI, IMG(SL_KQ), trJ); cs_store_cm(IMG(SL_A), cmO, acc); }
            else { const f32x16 acc = cs_mm<true, false>(cs_zero(), IMG(SL_D), trI, IMG(SL_X1), rowJ); cs_store_cm(IMG(SL_B), cmO, acc); }
            __syncthreads();
            if (grpA) { f32x16 acc = cs_mm<false, true>(cs_zero(), IMG(SL_A), rowI, IMG(SL_N1), trJ);
                const f32x16 rq = cs_load_cm(IMG(SL_RQ), cmO);
                acc = rq - acc;
                cs_store_cm(IMG(SL_M2), cmO, acc); }
            else { const f32x16 a1 = cs_mm<true, true>(cs_zero(), IMG(SL_VV), trI, IMG(SL_N2), trJ); const f32x16 a2 = cs_mm<false, true>(cs_zero(), IMG(SL_B), rowI, IMG(SL_N1), trJ); accR = a1 - a2; }
            if (!grpA) { f32x16 acc = cs_mm<false, true>(cs_zero(), IMG(SL_A), rowI, IMG(SL_AK), trJ); const float gc = GC[32 * tj + r];
#pragma unroll
                for (int i = 0; i < 16; ++i) { const int m = 32 * ti + (i & 3) + 8 * (i >> 2) + 4 * hh, nn = 32 * tj + r; acc[i] = ((m == nn ? 1.0f : 0.0f) - acc[i]) * gc; }
                cs_store_cm(IMG(SL_C), cmO, acc); }
            else { const f32x16 a1 = cs_mm<true, true>(cs_zero(), IMG(SL_DK), trI, IMG(SL_VV), trJ); const f32x16 a2 = cs_mm<true, false>(cs_zero(), IMG(SL_AK), trI, IMG(SL_B), rowJ);
#pragma unroll
                for (int g = 0; g < 4; ++g) { const f32x4 gcv = *(const LAS f32x4*)(GC + 32 * ti + 8 * g + 4 * hh);
#pragma unroll
                    for (int e = 0; e < 4; ++e) accR[4 * g + e] = (a1[4 * g + e] - a2[4 * g + e]) * gcv[e]; } }
            __syncthreads();
            if (grpA) { accR = cs_mm<false, false>(accR, IMG(SL_C), rowI, IMG(sOld), rowJ); cs_store_cm(IMG(sNew), cmO, accR); }
            else { accR = cs_mm<false, false>(accR, IMG(sOld), rowI, IMG(SL_M2), rowJ);
                const int t = 32 * tj + r, ii = n * 64 + t; const int tk = z ? (SEQ - 1) - ii : ii;
                bf16_t* yp = ydir + ((size_t)z * NTOK + b * SEQ + tk) * DM + h * 64 + 32 * ti + 4 * hh;
#pragma unroll
                for (int g = 0; g < 4; ++g) { fv8 x; x[0] = accR[4 * g]; x[1] = accR[4 * g + 1]; x[2] = accR[4 * g + 2]; x[3] = accR[4 * g + 3]; x[4] = 0.f; x[5] = 0.f; x[6] = 0.f; x[7] = 0.f;
                    const bf16x8s y8 = __builtin_bit_cast(bf16x8s, __builtin_convertvector(x, bfv8)); s16x4 w; w[0] = y8[0]; w[1] = y8[1]; w[2] = y8[2]; w[3] = y8[3];
                    *(s16x4*)(yp + 8 * g) = w; } }
            __syncthreads();
#if STAMP_SCAN
            { const unsigned ts2 = (unsigned)__builtin_readcyclecounter(); if (blockIdx.x == 0 && tid == 0) { unsigned* acc = (unsigned*)(kws() + 8192);
                acc[0] += (STAMP_SCAN == 1 ? (ts1 - ts0) : (STAMP_SCAN == 2 ? (ts2 - ts1) : (ts2 - ts0))); } }
#endif
        }
#undef CS_LOAD
    }
#undef IMG
}
#define XB_TMO      128
#define XB_XCNT(j)  (256  + 64 * (j))
#define XB_XSUB(j)  (1280 + 64 * (j))
#define XB_XGEN(j)  (2304 + 64 * (j))
#define XB_TOP      3328
#define XB_TOPGEN   3392
#define XCD_BAR_WORDS 3456
#define XB_SPIN_CAP (1u << 20)

__device__ __forceinline__ unsigned xb_ld(unsigned* p)              { return __hip_atomic_load(p, __ATOMIC_RELAXED, __HIP_MEMORY_SCOPE_AGENT); }
__device__ __forceinline__ unsigned xb_add(unsigned* p, unsigned v) { return __hip_atomic_fetch_add(p, v, __ATOMIC_RELAXED, __HIP_MEMORY_SCOPE_AGENT); }
__device__ __forceinline__ unsigned xb_xcc_id() { return (unsigned)__builtin_amdgcn_s_getreg((3 << 11) | 20) & 0xFu; }
#define XB_SPIN(cond, bar) do { unsigned _sp = 0; while (cond) { __builtin_amdgcn_s_sleep(1); \
    if ((++_sp & 255u) == 0u) { if (xb_ld(&(bar)[XB_TMO])) break; if (_sp > XB_SPIN_CAP) { atomicAdd(&(bar)[XB_TMO], 1u); break; } } } } while (0)

struct XcdBarrier {
    unsigned* bar; unsigned x; int wv;
    volatile LAS unsigned* st;
};

__device__ __forceinline__ XcdBarrier xcd_barrier_post(unsigned* bar, volatile LAS unsigned* st) {
    XcdBarrier b; b.bar = bar; b.x = xb_xcc_id(); b.st = st;
    if (threadIdx.x == 0) (void)xb_add(&bar[XB_XCNT(b.x)], 1u);
    return b;
}
__device__ __forceinline__ void xcd_barrier_complete(unsigned* bar, unsigned x, unsigned& nloc, unsigned& nx) {
    const unsigned G = gridDim.x * gridDim.y * gridDim.z;
    unsigned sum, cnt, mine, sp = 0u;
    for (;;) {
        sum = 0u; cnt = 0u; mine = 0u;
#pragma unroll
        for (unsigned j = 0; j < 16; ++j) { const unsigned c = xb_ld(&bar[XB_XCNT(j)]); sum += c; cnt += (c > 0u) ? 1u : 0u; mine = (j == x) ? c : mine; }
        if (sum == G) break;
        __builtin_amdgcn_s_sleep(1);
        if ((++sp & 255u) == 0u) { if (xb_ld(&bar[XB_TMO])) break; if (sp > XB_SPIN_CAP) { atomicAdd(&bar[XB_TMO], 1u); break; } }
    }
    nloc = mine > 0u ? mine : 1u; nx = cnt > 0u ? cnt : 1u;
}

__device__ __forceinline__ void xcd_barrier(const XcdBarrier& b) {
    asm volatile("s_waitcnt vmcnt(0)" ::: "memory");
    __syncthreads();
    unsigned xz_ = 0u; asm volatile("" : "+v"(xz_));
    if (b.wv == 0 && __builtin_amdgcn_mbcnt_hi(~0u, __builtin_amdgcn_mbcnt_lo(~0u, xz_)) == 0u) {
        unsigned* bar = b.bar; asm volatile("" : "+s"(bar));
        __builtin_amdgcn_s_waitcnt(0);
        unsigned nloc = b.st[0], nx = b.st[1];
        if (nloc == 0u) { xcd_barrier_complete(bar, b.x, nloc, nx); b.st[0] = nloc; b.st[1] = nx; }
        const unsigned old = xb_add(&bar[XB_XSUB(b.x)], 1u);
        const unsigned gen = old / nloc;
        if (old + 1u == (gen + 1u) * nloc) {
            __builtin_amdgcn_fence(__ATOMIC_RELEASE, "agent");
            asm volatile("s_waitcnt vmcnt(0)" ::: "memory");
            const unsigned og = xb_add(&bar[XB_TOP], 1u);
            const unsigned tg = og / nx;
            if (og + 1u == (tg + 1u) * nx) xb_add(&bar[XB_TOPGEN], 1u);
            else XB_SPIN(xb_ld(&bar[XB_TOPGEN]) == tg, bar);
            __builtin_amdgcn_fence(__ATOMIC_ACQUIRE, "agent");
            xb_add(&bar[XB_XGEN(b.x)], 1u);
            asm volatile("s_waitcnt vmcnt(0)" ::: "memory");
        } else {
            XB_SPIN(xb_ld(&bar[XB_XGEN(b.x)]) == gen, bar);
            __builtin_amdgcn_fence(__ATOMIC_ACQUIRE, "agent");
            asm volatile("s_waitcnt vmcnt(0)" ::: "memory");
        }
    }
    __syncthreads();
}


template <class Epi, class Sched>
__device__ __forceinline__ void run_gemm(int wv, LAS unsigned char* lds, const bf16_t* A, int lda, const bf16_t* Bt, int ldb, int M, int N, int K, const Sched& S, const Epi& E, int pshift = 30, int pmask = -1, int koff = 0, int alt_from = 1 << 30, int nt_alt = 0) {
    asm volatile("" : "+s"(K));
    Gemm g; g.A = A; g.Bt = Bt; g.M = M; g.N = N; g.K = K; g.lda = lda; g.ldb = ldb; g.wv = wv; g.sa = 0; g.sb = 0; g.pshift = pshift; g.pmask = pmask; g.koff = koff; g.alt_from = alt_from; g.nt_alt = nt_alt;
    pg8::gemm_phase<Epi, Sched, false>(lds, g, S, E, nullptr);
}
template <class Epi, class Sched>
__device__ __forceinline__ void run_gemm_f8(int wv, LAS unsigned char* lds, const unsigned char* A, int lda, const unsigned char* Bt, int ldb, int M, int N, int K, int sa, int sb, const Sched& S, const Epi& E) {
    asm volatile("" : "+s"(K));
    Gemm g; g.A = (const bf16_t*)A; g.Bt = (const bf16_t*)Bt; g.M = M; g.N = N; g.K = K; g.lda = lda; g.ldb = ldb; g.wv = wv; g.sa = sa; g.sb = sb; g.pshift = 30; g.pmask = -1; g.koff = 0; g.alt_from = 1 << 30; g.nt_alt = 0;
    pg8::gemm_phase_f8<Epi, Sched, false>(lds, g, S, E, nullptr);
}

#ifndef EN_MASK
#define EN_MASK 0xFFFFFFFFu
#endif
#define EN_PH(k) ((EN_MASK >> (k)) & 1u)
#ifndef PROBE_REP
#define PROBE_REP (-1)
#endif
#ifndef PROBE_MASK
#define PROBE_MASK 0u
#endif
#define REP(k) for (int rep_ = 0; rep_ < (((PROBE_REP == (k)) || ((k) < 32 && ((PROBE_MASK >> ((k) & 31)) & 1u))) ? 2 : 1); ++rep_)
constexpr int NPH_PRO = 2, NPH_LAYER = 12, NPH_TOTAL = NPH_PRO + DEPTH * NPH_LAYER;

__global__ void __launch_bounds__(512, 2) mega(Params Pk) {
    Params P = Pk; P.pad0 = __builtin_amdgcn_readfirstlane((int)threadIdx.x >> 6);
    extern __shared__ __attribute__((aligned(16))) unsigned char shm[];
    float* ldsf = (float*)shm;
    LAS unsigned char* ldsl = (LAS unsigned char*)shm;
    unsigned char* ws = kws();
    const int G = gridDim.x, c = blockIdx.x;
    XcdBarrier bar;
    if (P.fused) {
        volatile LAS unsigned* st = (volatile LAS unsigned*)(ldsl + LDS_BYTES - 16);
        if (threadIdx.x == 0) { st[0] = 0u; st[1] = 0u; st[2] = 0u; st[3] = 0u; }
        __syncthreads();
        bar = xcd_barrier_post((unsigned*)(ws + WS_CTL), st); bar.wv = P.pad0;
    }
    int ph = 0;
#define PH_BEGIN if (ph >= P.ph_lo && ph < P.ph_hi) {
#ifndef BAR_TWICE
#define BAR_TWICE 0
#endif
#define PH_END_  if (P.fused) { xcd_barrier(bar); if (BAR_TWICE) xcd_barrier(bar); } else __syncthreads(); } ++ph;

    PH_BEGIN
#if EN_PH(0)
REP(0) { if (rep_) __syncthreads();
phase_convert(P, ldsf);
}
#endif
 PH_END_
    PH_BEGIN
#if EN_PH(1)
REP(1) { if (rep_) __syncthreads();
{ pg8::StaticOrder S; S.init(NBATCH * NMEM, DEPTH * 512, G, c); EpiBf16Store E; E.O = (bf16_t*)(ws + WS_KVMEM); E.ldc = DEPTH * 512; E.st = ldsl + 131072; E.GP = nullptr;
        run_gemm(P.pad0, ldsl, (const bf16_t*)(ws + WS_MEMB), DM, (const bf16_t*)(ws + WS_WKV), DM, NBATCH * NMEM, DEPTH * 512, DM, S, E); }
}
#endif
 PH_END_

    for (int l = 0; l < DEPTH; ++l) {
        PH_BEGIN
#if EN_PH(2)
REP(2) { if (rep_) __syncthreads();
{ pg8::StaticOrder S; S.init(NTOK, INC, G, c); EpiBf16Store E; E.O = (bf16_t*)(ws + WS_P); E.ldc = INC; E.st = ldsl + 131072; E.GP = (bf16_t*)(ws + WS_GATEP);
            run_gemm(P.pad0, ldsl, (const bf16_t*)(ws + WS_XB), DM, (const bf16_t*)(ws + WS_WIN) + (size_t)l * INC * DM, DM, NTOK, INC, DM, S, E); }
}
#endif
 PH_END_
        PH_BEGIN
#if EN_PH(3)
REP(3) { if (rep_) __syncthreads();
phase_prepass(P, l);
}
#endif
 PH_END_
        PH_BEGIN
#if EN_PH(4)
REP(4) { if (rep_) __syncthreads();
{ pg8::StaticOrder S; S.init(NTOK, LORA_N, G, c); EpiLora E; E.O = (bf16_t*)(ws + WS_LORA); E.w0 = kin(I_W0) + l * 2048; E.a0 = kin(I_A0) + l * 2048;
            run_gemm(P.pad0, ldsl, (const bf16_t*)(ws + WS_APR), 256, (const bf16_t*)(ws + WS_WLORA) + (size_t)l * LORA_N * 256, 256, NTOK, LORA_N, 128, S, E, 4, -1, 256); }
}
#endif
 PH_END_
        PH_BEGIN
#if EN_PH(5)
REP(5) { if (rep_) __syncthreads();
REP(100) { if (rep_) __syncthreads(); phase_scan_chunked(P, l, ldsl); }
        REP(101) { if (rep_) __syncthreads(); phase_attn_mfma(P, l, ldsl); }
}
#endif
 PH_END_
        PH_BEGIN
#if EN_PH(6)
REP(6) { if (rep_) __syncthreads();
phase_post(P, l);
}
#endif
 PH_END_
        PH_BEGIN
#if EN_PH(7)
REP(7) { if (rep_) __syncthreads();
{ BranchOrder S; S.init(NTOK, DM, G, c);
            const bf16_t* ycat = (const bf16_t*)(ws + WS_YCAT); const bf16_t* wbr = (const bf16_t*)(ws + WS_WBR) + (size_t)l * DM * BRK;
            EpiBranchAll E; E.gateP = (const bf16_t*)(ws + WS_GATEP); E.mbP = (bf16_t*)(ws + WS_MBP); E.mb = (bf16_t*)(ws + WS_MB); E.st = ldsl + 131072;
            run_gemm(P.pad0, ldsl, ycat, BRK, wbr, BRK, NTOK, DM, 1024, S, E, 2, 3, 2048, 3, 4); }
}
#endif
 PH_END_
        PH_BEGIN
#if EN_PH(8)
REP(8) { if (rep_) __syncthreads();
{ pg8::StaticOrder S; S.init(NTOK, DM, G, c); EpiResid E; E.xf = (const float*)(ws + WS_XF); E.o = (float*)(ws + WS_PRELN);
            run_gemm(P.pad0, ldsl, (const bf16_t*)(ws + WS_MB), DM, (const bf16_t*)(ws + WS_WOUT) + (size_t)l * DM * DM, DM, NTOK, DM, DM, S, E); }
}
#endif
 PH_END_
        PH_BEGIN
#if EN_PH(9)
REP(9) { if (rep_) __syncthreads();
phase_ln1(P, l, ldsf);
}
#endif
 PH_END_
        PH_BEGIN
#if EN_PH(10)
REP(10) { if (rep_) __syncthreads();
phase_topk(P, (unsigned long long*)shm);
}
#endif
 PH_END_
        PH_BEGIN
#if EN_PH(11)
REP(11) { if (rep_) __syncthreads();
{ GroupedOrder S; S.init(8, 16, NEXP, G, c); EpiSwiGLU E; E.H = ws + WS_H;
            run_gemm_f8(P.pad0, ldsl, ws + WS_XE, DM, ws + WS_WGU + (size_t)l * NEXP * 4096 * DM, DM, NEXP * 2048, NEXP * 4096, DM, E8_ONE, E8_W, S, E); }
}
#endif
 PH_END_
        PH_BEGIN
#if EN_PH(12)
REP(12) { if (rep_) __syncthreads();
{ GroupedOrder S; S.init(8, 4, NEXP, G, c); EpiDown E; E.Y = (bf16_t*)(ws + WS_YE); E.grow = (const float*)(ws + WS_GROW);
            run_gemm_f8(P.pad0, ldsl, ws + WS_H, DEXP, ws + WS_WDN + (size_t)l * NEXP * DM * DEXP, DEXP, NEXP * 2048, NEXP * DM, DEXP, E8_H, E8_W, S, E); }
}
#endif
 PH_END_
        PH_BEGIN
#if EN_PH(13)
REP(13) { if (rep_) __syncthreads();
phase_ln2(P, l);
}
#endif
 PH_END_
    }
#undef PH_BEGIN
#undef PH_END_
#if STAMP_SCAN
    if (blockIdx.x == 0 && threadIdx.x == 0) { const unsigned long long want = 4ull * *(volatile unsigned*)(kws() + 8192); const long long t0 = clock64(); while ((unsigned long long)(clock64() - t0) < want) __builtin_amdgcn_s_sleep(8); }
#endif
}

#ifndef MK_FUSED
#define MK_FUSED 1
#endif

extern "C" void kernel_launch(void* const* d_in, const int* in_sizes, int n_in, void* d_out, int out_size, void* d_ws, size_t ws_size, hipStream_t stream) {
    static int grid = 0;
    if (grid == 0) {
        if (n_in != N_IN || ws_size < WS_END) { fprintf(stderr, "kernel_launch: unexpected n_in %d or ws_size %zu (< %zu)\n", n_in, ws_size, (size_t)WS_END); grid = -1; return; }
        int dev = 0, cus = 0;
        if (hipGetDevice(&dev) != hipSuccess || hipDeviceGetAttribute(&cus, hipDeviceAttributeMultiprocessorCount, dev) != hipSuccess) { grid = -1; return; }
        if (hipFuncSetAttribute((const void*)mega, hipFuncAttributeMaxDynamicSharedMemorySize, LDS_BYTES) != hipSuccess) { fprintf(stderr, "kernel_launch: hipFuncSetAttribute failed\n"); grid = -1; return; }
        grid = cus > 0 ? cus : 256;
    }
    if (grid < 0) return;
    Params P{};
    for (int i = 0; i < N_IN; ++i) P.in[i] = (const float*)d_in[i];
    P.out = (float*)d_out; P.ws = (unsigned char*)d_ws; P.pad0 = 0;
#if MK_FUSED
    (void)hipMemsetAsync((char*)d_ws + WS_CTL, 0, XCD_BAR_WORDS * sizeof(unsigned), stream);
    P.ph_lo = 0; P.ph_hi = NPH_TOTAL; P.fused = 1;
    hipLaunchKernelGGL(mega, dim3(grid), dim3(NTHR), LDS_BYTES, stream, P);
#else
    for (int ph = 0; ph < NPH_TOTAL; ++ph) {
        P.ph_lo = ph; P.ph_hi = ph + 1; P.fused = 0;
        hipLaunchKernelGGL(mega, dim3(grid), dim3(NTHR), LDS_BYTES, stream, P);
    }
#endif
}
```

```cpp
#include <hip/hip_runtime.h>
#include <stdint.h>
#include <stdio.h>

namespace pg8 {
#define PG8_LAS __attribute__((address_space(3)))
typedef unsigned short bf16_t;
typedef short bf16x8 __attribute__((ext_vector_type(8)));
typedef float f32x4 __attribute__((ext_vector_type(4)));
typedef unsigned u32x4 __attribute__((ext_vector_type(4)));
constexpr int BM = 256, BK = 64, HALF = 128, HTB = HALF * BK * 2  , STAGE_BYTES = 8 * HTB, NXCD = 8, WGM = 8;

__host__ __device__ __forceinline__ int lds_byte(int r, int c) { const int st = (r >> 4) * 2 + (c >> 5), rr = r & 15, cc = c & 31, ob = rr * 64 + cc * 2; return st * 1024 + (ob ^ (((ob >> 9) & 1) << 5)); }
__host__ __device__ __forceinline__ void stage_rc(int b, int& R, int& C) { const int st = b / 1024, sb = b % 1024, swz = sb ^ (((sb >> 9) & 1) << 5); R = (st >> 1) * 16 + swz / 64; C = (st & 1) * 32 + (swz % 64) / 2; }
__host__ __device__ __forceinline__ int perm32(int rho) { const int n = rho >> 4, i = rho & 15; return 8 * (i >> 2) + 4 * n + (i & 3); }

struct Unit { int pm, pn; };
struct Gemm { const bf16_t* A; const bf16_t* Bt; int M, N, K, lda, ldb, wv, sa, sb, pshift, pmask, koff, alt_from, nt_alt; };
struct StaticOrder {
    int nM, nN, nwg, G, c;
    __host__ __device__ void init(int M, int N, int G_, int c_) { nM = M / BM; nN = N / BM; nwg = nM * nN; G = G_; c = c_; }
    __host__ __device__ bool next(int i, Unit& u) const {
        const long L = (long)i * G + c; if (L >= nwg) return false;
        int wgid = (int)L; { const int q = nwg / NXCD, r = nwg % NXCD, xcd = wgid % NXCD, off = wgid / NXCD; wgid = (xcd < r ? xcd * (q + 1) : r * (q + 1) + (xcd - r) * q) + off; }
        const int nig = WGM * nN, gid = wgid / nig, fm = gid * WGM, gsz = (nM - fm) < WGM ? (nM - fm) : WGM;
        u.pm = fm + ((wgid % nig) % gsz); u.pn = (wgid % nig) / gsz; return true;
    }
    __device__ __forceinline__ void a_ready(const Unit&) const {}
    __device__ __forceinline__ void done(const Unit&) const {}
};
__device__ __forceinline__ unsigned cvt_pk_bf16(float lo, float hi) { unsigned r; asm volatile("v_cvt_pk_bf16_f32 %0, %1, %2" : "=v"(r) : "v"(lo), "v"(hi)); return r; }
template <class Epi, class Sched, bool STAMP = false>
__device__ __forceinline__ void gemm_phase(PG8_LAS unsigned char* lds, const Gemm g, const Sched& S, const Epi& E, unsigned long long* stamps) {
    unsigned z_ = 0u; asm volatile("" : "+v"(z_)); int tid_ = g.wv * 64 + (int)__builtin_amdgcn_mbcnt_hi(~0u, __builtin_amdgcn_mbcnt_lo(~0u, z_)); asm volatile("" : "+v"(tid_));
    const int tid = tid_, wid = __builtin_amdgcn_readfirstlane(tid >> 6), lane = tid & 63, wr = wid >> 2, wc = wid & 3, fr = lane & 15, fq = lane >> 4;
    const int K = g.K, nt = K / BK;
    int ts_lo = 0, ts_hi = 0, nts = 0; const unsigned long long rt_entry = STAMP ? (unsigned long long)wall_clock64() : 0ull;
#define PG8_STAMP() do { if (STAMP && wid == 0 && nts < 64) { const unsigned long long _c = (unsigned long long)clock64(); \
        ts_lo = (lane == nts) ? (int)(unsigned)_c : ts_lo; ts_hi = (lane == nts) ? (int)(unsigned)(_c >> 32) : ts_hi; ++nts; } } while (0)
    PG8_STAMP();
    unsigned voffA[2], voffB[2];
#pragma unroll
    for (int i = 0; i < 2; ++i) { int R, C; stage_rc(tid * 16 + i * 8192, R, C); const int Rb = Epi::PERM ? ((R & ~31) + perm32(R & 31)) : R;
        voffA[i] = (unsigned)(R * g.lda + C) * 2u; voffB[i] = (unsigned)(Rb * g.ldb + C) * 2u; }
    const size_t kstep = (size_t)(BK * 2);
    const size_t hstepA = (size_t)HALF * g.lda * 2, hstepB = (size_t)HALF * g.ldb * 2;
    const size_t tstepA = 2 * hstepA, tstepB = 2 * hstepB;
    const unsigned ldsw = (unsigned)wid * 1024u;
    const int aoff = lds_byte(wr * 64 + fr, fq * 8), boff = lds_byte(wc * 32 + fr, fq * 8);
#define PG8_SA(b, h) (((b) * 2 + (h)) * HTB)
#define PG8_SB(b, h) ((4 + (b) * 2 + (h)) * HTB)
#define PG8_STAGE(bufoff, gbase, voff) do { _Pragma("unroll") for (int _i = 0; _i < 2; ++_i) \
        __builtin_amdgcn_global_load_lds((const unsigned*)((const char*)(gbase) + (voff)[_i]), (PG8_LAS unsigned*)(lds + (bufoff) + ldsw + _i * 8192), 16, 0, 0); } while (0)
#define PG8_LDA(dst, b, h) do { _Pragma("unroll") for (int m = 0; m < 4; ++m) _Pragma("unroll") for (int k = 0; k < 2; ++k) dst[m][k] = *(const PG8_LAS bf16x8*)(lds + PG8_SA(b, h) + aoff + m * 2048 + k * 1024); } while (0)
#define PG8_LDB(dst, b, h) do { _Pragma("unroll") for (int n = 0; n < 2; ++n) _Pragma("unroll") for (int k = 0; k < 2; ++k) dst[n][k] = *(const PG8_LAS bf16x8*)(lds + PG8_SB(b, h) + boff + n * 2048 + k * 1024); } while (0)
#define PG8_MMA(ai, bj, At, Bt) do { __builtin_amdgcn_s_setprio(1); _Pragma("unroll") for (int m = 0; m < 4; ++m) _Pragma("unroll") for (int n = 0; n < 2; ++n) _Pragma("unroll") for (int k = 0; k < 2; ++k) \
        acc[ai][bj][m][n] = __builtin_amdgcn_mfma_f32_16x16x32_bf16(Bt[n][k], At[m][k], acc[ai][bj][m][n], 0, 0, 0); __builtin_amdgcn_s_setprio(0); } while (0)
#define PG8_WAIT_V(n) asm volatile("s_waitcnt vmcnt(" #n ")" ::: "memory")
#define PG8_WAIT_L(n) asm volatile("s_waitcnt lgkmcnt(" #n ")" ::: "memory")
#define PG8_BAR __builtin_amdgcn_s_barrier()
#define PG8_SCHED __builtin_amdgcn_sched_barrier(0)
    Unit cur, nxt; int ui = 0;
    if (!S.next(0, cur)) return;
    f32x4 acc[2][2][4][2];
#pragma unroll
    for (int a = 0; a < 2; ++a)
#pragma unroll
        for (int b = 0; b < 2; ++b)
#pragma unroll
            for (int m = 0; m < 4; ++m)
#pragma unroll
                for (int n = 0; n < 2; ++n) acc[a][b][m][n] = (f32x4){0.f, 0.f, 0.f, 0.f};
    bf16x8 At[4][2], B0[2][2], B1[2][2];
    const char* cA = (const char*)g.A + (size_t)cur.pm * tstepA + (size_t)(cur.pn >> g.pshift) * g.koff; const char* cB = (const char*)g.Bt + (size_t)(cur.pn & g.pmask) * tstepB + (size_t)(cur.pn >> g.pshift) * g.koff;
    S.a_ready(cur);
    PG8_STAGE(PG8_SB(0, 0), cB, voffB); PG8_STAGE(PG8_SA(0, 0), cA, voffA); PG8_STAGE(PG8_SB(0, 1), cB + hstepB, voffB); PG8_STAGE(PG8_SA(0, 1), cA + hstepA, voffA);
    if (wr == 1) PG8_BAR;
    PG8_WAIT_V(4); PG8_BAR;
    PG8_STAGE(PG8_SB(1, 0), cB + kstep, voffB); PG8_STAGE(PG8_SA(1, 0), cA + kstep, voffA); PG8_STAGE(PG8_SB(1, 1), cB + hstepB + kstep, voffB);
    PG8_WAIT_V(6); PG8_BAR;
    PG8_STAMP();
    for (;;) {
        const bool has_next = S.next(ui + 1, nxt);
        const char* nA = has_next ? (const char*)g.A + (size_t)nxt.pm * tstepA + (size_t)(nxt.pn >> g.pshift) * g.koff : cA; const char* nB = has_next ? (const char*)g.Bt + (size_t)(nxt.pn & g.pmask) * tstepB + (size_t)(nxt.pn >> g.pshift) * g.koff : cB;
        const int ntu = ((cur.pn >> g.pshift) >= g.alt_from) ? g.nt_alt : nt;
        for (int t = 0; t < ntu; t += 2) {
            const bool last = (t == ntu - 2);
            const char* a1 = cA + (size_t)(t + 1) * kstep;
            const char* a2 = last ? nA : cA + (size_t)(t + 2) * kstep; const char* b2 = last ? nB : cB + (size_t)(t + 2) * kstep;
            const char* a3 = a2 + kstep; const char* b3 = b2 + kstep;
            if (last && has_next) S.a_ready(nxt);
            PG8_LDB(B0, 0, 0); PG8_SCHED; PG8_LDA(At, 0, 0); PG8_STAGE(PG8_SA(1, 1), a1 + hstepA, voffA);
            PG8_WAIT_L(8); PG8_BAR; PG8_WAIT_L(0); PG8_MMA(0, 0, At, B0); PG8_BAR; PG8_SCHED;
            PG8_LDB(B1, 0, 1); PG8_STAGE(PG8_SB(0, 0), b2, voffB);
            PG8_BAR; PG8_WAIT_L(0); PG8_MMA(0, 1, At, B1); PG8_BAR;
            PG8_LDA(At, 0, 1); PG8_STAGE(PG8_SA(0, 0), a2, voffA);
            PG8_BAR; PG8_WAIT_L(0); PG8_MMA(1, 0, At, B0); PG8_BAR; PG8_SCHED;
            PG8_STAGE(PG8_SB(0, 1), b2 + hstepB, voffB);
            PG8_WAIT_V(6); PG8_BAR; PG8_MMA(1, 1, At, B1); PG8_BAR;
            PG8_LDB(B0, 1, 0); PG8_SCHED; PG8_LDA(At, 1, 0); PG8_STAGE(PG8_SA(0, 1), a2 + hstepA, voffA);
            PG8_WAIT_L(8); PG8_BAR; PG8_WAIT_L(0); PG8_MMA(0, 0, At, B0); PG8_BAR; PG8_SCHED;
            PG8_LDB(B1, 1, 1); PG8_STAGE(PG8_SB(1, 0), b3, voffB);
            PG8_BAR; PG8_WAIT_L(0); PG8_MMA(0, 1, At, B1); PG8_BAR;
            PG8_LDA(At, 1, 1); PG8_STAGE(PG8_SA(1, 0), a3, voffA);
            PG8_BAR; PG8_WAIT_L(0); PG8_MMA(1, 0, At, B0); PG8_BAR; PG8_SCHED;
            PG8_STAGE(PG8_SB(1, 1), b3 + hstepB, voffB);
            PG8_WAIT_V(6); PG8_BAR; PG8_MMA(1, 1, At, B1); PG8_BAR;
        }
        PG8_STAMP();
        if constexpr (!Epi::AFTER_DRAIN) { E(acc, cur, wr, wc, fr, fq); S.done(cur); }
        PG8_STAMP();
        if (!has_next) break;
#pragma unroll
        for (int a = 0; a < 2; ++a)
#pragma unroll
            for (int b = 0; b < 2; ++b)
#pragma unroll
                for (int m = 0; m < 4; ++m)
#pragma unroll
                    for (int n = 0; n < 2; ++n) acc[a][b][m][n] = (f32x4){0.f, 0.f, 0.f, 0.f};
        cur = nxt; cA = nA; cB = nB; ++ui;
    }
    PG8_WAIT_V(0);
    if (wr == 0) PG8_BAR;
    PG8_BAR;
    if constexpr (Epi::AFTER_DRAIN) { E.fused(acc, cur, wr, wc, fr, fq, lds, wid, lane); S.done(cur); }
    PG8_STAMP();
    if (STAMP && wid == 0) { stamps[lane] = lane < nts ? (((unsigned long long)(unsigned)ts_hi << 32) | (unsigned)ts_lo) : 0ull;
        if (lane == 62) stamps[62] = rt_entry; if (lane == 63) stamps[63] = (unsigned long long)wall_clock64(); }
#undef PG8_STAMP
#undef PG8_SA
#undef PG8_SB
#undef PG8_STAGE
#undef PG8_LDA
#undef PG8_LDB
#undef PG8_MMA
#undef PG8_WAIT_V
#undef PG8_WAIT_L
#undef PG8_BAR
#undef PG8_SCHED
}

typedef short bf16x16 __attribute__((ext_vector_type(16)));
typedef int v8i __attribute__((ext_vector_type(8)));
template <class Epi, class Sched, bool STAMP = false>
__device__ __forceinline__ void gemm_phase_f8(PG8_LAS unsigned char* lds, const Gemm g, const Sched& S, const Epi& E, unsigned long long* stamps) {
    unsigned z_ = 0u; asm volatile("" : "+v"(z_)); int tid_ = g.wv * 64 + (int)__builtin_amdgcn_mbcnt_hi(~0u, __builtin_amdgcn_mbcnt_lo(~0u, z_)); asm volatile("" : "+v"(tid_));
    const int tid = tid_, wid = __builtin_amdgcn_readfirstlane(tid >> 6), lane = tid & 63, wr = wid >> 2, wc = wid & 3, fr = lane & 15, fq = lane >> 4;
    const int K = g.K, nt = K / 128;
    int ts_lo = 0, ts_hi = 0, nts = 0; const unsigned long long rt_entry = STAMP ? (unsigned long long)wall_clock64() : 0ull;
#define PG8_STAMP() do { if (STAMP && wid == 0 && nts < 64) { const unsigned long long _c = (unsigned long long)clock64(); \
        ts_lo = (lane == nts) ? (int)(unsigned)_c : ts_lo; ts_hi = (lane == nts) ? (int)(unsigned)(_c >> 32) : ts_hi; ++nts; } } while (0)
    PG8_STAMP();
    unsigned voffA[2], voffB[2];
#pragma unroll
    for (int i = 0; i < 2; ++i) { int R, C; stage_rc(tid * 16 + i * 8192, R, C); const int Rb = Epi::PERM ? ((R & ~31) + perm32(R & 31)) : R;
        voffA[i] = (unsigned)(R * g.lda) + (unsigned)C * 2u; voffB[i] = (unsigned)(Rb * g.ldb) + (unsigned)C * 2u; }
    const size_t kstep = (size_t)(BK * 2);
    const size_t hstepA = (size_t)HALF * g.lda, hstepB = (size_t)HALF * g.ldb;
    const size_t tstepA = 2 * hstepA, tstepB = 2 * hstepB;
    const unsigned ldsw = (unsigned)wid * 1024u;
    const int aoff = lds_byte(wr * 64 + fr, fq * 8), boff = lds_byte(wc * 32 + fr, fq * 8);
#define PG8_SA(b, h) (((b) * 2 + (h)) * HTB)
#define PG8_SB(b, h) ((4 + (b) * 2 + (h)) * HTB)
#define PG8_STAGE(bufoff, gbase, voff) do { _Pragma("unroll") for (int _i = 0; _i < 2; ++_i) \
        __builtin_amdgcn_global_load_lds((const unsigned*)((const char*)(gbase) + (voff)[_i]), (PG8_LAS unsigned*)(lds + (bufoff) + ldsw + _i * 8192), 16, 0, 0); } while (0)
#define PG8_LDA(dst, b, h) do { _Pragma("unroll") for (int m = 0; m < 4; ++m) { const bf16x8 lo_ = *(const PG8_LAS bf16x8*)(lds + PG8_SA(b, h) + aoff + m * 2048), hi_ = *(const PG8_LAS bf16x8*)(lds + PG8_SA(b, h) + aoff + m * 2048 + 1024); \
        dst[m] = __builtin_shufflevector(lo_, hi_, 0, 1, 2, 3, 4, 5, 6, 7, 8, 9, 10, 11, 12, 13, 14, 15); } } while (0)
#define PG8_LDB(dst, b, h) do { _Pragma("unroll") for (int n = 0; n < 2; ++n) { const bf16x8 lo_ = *(const PG8_LAS bf16x8*)(lds + PG8_SB(b, h) + boff + n * 2048), hi_ = *(const PG8_LAS bf16x8*)(lds + PG8_SB(b, h) + boff + n * 2048 + 1024); \
        dst[n] = __builtin_shufflevector(lo_, hi_, 0, 1, 2, 3, 4, 5, 6, 7, 8, 9, 10, 11, 12, 13, 14, 15); } } while (0)
#define PG8_MMA(ai, bj, At, Bt) do { __builtin_amdgcn_s_setprio(1); _Pragma("unroll") for (int m = 0; m < 4; ++m) _Pragma("unroll") for (int n = 0; n < 2; ++n) \
        asm volatile("v_mfma_scale_f32_16x16x128_f8f6f4 %0, %1, %2, %0, %3, %4 op_sel_hi:[0,0,0]" : "+v"(acc[ai][bj][m][n]) : "v"(__builtin_bit_cast(v8i, Bt[n])), "v"(__builtin_bit_cast(v8i, At[m])), "v"(sbv), "v"(sav)); \
        __builtin_amdgcn_s_setprio(0); } while (0)
#define PG8_WAIT_V(n) asm volatile("s_waitcnt vmcnt(" #n ")" ::: "memory")
#define PG8_WAIT_L(n) asm volatile("s_waitcnt lgkmcnt(" #n ")" ::: "memory")
#define PG8_BAR __builtin_amdgcn_s_barrier()
#define PG8_SCHED __builtin_amdgcn_sched_barrier(0)
    Unit cur, nxt; int ui = 0;
    if (!S.next(0, cur)) return;
    f32x4 acc[2][2][4][2];
#pragma unroll
    for (int a = 0; a < 2; ++a)
#pragma unroll
        for (int b = 0; b < 2; ++b)
#pragma unroll
            for (int m = 0; m < 4; ++m)
#pragma unroll
                for (int n = 0; n < 2; ++n) acc[a][b][m][n] = (f32x4){0.f, 0.f, 0.f, 0.f};
    bf16x16 At[4], B0[2], B1[2];
    int sav = g.sa, sbv = g.sb;
    const char* cA = (const char*)g.A + (size_t)cur.pm * tstepA + (size_t)(cur.pn >> g.pshift) * g.koff; const char* cB = (const char*)g.Bt + (size_t)(cur.pn & g.pmask) * tstepB + (size_t)(cur.pn >> g.pshift) * g.koff;
    S.a_ready(cur);
    PG8_STAGE(PG8_SB(0, 0), cB, voffB); PG8_STAGE(PG8_SA(0, 0), cA, voffA); PG8_STAGE(PG8_SB(0, 1), cB + hstepB, voffB); PG8_STAGE(PG8_SA(0, 1), cA + hstepA, voffA);
    if (wr == 1) PG8_BAR;
    PG8_WAIT_V(4); PG8_BAR;
    PG8_STAGE(PG8_SB(1, 0), cB + kstep, voffB); PG8_STAGE(PG8_SA(1, 0), cA + kstep, voffA); PG8_STAGE(PG8_SB(1, 1), cB + hstepB + kstep, voffB);
    PG8_WAIT_V(6); PG8_BAR;
    PG8_STAMP();
    for (;;) {
        const bool has_next = S.next(ui + 1, nxt);
        const char* nA = has_next ? (const char*)g.A + (size_t)nxt.pm * tstepA + (size_t)(nxt.pn >> g.pshift) * g.koff : cA; const char* nB = has_next ? (const char*)g.Bt + (size_t)(nxt.pn & g.pmask) * tstepB + (size_t)(nxt.pn >> g.pshift) * g.koff : cB;
        for (int t = 0; t < nt; t += 2) {
            const bool last = (t == nt - 2);
            const char* a1 = cA + (size_t)(t + 1) * kstep;
            const char* a2 = last ? nA : cA + (size_t)(t + 2) * kstep; const char* b2 = last ? nB : cB + (size_t)(t + 2) * kstep;
            const char* a3 = a2 + kstep; const char* b3 = b2 + kstep;
            if (last && has_next) S.a_ready(nxt);
            PG8_LDB(B0, 0, 0); PG8_SCHED; PG8_LDA(At, 0, 0); PG8_STAGE(PG8_SA(1, 1), a1 + hstepA, voffA);
            PG8_WAIT_L(8); PG8_BAR; PG8_WAIT_L(0); PG8_MMA(0, 0, At, B0); PG8_BAR; PG8_SCHED;
            PG8_LDB(B1, 0, 1); PG8_STAGE(PG8_SB(0, 0), b2, voffB);
            PG8_BAR; PG8_WAIT_L(0); PG8_MMA(0, 1, At, B1); PG8_BAR;
            PG8_LDA(At, 0, 1); PG8_STAGE(PG8_SA(0, 0), a2, voffA);
            PG8_BAR; PG8_WAIT_L(0); PG8_MMA(1, 0, At, B0); PG8_BAR; PG8_SCHED;
            PG8_STAGE(PG8_SB(0, 1), b2 + hstepB, voffB);
            PG8_WAIT_V(6); PG8_BAR; PG8_MMA(1, 1, At, B1); PG8_BAR;
            PG8_LDB(B0, 1, 0); PG8_SCHED; PG8_LDA(At, 1, 0); PG8_STAGE(PG8_SA(0, 1), a2 + hstepA, voffA);
            PG8_WAIT_L(8); PG8_BAR; PG8_WAIT_L(0); PG8_MMA(0, 0, At, B0); PG8_BAR; PG8_SCHED;
            PG8_LDB(B1, 1, 1); PG8_STAGE(PG8_SB(1, 0), b3, voffB);
            PG8_BAR; PG8_WAIT_L(0); PG8_MMA(0, 1, At, B1); PG8_BAR;
            PG8_LDA(At, 1, 1); PG8_STAGE(PG8_SA(1, 0), a3, voffA);
            PG8_BAR; PG8_WAIT_L(0); PG8_MMA(1, 0, At, B0); PG8_BAR; PG8_SCHED;
            PG8_STAGE(PG8_SB(1, 1), b3 + hstepB, voffB);
            PG8_WAIT_V(6); PG8_BAR; PG8_MMA(1, 1, At, B1); PG8_BAR;
        }
        asm volatile("s_nop 15\n\ts_nop 7" ::: "memory");
        PG8_STAMP();
        if constexpr (!Epi::AFTER_DRAIN) { E(acc, cur, wr, wc, fr, fq); S.done(cur); }
        PG8_STAMP();
        if (!has_next) break;
#pragma unroll
        for (int a = 0; a < 2; ++a)
#pragma unroll
            for (int b = 0; b < 2; ++b)
#pragma unroll
                for (int m = 0; m < 4; ++m)
#pragma unroll
                    for (int n = 0; n < 2; ++n) acc[a][b][m][n] = (f32x4){0.f, 0.f, 0.f, 0.f};
        cur = nxt; cA = nA; cB = nB; ++ui;
    }
    PG8_WAIT_V(0);
    if (wr == 0) PG8_BAR;
    PG8_BAR;
    if constexpr (Epi::AFTER_DRAIN) { E.fused(acc, cur, wr, wc, fr, fq, lds, wid, lane); S.done(cur); }
    PG8_STAMP();
    if (STAMP && wid == 0) { stamps[lane] = lane < nts ? (((unsigned long long)(unsigned)ts_hi << 32) | (unsigned)ts_lo) : 0ull;
        if (lane == 62) stamps[62] = rt_entry; if (lane == 63) stamps[63] = (unsigned long long)wall_clock64(); }
#undef PG8_STAMP
#undef PG8_SA
#undef PG8_SB
#undef PG8_STAGE
#undef PG8_LDA
#undef PG8_LDB
#undef PG8_MMA
#undef PG8_WAIT_V
#undef PG8_WAIT_L
#undef PG8_BAR
#undef PG8_SCHED
}
}

using pg8::bf16_t; using pg8::f32x4; using pg8::u32x4; using pg8::Unit; using pg8::Gemm; using pg8::cvt_pk_bf16;
typedef float f32x2 __attribute__((ext_vector_type(2)));
typedef unsigned u32x2 __attribute__((ext_vector_type(2)));
#define LAS __attribute__((address_space(3)))

constexpr int DM = 1024, NBATCH = 8, SEQ = 2048, NTOK = NBATCH * SEQ, DEPTH = 4, NMEM = 256, INC = 12288;
constexpr int C_R = 0, C_K = 1024, C_V = 2048, C_DW = 3072, C_WQ = 3328, C_WK = 4352, C_WV = 4608, C_DQ = 4864, C_DK = 5888, C_DV = 6912, C_MQ = 7936, C_GATE = 8192;
constexpr int RWC = 3328, LORA_N = 5120, BRK = 3328;
constexpr float DN_ALPHA = 1.6817928305074290f;
constexpr int NEXP = 16, CAP = 256, DEXP = 2048;

enum { I_X = 0, I_MEM, I_RELB, I_WIN, I_MU, I_W0, I_WUP, I_A0, I_AUP, I_GUP, I_KK, I_KA, I_RK, I_GNG, I_GNB, I_SINK, I_LAM, I_SUBLN, I_WKV, I_WBR, I_WOUT,
       I_LN1G, I_LN1B, I_ROUTER, I_EWG, I_EWU, I_EWD, I_LN2G, I_LN2B, N_IN };

constexpr size_t MiB = 1ull << 20;
constexpr size_t WS_CTL = 0;
constexpr size_t WS_WIN = 1 * MiB;
constexpr size_t WS_WBR = WS_WIN + 96 * MiB;
constexpr size_t WS_WOUT = WS_WBR + 26 * MiB;
constexpr size_t WS_WKV = WS_WOUT + 8 * MiB;
constexpr size_t WS_WGU = WS_WKV + 4 * MiB;
constexpr size_t WS_WDN = WS_WGU + 512 * MiB;
constexpr size_t WS_MBP = WS_WGU + 256 * MiB;
constexpr size_t WS_GATEP = WS_WDN + 128 * MiB;
constexpr size_t WS_WLORA = WS_WDN + 256 * MiB;
constexpr size_t WS_XF = WS_WLORA + 10 * MiB;
constexpr size_t WS_XB = WS_XF + 64 * MiB;
constexpr size_t WS_MEMB = WS_XB + 32 * MiB;
constexpr size_t WS_KVMEM = WS_MEMB + 4 * MiB;
constexpr size_t WS_P = WS_KVMEM + 8 * MiB;
constexpr size_t WS_XE = WS_P, WS_H = WS_P + 64 * MiB, WS_YE = WS_P + 192 * MiB;
constexpr size_t WS_APR = WS_P + 384 * MiB;
constexpr size_t WS_LORA = WS_APR + 8 * MiB;
constexpr size_t WS_YDIR = WS_LORA + 160 * MiB;
constexpr size_t WS_BONUS = WS_YDIR + 128 * MiB;
constexpr size_t WS_YCAT = WS_BONUS + 2 * MiB;
constexpr size_t WS_MF = WS_YCAT + 104 * MiB;
constexpr size_t WS_PRELN = WS_MF + 64 * MiB;
constexpr size_t WS_DTMP = WS_MF;
constexpr size_t WS_MB = WS_PRELN + 64 * MiB;
constexpr size_t WS_AFF = WS_MB + 32 * MiB;
constexpr size_t WS_GROW = WS_AFF + 1 * MiB;
constexpr size_t WS_SLOT = WS_GROW + 1 * MiB;
constexpr size_t WS_END = WS_SLOT + 1 * MiB;

struct Params {
    const float* in[N_IN];
    float* out;
    unsigned char* ws;
    int ph_lo, ph_hi;
    int fused, pad0;
};

#define CAS __attribute__((address_space(4)))
__device__ __forceinline__ const CAS unsigned char* karg_base() { const CAS unsigned char* q = (const CAS unsigned char*)__builtin_amdgcn_kernarg_segment_ptr(); asm volatile("" : "+s"(q)); return q; }
__device__ __forceinline__ const float* kin(int i) { return ((const float* const CAS*)karg_base())[i]; }
__device__ __forceinline__ float* kout() { return *(float* const CAS*)(karg_base() + N_IN * 8); }
__device__ __forceinline__ unsigned char* kws() { return *(unsigned char* const CAS*)(karg_base() + N_IN * 8 + 8); }
constexpr int LDS_BYTES = 145 * 1024;
constexpr int NTHR = 512;

__device__ __forceinline__ float bf2f(unsigned v) { return __uint_as_float(v << 16); }
__device__ __forceinline__ float bflo(unsigned v) { return __uint_as_float(v << 16); }
__device__ __forceinline__ float bfhi(unsigned v) { return __uint_as_float(v & 0xffff0000u); }
__device__ __forceinline__ unsigned short f2bf(float f) { unsigned u = __float_as_uint(f); u += 0x7FFFu + ((u >> 16) & 1u); return (unsigned short)(u >> 16); }
__device__ __forceinline__ int lane_id() { unsigned z = 0u; asm volatile("" : "+v"(z)); return (int)__builtin_amdgcn_mbcnt_hi(~0u, __builtin_amdgcn_mbcnt_lo(~0u, z)); }
__device__ __forceinline__ int otid(int wv) { int t = wv * 64 + lane_id(); asm volatile("" : "+v"(t)); return t; }
__device__ __forceinline__ float shfl_xor_o(float v, int mask) { const int lid = lane_id(); return __builtin_bit_cast(float, __builtin_amdgcn_ds_bpermute((lid ^ mask) << 2, __builtin_bit_cast(int, v))); }
__device__ __forceinline__ float wave_sum(float v) {
    const int lid = lane_id();
#pragma unroll
    for (int o = 1; o < 64; o <<= 1) v += __builtin_bit_cast(float, __builtin_amdgcn_ds_bpermute((lid ^ o) << 2, __builtin_bit_cast(int, v)));
    return v;
}
__device__ __forceinline__ float dpp_xor1(float v) { return __builtin_bit_cast(float, __builtin_amdgcn_update_dpp(0, __builtin_bit_cast(int, v), 0xB1, 0xF, 0xF, true)); }
__device__ __forceinline__ float dpp_xor2(float v) { return __builtin_bit_cast(float, __builtin_amdgcn_update_dpp(0, __builtin_bit_cast(int, v), 0x4E, 0xF, 0xF, true)); }
__device__ __forceinline__ float dpp_hmir(float v) { return __builtin_bit_cast(float, __builtin_amdgcn_update_dpp(0, __builtin_bit_cast(int, v), 0x141, 0xF, 0xF, true)); }
__device__ __forceinline__ float sum8(float v) { v += dpp_xor1(v); v += dpp_xor2(v); v += dpp_hmir(v); return v; }
__device__ __forceinline__ float dpp_mir(float v) { return __builtin_bit_cast(float, __builtin_amdgcn_update_dpp(0, __builtin_bit_cast(int, v), 0x140, 0xF, 0xF, true)); }
__device__ __forceinline__ float sum16(float v) { v = sum8(v); v += dpp_mir(v); return v; }
__device__ __forceinline__ float sigmoidf_(float x) { return __builtin_amdgcn_rcpf(1.0f + __expf(-x)); }
__device__ __forceinline__ int t5_bucket(int rel) {
    const int n = rel < 0 ? -rel : rel;
    int large = 2 + (31 - __clz(n * n));
    large = large > 15 ? 15 : large;
    return (rel > 0 ? 16 : 0) + (n < 8 ? n : large);
}

struct GroupedOrder {
    int nMe, nNe, upe, total, G, c;
    __device__ void init(int nMe_, int nNe_, int E, int G_, int c_) { nMe = nMe_; nNe = nNe_; upe = nMe_ * nNe_; total = upe * E; G = G_; c = c_; }
    __device__ bool next(int i, Unit& u) const {
        const int L = i * G + c; if (L >= total) return false;
        const int e = L / upe, rem = L % upe, x = rem & 7, j = rem >> 3;
        const int am = nMe >> 1, pm_e = (x & 1) * am + (j % am), pn_e = (x >> 1) * (nNe >> 2) + (j / am);
        u.pm = e * nMe + pm_e; u.pn = e * nNe + pn_e; return true;
    }
    __device__ __forceinline__ void a_ready(const Unit&) const {}
    __device__ __forceinline__ void done(const Unit&) const {}
};

__device__ __forceinline__ void st_block_bf16(LAS unsigned char* sw, int woff, int roff, const u32x4& X, const u32x4& Y, bf16_t* rowp, size_t ldc) {
    *(LAS u32x4*)(sw + woff) = X; *(LAS u32x4*)(sw + (woff ^ 64)) = Y;
    const u32x4 r0 = *(const LAS u32x4*)(sw + roff), r1 = *(const LAS u32x4*)(sw + roff + 1024);
    *(u32x4*)rowp = r0; *(u32x4*)(rowp + 8 * ldc) = r1;
}
#define ST_BLOCK_SETUP(st_) LAS unsigned char* sw = (st_) + (wr * 4 + wc) * 2048; const int woff = fr * 128 + ((fq ^ (fr & 7)) << 4), lane_ = fq * 16 + fr, rrow = lane_ >> 3, rp = lane_ & 7, roff = rrow * 128 + ((rp ^ (rrow & 7)) << 4)
struct EpiBf16Store {
    static constexpr bool PERM = true, AFTER_DRAIN = false;
    bf16_t* O; int ldc; LAS unsigned char* st;
    bf16_t* GP;
    __device__ __forceinline__ void operator()(const f32x4 (&acc)[2][2][4][2], const Unit& u, int wr, int wc, int fr, int fq) const {
        typedef float fv8_ __attribute__((ext_vector_type(8))); typedef __bf16 bfv8_ __attribute__((ext_vector_type(8)));
        if (GP != nullptr && u.pn >= 32) {
            u32x4* gp = (u32x4*)GP + ((size_t)((u.pm * 16 + (u.pn - 32)) * 8 + wr * 4 + wc) * 16) * 64 + fq * 16 + fr;
#pragma unroll
            for (int ai = 0; ai < 2; ++ai)
#pragma unroll
                for (int m = 0; m < 4; ++m)
#pragma unroll
                    for (int bj = 0; bj < 2; ++bj) { const f32x4 v0 = acc[ai][bj][m][0], v1 = acc[ai][bj][m][1];
                        const fv8_ x8 = {v0[0], v0[1], v0[2], v0[3], v1[0], v1[1], v1[2], v1[3]};
                        gp[((ai * 4 + m) * 2 + bj) * 64] = __builtin_bit_cast(u32x4, __builtin_convertvector(x8, bfv8_)); }
            return;
        }
        ST_BLOCK_SETUP(st);
        bf16_t* op = O + (size_t)(u.pm * 256 + wr * 64 + rrow) * ldc + u.pn * 256 + wc * 64 + rp * 8;
#pragma unroll
        for (int ai = 0; ai < 2; ++ai)
#pragma unroll
            for (int m = 0; m < 4; ++m) { u32x4 wq[2];
#pragma unroll
                for (int bj = 0; bj < 2; ++bj) { const f32x4 v0 = acc[ai][bj][m][0], v1 = acc[ai][bj][m][1];
                    const fv8_ x8 = {v0[0], v0[1], v0[2], v0[3], v1[0], v1[1], v1[2], v1[3]};
                    wq[bj] = __builtin_bit_cast(u32x4, __builtin_convertvector(x8, bfv8_)); }
                st_block_bf16(sw, woff, roff, wq[0], wq[1], op + (size_t)(ai * 128 + m * 16) * ldc, ldc); }
    }
};
struct EpiLora {
    static constexpr bool PERM = true, AFTER_DRAIN = false;
    bf16_t* O; const float* w0; const float* a0;
    __device__ __forceinline__ void operator()(const f32x4 (&acc)[2][2][4][2], const Unit& u, int wr, int wc, int fr, int fq) const {
        const int row0 = u.pm * 256 + wr * 64 + fr, col0 = u.pn * 256 + wc * 64 + 8 * fq;
        const int region = u.pn >> 3;
        f32x4 bv[2][2];
#pragma unroll
        for (int bj = 0; bj < 2; ++bj)
#pragma unroll
            for (int n = 0; n < 2; ++n) { const int c = col0 + bj * 32 + 4 * n;
                bv[bj][n] = region == 0 ? *(const f32x4*)(w0 + c) : (region == 1 ? *(const f32x4*)(a0 + (c - 2048)) : (f32x4){0.f, 0.f, 0.f, 0.f}); }
#pragma unroll
        for (int ai = 0; ai < 2; ++ai)
#pragma unroll
            for (int m = 0; m < 4; ++m) { bf16_t* rowp = O + (size_t)(row0 + ai * 128 + m * 16) * LORA_N + col0;
#pragma unroll
                for (int bj = 0; bj < 2; ++bj) { f32x4 v0 = acc[ai][bj][m][0] + bv[bj][0], v1 = acc[ai][bj][m][1] + bv[bj][1];
                    if (region < 2) {
                        const float sc = region == 0 ? -0.6065306597126334f : 1.0f;
#pragma unroll
                        for (int j = 0; j < 4; ++j) { v0[j] = sc * sigmoidf_(v0[j]); v1[j] = sc * sigmoidf_(v1[j]); }
                    }
                    u32x4 w; w.x = cvt_pk_bf16(v0[0], v0[1]); w.y = cvt_pk_bf16(v0[2], v0[3]); w.z = cvt_pk_bf16(v1[0], v1[1]); w.w = cvt_pk_bf16(v1[2], v1[3]);
                    *(u32x4*)(rowp + bj * 32) = w; } }
    }
};
struct BranchOrder {
    pg8::StaticOrder S0;
    __device__ __forceinline__ void init(int M, int N, int G_, int c_) { S0.init(M, N, G_, c_); }
    __device__ __forceinline__ bool next(int i, Unit& u) const { if (i >= 4) return false; Unit t; if (!S0.next(0, t)) return false; u.pm = t.pm; u.pn = i * 4 + t.pn; return true; }
    __device__ __forceinline__ void a_ready(const Unit&) const {}
    __device__ __forceinline__ void done(const Unit&) const {}
};
struct EpiBranchAll {
    static constexpr bool PERM = true, AFTER_DRAIN = false;
    const bf16_t* gateP;
    bf16_t* mbP; bf16_t* mb; LAS unsigned char* st;
    __device__ __forceinline__ void operator()(const f32x4 (&acc)[2][2][4][2], const Unit& u, int wr, int wc, int fr, int fq) const {
        const int wv8 = wr * 4 + wc, ln = fq * 16 + fr, br = u.pn >> 2, pn = u.pn & 3, MODE = br == 0 ? 0 : (br == 3 ? 2 : 1);
        const u32x4* gp = (const u32x4*)gateP + ((size_t)((u.pm * 16 + br * 4 + pn) * 8 + wv8) * 16) * 64 + ln;
        u32x4* mp = (u32x4*)mbP + ((size_t)((u.pm * 4 + pn) * 8 + wv8) * 16) * 64 + ln;
        u32x4 gw[2][4][2];
#pragma unroll
        for (int ai = 0; ai < 2; ++ai)
#pragma unroll
            for (int m = 0; m < 4; ++m)
#pragma unroll
                for (int bj = 0; bj < 2; ++bj) gw[ai][m][bj] = gp[((ai * 4 + m) * 2 + bj) * 64];
        asm volatile("" ::: "memory");
        f32x4 v[2][4][2][2];
#pragma unroll
        for (int ai = 0; ai < 2; ++ai)
#pragma unroll
            for (int m = 0; m < 4; ++m)
#pragma unroll
                for (int bj = 0; bj < 2; ++bj) { const u32x4 g = gw[ai][m][bj]; f32x4 g0, g1;
                    g0[0] = sigmoidf_(bflo(g.x)); g0[1] = sigmoidf_(bfhi(g.x)); g0[2] = sigmoidf_(bflo(g.y)); g0[3] = sigmoidf_(bfhi(g.y));
                    g1[0] = sigmoidf_(bflo(g.z)); g1[1] = sigmoidf_(bfhi(g.z)); g1[2] = sigmoidf_(bflo(g.w)); g1[3] = sigmoidf_(bfhi(g.w));
                    v[ai][m][bj][0] = acc[ai][bj][m][0] * g0; v[ai][m][bj][1] = acc[ai][bj][m][1] * g1; }
        if (MODE >= 1) {
#pragma unroll
            for (int ai = 0; ai < 2; ++ai)
#pragma unroll
                for (int m = 0; m < 4; ++m)
#pragma unroll
                    for (int bj = 0; bj < 2; ++bj) gw[ai][m][bj] = mp[((ai * 4 + m) * 2 + bj) * 64];
            asm volatile("" ::: "memory");
#pragma unroll
            for (int ai = 0; ai < 2; ++ai)
#pragma unroll
                for (int m = 0; m < 4; ++m)
#pragma unroll
                    for (int bj = 0; bj < 2; ++bj) { const u32x4 o = gw[ai][m][bj];
                        v[ai][m][bj][0][0] += bflo(o.x); v[ai][m][bj][0][1] += bfhi(o.x); v[ai][m][bj][0][2] += bflo(o.y); v[ai][m][bj][0][3] += bfhi(o.y);
                        v[ai][m][bj][1][0] += bflo(o.z); v[ai][m][bj][1][1] += bfhi(o.z); v[ai][m][bj][1][2] += bflo(o.w); v[ai][m][bj][1][3] += bfhi(o.w); }
        }
        if (MODE < 2) {
#pragma unroll
            for (int ai = 0; ai < 2; ++ai)
#pragma unroll
                for (int m = 0; m < 4; ++m)
#pragma unroll
                    for (int bj = 0; bj < 2; ++bj) { const f32x4 v0 = v[ai][m][bj][0], v1 = v[ai][m][bj][1];
                        u32x4 w; w.x = cvt_pk_bf16(v0[0], v0[1]); w.y = cvt_pk_bf16(v0[2], v0[3]); w.z = cvt_pk_bf16(v1[0], v1[1]); w.w = cvt_pk_bf16(v1[2], v1[3]);
                        mp[((ai * 4 + m) * 2 + bj) * 64] = w; }
        } else {
            ST_BLOCK_SETUP(st);
            bf16_t* op = mb + (size_t)(u.pm * 256 + wr * 64 + rrow) * DM + pn * 256 + wc * 64 + rp * 8;
#pragma unroll
            for (int ai = 0; ai < 2; ++ai)
#pragma unroll
                for (int m = 0; m < 4; ++m) { u32x4 wq[2];
#pragma unroll
                    for (int bj = 0; bj < 2; ++bj) { const f32x4 v0 = v[ai][m][bj][0], v1 = v[ai][m][bj][1];
                        wq[bj].x = cvt_pk_bf16(v0[0], v0[1]); wq[bj].y = cvt_pk_bf16(v0[2], v0[3]); wq[bj].z = cvt_pk_bf16(v1[0], v1[1]); wq[bj].w = cvt_pk_bf16(v1[2], v1[3]); }
                    st_block_bf16(sw, woff, roff, wq[0], wq[1], op + (size_t)(ai * 128 + m * 16) * DM, DM); }
        }
    }
};
struct EpiResid {
    static constexpr bool PERM = true, AFTER_DRAIN = false;
    const float* xf; float* o;
    __device__ __forceinline__ void operator()(const f32x4 (&acc)[2][2][4][2], const Unit& u, int wr, int wc, int fr, int fq) const {
        const int row0 = u.pm * 256 + wr * 64 + fr, col0 = u.pn * 256 + wc * 64 + 8 * fq;
#pragma unroll
        for (int ai = 0; ai < 2; ++ai) {
            f32x4 xv[4][2][2];
#pragma unroll
            for (int m = 0; m < 4; ++m)
#pragma unroll
                for (int bj = 0; bj < 2; ++bj) { const size_t off = (size_t)(row0 + ai * 128 + m * 16) * DM + col0 + bj * 32; xv[m][bj][0] = *(const f32x4*)(xf + off); xv[m][bj][1] = *(const f32x4*)(xf + off + 4); }
            asm volatile("" ::: "memory");
#pragma unroll
            for (int m = 0; m < 4; ++m)
#pragma unroll
                for (int bj = 0; bj < 2; ++bj) { const size_t off = (size_t)(row0 + ai * 128 + m * 16) * DM + col0 + bj * 32;
                    *(f32x4*)(o + off) = xv[m][bj][0] * DN_ALPHA + acc[ai][bj][m][0]; *(f32x4*)(o + off + 4) = xv[m][bj][1] * DN_ALPHA + acc[ai][bj][m][1]; }
            asm volatile("" ::: "memory");
        }
    }
};
constexpr float W8_SCALE = 64.0f, H8_SCALE = 16.0f;
constexpr int E8_ONE = 0x7F7F7F7F, E8_W = 0x79797979  , E8_H = 0x7B7B7B7B  ;
__device__ __forceinline__ unsigned pk_fp8x4(float a, float b, float c, float d) { int w = __builtin_amdgcn_cvt_pk_fp8_f32(a, b, 0, false); w = __builtin_amdgcn_cvt_pk_fp8_f32(c, d, w, true); return (unsigned)w; }
struct EpiSwiGLU {
    static constexpr bool PERM = true, AFTER_DRAIN = false;
    unsigned char* H;
    __device__ __forceinline__ void operator()(const f32x4 (&acc)[2][2][4][2], const Unit& u, int wr, int wc, int fr, int fq) const {
        const int row0 = u.pm * 256 + wr * 64 + fr, col0 = (u.pn & 15) * 128 + wc * 32 + 8 * fq;
#pragma unroll
        for (int ai = 0; ai < 2; ++ai)
#pragma unroll
            for (int m = 0; m < 4; ++m) { unsigned char* rowp = H + (size_t)(row0 + ai * 128 + m * 16) * DEXP + col0;
                f32x4 v[2];
#pragma unroll
                for (int n = 0; n < 2; ++n)
#pragma unroll
                    for (int j = 0; j < 4; ++j) { const float g = acc[ai][0][m][n][j], up = acc[ai][1][m][n][j]; v[n][j] = g * sigmoidf_(g) * up * H8_SCALE; }
                u32x2 w; w.x = pk_fp8x4(v[0][0], v[0][1], v[0][2], v[0][3]); w.y = pk_fp8x4(v[1][0], v[1][1], v[1][2], v[1][3]);
                *(u32x2*)rowp = w; }
    }
};
struct EpiDown {
    static constexpr bool PERM = true, AFTER_DRAIN = false;
    bf16_t* Y; const float* grow;
    __device__ __forceinline__ void operator()(const f32x4 (&acc)[2][2][4][2], const Unit& u, int wr, int wc, int fr, int fq) const {
        const int row0 = u.pm * 256 + wr * 64 + fr, col0 = (u.pn & 3) * 256 + wc * 64 + 8 * fq;
        float gr[2][4];
#pragma unroll
        for (int ai = 0; ai < 2; ++ai)
#pragma unroll
            for (int m = 0; m < 4; ++m) gr[ai][m] = grow[row0 + ai * 128 + m * 16];
#pragma unroll
        for (int ai = 0; ai < 2; ++ai)
#pragma unroll
            for (int m = 0; m < 4; ++m) { const int row = row0 + ai * 128 + m * 16; const float g = gr[ai][m]; bf16_t* rowp = Y + (size_t)row * DM + col0;
#pragma unroll
                for (int bj = 0; bj < 2; ++bj) { const f32x4 v0 = acc[ai][bj][m][0] * g, v1 = acc[ai][bj][m][1] * g;
                    u32x4 w; w.x = cvt_pk_bf16(v0[0], v0[1]); w.y = cvt_pk_bf16(v0[2], v0[3]); w.z = cvt_pk_bf16(v1[0], v1[1]); w.w = cvt_pk_bf16(v1[2], v1[3]);
                    *(u32x4*)(rowp + bj * 32) = w; } }
    }
};

__device__ __forceinline__ int wcont_row(int gn) { return (gn & ~255) | (((gn >> 5) & 1) << 7) | (((gn >> 6) & 3) << 5) | (gn & 31); }
__device__ __forceinline__ void tconv(const float* __restrict__ src, int nb, int K, int N, bf16_t* __restrict__ dst, size_t dst_bs, int ldd, int blk, int bstride, int boff, float* tile, int wv) {
    const int tid = otid(wv), ntn = N >> 8, tpb = (K >> 6) * ntn, nt = nb * tpb;
    f32x4 v[8];
#define TC_LOAD(t_) do { const int bi_ = (t_) / tpb, tr_ = (t_) % tpb, k0_ = (tr_ / ntn) * 64, n0_ = (tr_ % ntn) * 256; const float* sb_ = src + (size_t)bi_ * K * N; \
        _Pragma("unroll") for (int i = 0; i < 8; ++i) { const int kk = i * 8 + (tid >> 6), nn = (tid & 63) * 4; v[i] = *(const f32x4*)(sb_ + (size_t)(k0_ + kk) * N + n0_ + nn); } } while (0)
    int t = blockIdx.x;
    if (t < nt) TC_LOAD(t);
    for (; t < nt; t += gridDim.x) {
        const int bi = t / tpb, tr = t % tpb, k0 = (tr / ntn) * 64, n0 = (tr % ntn) * 256;
#pragma unroll
        for (int i = 0; i < 8; ++i) { const int kk = i * 8 + (tid >> 6), nn = (tid & 63) * 4; float* tp = tile + kk * 257 + nn; tp[0] = v[i][0]; tp[1] = v[i][1]; tp[2] = v[i][2]; tp[3] = v[i][3]; }
        __syncthreads();
        if (t + (int)gridDim.x < nt) TC_LOAD(t + (int)gridDim.x);
        bf16_t* db = dst + (size_t)bi * dst_bs;
#pragma unroll
        for (int j = 0; j < 4; ++j) { const int q = tid + 512 * j, n = q >> 3, kc = q & 7; const float* s = tile + (kc * 8) * 257 + n;
            u32x4 o; o.x = cvt_pk_bf16(s[0], s[257]); o.y = cvt_pk_bf16(s[2 * 257], s[3 * 257]); o.z = cvt_pk_bf16(s[4 * 257], s[5 * 257]); o.w = cvt_pk_bf16(s[6 * 257], s[7 * 257]);
            const int gn = n0 + n, drow = blk == (1 << 30) ? wcont_row(gn) : (gn / blk) * bstride + boff + (gn % blk);
            *(u32x4*)(db + (size_t)drow * ldd + k0 + kc * 8) = o; }
        __syncthreads();
    }
#undef TC_LOAD
}
__device__ __forceinline__ void tconv8(const float* __restrict__ src, int nb, int K, int N, unsigned char* __restrict__ dst, size_t dst_bs, int ldd, int blk, int bstride, int boff, float sc, float* tile, int wv) {
    const int tid = otid(wv), ntn = N >> 7, tpb = (K >> 7) * ntn, nt = nb * tpb;
    f32x4 v[8];
#define TC_LOAD(t_) do { const int bi_ = (t_) / tpb, tr_ = (t_) % tpb, k0_ = (tr_ / ntn) * 128, n0_ = (tr_ % ntn) * 128; const float* sb_ = src + (size_t)bi_ * K * N; \
        _Pragma("unroll") for (int i = 0; i < 8; ++i) { const int kk = i * 16 + (tid >> 5), nn = (tid & 31) * 4; v[i] = *(const f32x4*)(sb_ + (size_t)(k0_ + kk) * N + n0_ + nn); } } while (0)
    int t = blockIdx.x;
    if (t < nt) TC_LOAD(t);
    for (; t < nt; t += gridDim.x) {
        const int bi = t / tpb, tr = t % tpb, k0 = (tr / ntn) * 128, n0 = (tr % ntn) * 128;
#pragma unroll
        for (int i = 0; i < 8; ++i) { const int kk = i * 16 + (tid >> 5), nn = (tid & 31) * 4; float* tp = tile + kk * 129 + nn; tp[0] = v[i][0]; tp[1] = v[i][1]; tp[2] = v[i][2]; tp[3] = v[i][3]; }
        __syncthreads();
        if (t + (int)gridDim.x < nt) TC_LOAD(t + (int)gridDim.x);
        unsigned char* db = dst + (size_t)bi * dst_bs;
#pragma unroll
        for (int j = 0; j < 2; ++j) { const int q = tid + 512 * j, n = q >> 3, kc = q & 7; const float* s = tile + (kc * 16) * 129 + n;
            u32x4 o;
            o.x = pk_fp8x4(s[0] * sc, s[129] * sc, s[2 * 129] * sc, s[3 * 129] * sc); o.y = pk_fp8x4(s[4 * 129] * sc, s[5 * 129] * sc, s[6 * 129] * sc, s[7 * 129] * sc);
            o.z = pk_fp8x4(s[8 * 129] * sc, s[9 * 129] * sc, s[10 * 129] * sc, s[11 * 129] * sc); o.w = pk_fp8x4(s[12 * 129] * sc, s[13 * 129] * sc, s[14 * 129] * sc, s[15 * 129] * sc);
            const int gn = n0 + n, drow = blk == (1 << 30) ? wcont_row(gn) : (gn / blk) * bstride + boff + (gn % blk);
            *(u32x4*)(db + (size_t)drow * ldd + k0 + kc * 16) = o; }
        __syncthreads();
    }
#undef TC_LOAD
}

__device__ __forceinline__ void phase_convert(const Params& P, float* ldsf) {
    unsigned char* ws = kws();
    const int NOBLK = 1 << 30;
    tconv(kin(I_WIN), DEPTH, DM, INC, (bf16_t*)(ws + WS_WIN), (size_t)INC * DM, DM, NOBLK, 0, 0, ldsf, P.pad0);
    tconv(kin(I_WBR), DEPTH, BRK, DM, (bf16_t*)(ws + WS_WBR), (size_t)DM * BRK, BRK, NOBLK, 0, 0, ldsf, P.pad0);
    tconv(kin(I_WOUT), DEPTH, DM, DM, (bf16_t*)(ws + WS_WOUT), (size_t)DM * DM, DM, NOBLK, 0, 0, ldsf, P.pad0);
    tconv(kin(I_WKV), DEPTH, DM, 512, (bf16_t*)(ws + WS_WKV), (size_t)512 * DM, DM, NOBLK, 0, 0, ldsf, P.pad0);
    tconv8(kin(I_EWG), DEPTH * NEXP, DM, DEXP, ws + WS_WGU, (size_t)4096 * DM, DM, 128, 256, 0, W8_SCALE, ldsf, P.pad0);
    tconv8(kin(I_EWU), DEPTH * NEXP, DM, DEXP, ws + WS_WGU, (size_t)4096 * DM, DM, 128, 256, 128, W8_SCALE, ldsf, P.pad0);
    tconv8(kin(I_EWD), DEPTH * NEXP, DEXP, DM, ws + WS_WDN, (size_t)DM * DEXP, DEXP, NOBLK, 0, 0, W8_SCALE, ldsf, P.pad0);
    for (int l = 0; l < DEPTH; ++l) {
        bf16_t* wl = (bf16_t*)(ws + WS_WLORA) + (size_t)l * LORA_N * 256;
        tconv(kin(I_WUP) + (size_t)l * 2 * 64 * 1024, 2, 64, 1024, wl, (size_t)1024 * 256, 256, NOBLK, 0, 0, ldsf, P.pad0);
        tconv(kin(I_AUP) + (size_t)l * 2 * 64 * 1024, 2, 64, 1024, wl + (size_t)2048 * 256 + 64, (size_t)1024 * 256, 256, NOBLK, 0, 0, ldsf, P.pad0);
        tconv(kin(I_GUP) + (size_t)l * 128 * 1024, 1, 128, 1024, wl + (size_t)4096 * 256 + 128, 0, 256, NOBLK, 0, 0, ldsf, P.pad0);
    }
    const size_t gtid = (size_t)blockIdx.x * NTHR + otid(P.pad0), gsz = (size_t)gridDim.x * NTHR;
    { u32x4* wl4 = (u32x4*)(ws + WS_WLORA); const u32x4 zz = {0u, 0u, 0u, 0u};
      for (size_t i = gtid; i < (size_t)DEPTH * LORA_N * 32; i += gsz) { const int k8 = (int)(i & 31), n = (int)((i >> 5) % LORA_N);
          const bool blockpart = n < 2048 ? (k8 < 8) : (n < 4096 ? (k8 >= 8 && k8 < 16) : (k8 >= 16));
          if (!blockpart) wl4[i] = zz; } }
    { const f32x4* x4 = (const f32x4*)kin(I_X); f32x4* xf4 = (f32x4*)(ws + WS_XF); u32x2* xb2 = (u32x2*)(ws + WS_XB);
      for (size_t i0 = gtid; i0 < (size_t)NTOK * DM / 4; i0 += gsz * 8) { f32x4 v[8];
#pragma unroll
          for (int q = 0; q < 8; ++q) { const size_t i = i0 + q * gsz; v[q] = i < (size_t)NTOK * DM / 4 ? x4[i] : (f32x4){0.f, 0.f, 0.f, 0.f}; }
#pragma unroll
          for (int q = 0; q < 8; ++q) { const size_t i = i0 + q * gsz; if (i < (size_t)NTOK * DM / 4) { xf4[i] = v[q]; u32x2 w; w.x = cvt_pk_bf16(v[q][0], v[q][1]); w.y = cvt_pk_bf16(v[q][2], v[q][3]); xb2[i] = w; } } } }
    { const f32x4* m4 = (const f32x4*)kin(I_MEM); u32x2* mb2 = (u32x2*)(ws + WS_MEMB);
      for (size_t i = gtid; i < (size_t)NBATCH * NMEM * DM / 4; i += gsz) { const f32x4 v = m4[i]; u32x2 w; w.x = cvt_pk_bf16(v[0], v[1]); w.y = cvt_pk_bf16(v[2], v[3]); mb2[i] = w; } }
}

__device__ __forceinline__ void phase_prepass(const Params& P, int l) {
    const bf16_t* p = (const bf16_t*)(kws() + WS_P); bf16_t* ap = (bf16_t*)(kws() + WS_APR);
    const float* mu = kin(I_MU) + (size_t)l * 2 * RWC;
    const int gtid = blockIdx.x * NTHR + otid(P.pad0), gsz = gridDim.x * NTHR;
    const int jg = gtid & 63, col = C_DW + jg * 4;
    const f32x4 m0 = *(const f32x4*)(mu + col), m1 = *(const f32x4*)(mu + RWC + col);
    for (int t0 = gtid >> 6; t0 < NTOK; t0 += (gsz >> 6) * 4) {
        u32x2 xc[4], xp[4], xn[4];
#pragma unroll
        for (int q = 0; q < 4; ++q) { const int tok = t0 + q * (gsz >> 6); const int tk = tok < NTOK ? tok : 0; const int s = tk & (SEQ - 1); const bf16_t* pr = p + (size_t)tk * INC + col; const u32x2 zz = {0u, 0u};
            xc[q] = *(const u32x2*)pr; xp[q] = s > 0 ? *(const u32x2*)(pr - INC) : zz; xn[q] = s < SEQ - 1 ? *(const u32x2*)(pr + INC) : zz; }
#pragma unroll
        for (int q = 0; q < 4; ++q) { const int tok = t0 + q * (gsz >> 6);
            f32x4 x, a, b;
            x[0] = bflo(xc[q].x); x[1] = bfhi(xc[q].x); x[2] = bflo(xc[q].y); x[3] = bfhi(xc[q].y);
            a[0] = bflo(xp[q].x); a[1] = bfhi(xp[q].x); a[2] = bflo(xp[q].y); a[3] = bfhi(xp[q].y);
            b[0] = bflo(xn[q].x); b[1] = bfhi(xn[q].x); b[2] = bflo(xn[q].y); b[3] = bfhi(xn[q].y);
            f32x4 v = x + m0 * (a - x) + m1 * (b - x);
            if (jg < 16) {
#pragma unroll
                for (int j = 0; j < 4; ++j) v[j] = 1.0f - 2.0f * __builtin_amdgcn_rcpf(1.0f + __expf(2.0f * v[j]));
            } else if (jg >= 32) {
#pragma unroll
                for (int j = 0; j < 4; ++j) v[j] = sigmoidf_(v[j]);
            }
            if (tok < NTOK) { typedef __bf16 bf4_ __attribute__((ext_vector_type(4)));
                *(bf4_*)(ap + (size_t)tok * 256 + jg * 4) = __builtin_convertvector(v, bf4_); } }
    }
}

__device__ __forceinline__ void phase_post(const Params& P, int l) {
    const bf16_t* p = (const bf16_t*)(kws() + WS_P); const bf16_t* lora = (const bf16_t*)(kws() + WS_LORA);
    const bf16_t* ydir = (const bf16_t*)(kws() + WS_YDIR); const float* bonus = (const float*)(kws() + WS_BONUS);
    bf16_t* ycat = (bf16_t*)(kws() + WS_YCAT);
    const int tid = otid(P.pad0), lane = tid & 63, wid = tid >> 6;
    const float* mu = kin(I_MU) + (size_t)l * 2 * RWC;
    const int gw = blockIdx.x * 8 + wid, ngw = gridDim.x * 8;
    { const int hg = gw & 3, c4 = hg * 256 + lane * 4, h = hg * 4 + (lane >> 4);
      const f32x4 gng = *(const f32x4*)(kin(I_GNG) + l * 1024 + c4), gnb = *(const f32x4*)(kin(I_GNB) + l * 1024 + c4);
      const f32x4 mu0 = *(const f32x4*)(mu + C_V + c4), mu1 = *(const f32x4*)(mu + RWC + C_V + c4);
      for (int t0 = gw >> 2; t0 < NTOK; t0 += (ngw >> 2) * 4) {
          f32x4 y[4]; u32x2 vc[4], vp[4], vn[4], gg[4]; float bon[4]; bool ok[4];
#pragma unroll
          for (int q = 0; q < 4; ++q) { const int tok = t0 + q * (ngw >> 2); ok[q] = tok < NTOK; const int tk = ok[q] ? tok : 0; const int s = tk & (SEQ - 1);
              { const u32x2 y0 = *(const u32x2*)(ydir + (size_t)tk * DM + c4), y1 = *(const u32x2*)(ydir + ((size_t)NTOK + tk) * DM + c4);
                y[q][0] = bflo(y0.x) + bflo(y1.x); y[q][1] = bfhi(y0.x) + bfhi(y1.x); y[q][2] = bflo(y0.y) + bflo(y1.y); y[q][3] = bfhi(y0.y) + bfhi(y1.y); }
              const bf16_t* pv = p + (size_t)tk * INC + C_V + c4; const u32x2 zz = {0u, 0u};
              vc[q] = *(const u32x2*)pv; vp[q] = s > 0 ? *(const u32x2*)(pv - INC) : zz; vn[q] = s < SEQ - 1 ? *(const u32x2*)(pv + INC) : zz;
              gg[q] = *(const u32x2*)(lora + (size_t)tk * LORA_N + 4096 + c4);
              bon[q] = bonus[(size_t)tk * 16 + h] + bonus[((size_t)NTOK + tk) * 16 + h]; }
#pragma unroll
          for (int q = 0; q < 4; ++q) { const int tok = t0 + q * (ngw >> 2);
              const float mean = sum16((y[q][0] + y[q][1]) + (y[q][2] + y[q][3])) * (1.0f / 64.0f); const f32x4 dy = y[q] - mean;
              const float var = sum16((dy[0] * dy[0] + dy[1] * dy[1]) + (dy[2] * dy[2] + dy[3] * dy[3])) * (1.0f / 64.0f);
              const f32x4 yn = dy * rsqrtf(var + 64e-5f) * gng + gnb;
              f32x4 v, vpv, vnx, g;
              v[0] = bflo(vc[q].x); v[1] = bfhi(vc[q].x); v[2] = bflo(vc[q].y); v[3] = bfhi(vc[q].y);
              vpv[0] = bflo(vp[q].x); vpv[1] = bfhi(vp[q].x); vpv[2] = bflo(vp[q].y); vpv[3] = bfhi(vp[q].y);
              vnx[0] = bflo(vn[q].x); vnx[1] = bfhi(vn[q].x); vnx[2] = bflo(vn[q].y); vnx[3] = bfhi(vn[q].y);
              g[0] = bflo(gg[q].x); g[1] = bfhi(gg[q].x); g[2] = bflo(gg[q].y); g[3] = bfhi(gg[q].y);
              const f32x4 vs = v + mu0 * (vpv - v) + mu1 * (vnx - v);
              const f32x4 o = (yn + vs * bon[q]) * g;
              if (ok[q]) { u32x2 w; w.x = cvt_pk_bf16(o[0], o[1]); w.y = cvt_pk_bf16(o[2], o[3]); *(u32x2*)(ycat + (size_t)tok * BRK + c4) = w; } }
      } }
}

__device__ __forceinline__ void phase_ln1(const Params& P, int l, float* ldsf) {
    const float* pre = (const float*)(kws() + WS_PRELN); float* xf = (float*)(kws() + WS_XF); bf16_t* xb = (bf16_t*)(kws() + WS_XB); float* aff = (float*)(kws() + WS_AFF);
    const float* g = kin(I_LN1G) + l * DM; const float* bt = kin(I_LN1B) + l * DM; const float* router = kin(I_ROUTER) + (size_t)l * DM * 16;
    const int tid = otid(P.pad0), lane = tid & 63, wid = tid >> 6;
    { f32x4 tmp[8];
#pragma unroll
      for (int k8 = 0; k8 < 8; ++k8) tmp[k8] = ((const f32x4*)router)[tid + k8 * NTHR];
#pragma unroll
      for (int k8 = 0; k8 < 8; ++k8) { const int i = tid + k8 * NTHR, d = i >> 2, e0 = (i & 3) * 4; ldsf[(e0 + 0) * DM + d] = tmp[k8][0]; ldsf[(e0 + 1) * DM + d] = tmp[k8][1]; ldsf[(e0 + 2) * DM + d] = tmp[k8][2]; ldsf[(e0 + 3) * DM + d] = tmp[k8][3]; } }
    __syncthreads();
    f32x4 gv[4], bv[4];
#pragma unroll
    for (int i = 0; i < 4; ++i) { gv[i] = *(const f32x4*)(g + lane * 4 + 256 * i); bv[i] = *(const f32x4*)(bt + lane * 4 + 256 * i); }
    const int row_first = blockIdx.x * 8 + wid, row_step = gridDim.x * 8;
    f32x4 vnx[4];
    if (row_first < NTOK) {
#pragma unroll
        for (int i = 0; i < 4; ++i) vnx[i] = *(const f32x4*)(pre + (size_t)row_first * DM + lane * 4 + 256 * i);
    }
    for (int row = row_first; row < NTOK; row += row_step) {
        f32x4 v[4]; float s = 0.f;
#pragma unroll
        for (int i = 0; i < 4; ++i) { v[i] = vnx[i]; s += (v[i][0] + v[i][1]) + (v[i][2] + v[i][3]); }
        if (row + row_step < NTOK) {
#pragma unroll
            for (int i = 0; i < 4; ++i) vnx[i] = *(const f32x4*)(pre + (size_t)(row + row_step) * DM + lane * 4 + 256 * i);
        }
        const float mean = wave_sum(s) * (1.0f / DM); float s2 = 0.f;
#pragma unroll
        for (int i = 0; i < 4; ++i) { v[i] = v[i] - mean; s2 += (v[i][0] * v[i][0] + v[i][1] * v[i][1]) + (v[i][2] * v[i][2] + v[i][3] * v[i][3]); }
        const float rstd = rsqrtf(wave_sum(s2) * (1.0f / DM) + 1e-5f);
        float lg[16];
#pragma unroll
        for (int e = 0; e < 16; ++e) lg[e] = 0.f;
#pragma unroll
        for (int i = 0; i < 4; ++i) { v[i] = v[i] * rstd * gv[i] + bv[i];
            *(f32x4*)(xf + (size_t)row * DM + lane * 4 + 256 * i) = v[i];
            u32x2 w; w.x = cvt_pk_bf16(v[i][0], v[i][1]); w.y = cvt_pk_bf16(v[i][2], v[i][3]); *(u32x2*)(xb + (size_t)row * DM + lane * 4 + 256 * i) = w;
#pragma unroll
            for (int e = 0; e < 16; ++e) { const f32x4 r = *(const f32x4*)(ldsf + e * DM + lane * 4 + 256 * i); lg[e] += (v[i][0] * r[0] + v[i][1] * r[1]) + (v[i][2] * r[2] + v[i][3] * r[3]); } }
        const int lid = lane_id();
#define LN_HALVE(M, H) do { const bool up_ = (lid & (M)) != 0; _Pragma("unroll") for (int j = 0; j < (H); ++j) { const float send_ = up_ ? lg[j] : lg[j + (H)], keep_ = up_ ? lg[j + (H)] : lg[j]; \
            lg[j] = keep_ + __builtin_bit_cast(float, __builtin_amdgcn_ds_bpermute((lid ^ (M)) << 2, __builtin_bit_cast(int, send_))); } } while (0)
        LN_HALVE(32, 8); LN_HALVE(16, 4); LN_HALVE(8, 2); LN_HALVE(4, 1);
#undef LN_HALVE
        float tot = lg[0];
        tot += __builtin_bit_cast(float, __builtin_amdgcn_ds_bpermute((lid ^ 2) << 2, __builtin_bit_cast(int, tot)));
        tot += __builtin_bit_cast(float, __builtin_amdgcn_ds_bpermute((lid ^ 1) << 2, __builtin_bit_cast(int, tot)));
        float mx = tot;
#pragma unroll
        for (int M = 4; M < 64; M <<= 1) mx = fmaxf(mx, __builtin_bit_cast(float, __builtin_amdgcn_ds_bpermute((lid ^ M) << 2, __builtin_bit_cast(int, mx))));
        const float ex = expf(tot - mx); float se = ex;
#pragma unroll
        for (int M = 4; M < 64; M <<= 1) se += __builtin_bit_cast(float, __builtin_amdgcn_ds_bpermute((lid ^ M) << 2, __builtin_bit_cast(int, se)));
        const int eidx = ((lid >> 5) & 1) * 8 + ((lid >> 4) & 1) * 4 + ((lid >> 3) & 1) * 2 + ((lid >> 2) & 1);
        if ((lid & 3) == 0) aff[(size_t)row * 16 + eidx] = ex / se;
    }
    __syncthreads();
}
__device__ __forceinline__ void phase_ln2(const Params& P, int l) {
    float* xf = (float*)(kws() + WS_XF); bf16_t* xb = (bf16_t*)(kws() + WS_XB); const bf16_t* ye = (const bf16_t*)(kws() + WS_YE); const int* slot_of = (const int*)(kws() + WS_SLOT);
    const float* g = kin(I_LN2G) + l * DM; const float* bt = kin(I_LN2B) + l * DM;
    float* dst = (l == DEPTH - 1) ? kout() : xf;
    const int tid = otid(P.pad0), lane = tid & 63, wid = __builtin_amdgcn_readfirstlane(tid >> 6);
    f32x4 gv[4], bv[4];
#pragma unroll
    for (int i = 0; i < 4; ++i) { gv[i] = *(const f32x4*)(g + lane * 4 + 256 * i); bv[i] = *(const f32x4*)(bt + lane * 4 + 256 * i); }
    const int gw = blockIdx.x * 8 + wid, ngw = gridDim.x * 8;
    for (int r0 = gw; r0 < NTOK; r0 += 4 * ngw) {
        const int rk = r0 + (lane >> 4) * ngw; const int slv = rk < NTOK ? slot_of[(size_t)rk * 16 + (lane & 15)] : -1;
        const unsigned long long m64 = __ballot(slv >= 0);
#pragma unroll
        for (int pr = 0; pr < 2; ++pr) {
            f32x4 v[2][4]; u32x2 tmp[2][4][4]; int nv[2]; bool ok[2];
#pragma unroll
            for (int q = 0; q < 2; ++q) { const int k = pr * 2 + q; const int row = r0 + k * ngw; ok[q] = row < NTOK; const int rw = ok[q] ? row : 0; const int b = rw >> 11;
#pragma unroll
                for (int i = 0; i < 4; ++i) v[q][i] = *(const f32x4*)(xf + (size_t)rw * DM + lane * 4 + 256 * i);
                unsigned bits = ok[q] ? (unsigned)((m64 >> (16 * k)) & 0xFFFFull) : 0u; nv[q] = 0;
#pragma unroll
                for (int j = 0; j < 4; ++j) { if (bits) { const int e = __builtin_ctz(bits); bits &= bits - 1; const int sl = __builtin_amdgcn_readlane(slv, 16 * k + e);
                        const bf16_t* yr = ye + ((size_t)(e * 8 + b) * 256 + sl) * DM + lane * 4;
#pragma unroll
                        for (int i = 0; i < 4; ++i) tmp[q][j][i] = *(const u32x2*)(yr + 256 * i);
                        nv[q] = j + 1; } }
#pragma unroll
                for (int i = 0; i < 4; ++i) v[q][i] = v[q][i] * DN_ALPHA;
#pragma unroll
                for (int j = 0; j < 4; ++j) if (j < nv[q]) {
#pragma unroll
                    for (int i = 0; i < 4; ++i) { const u32x2 w = tmp[q][j][i]; v[q][i][0] += bflo(w.x); v[q][i][1] += bfhi(w.x); v[q][i][2] += bflo(w.y); v[q][i][3] += bfhi(w.y); } }
                while (bits) { const int e = __builtin_ctz(bits); bits &= bits - 1; const int sl = __builtin_amdgcn_readlane(slv, 16 * k + e);
                    const bf16_t* yr = ye + ((size_t)(e * 8 + b) * 256 + sl) * DM + lane * 4;
#pragma unroll
                    for (int i = 0; i < 4; ++i) { const u32x2 w = *(const u32x2*)(yr + 256 * i); v[q][i][0] += bflo(w.x); v[q][i][1] += bfhi(w.x); v[q][i][2] += bflo(w.y); v[q][i][3] += bfhi(w.y); } }
            }
#pragma unroll
            for (int q = 0; q < 2; ++q) { const int row = r0 + (pr * 2 + q) * ngw;
                float s = 0.f;
#pragma unroll
                for (int i = 0; i < 4; ++i) s += (v[q][i][0] + v[q][i][1]) + (v[q][i][2] + v[q][i][3]);
                const float mean = wave_sum(s) * (1.0f / DM); float s2 = 0.f;
#pragma unroll
                for (int i = 0; i < 4; ++i) { v[q][i] = v[q][i] - mean; s2 += (v[q][i][0] * v[q][i][0] + v[q][i][1] * v[q][i][1]) + (v[q][i][2] * v[q][i][2] + v[q][i][3] * v[q][i][3]); }
                const float rstd = rsqrtf(wave_sum(s2) * (1.0f / DM) + 1e-5f);
                if (ok[q]) {
#pragma unroll
                    for (int i = 0; i < 4; ++i) { const f32x4 o = v[q][i] * rstd * gv[i] + bv[i];
                        *(f32x4*)(dst + (size_t)row * DM + lane * 4 + 256 * i) = o;
                        if (l < DEPTH - 1) { u32x2 w; w.x = cvt_pk_bf16(o[0], o[1]); w.y = cvt_pk_bf16(o[2], o[3]); *(u32x2*)(xb + (size_t)row * DM + lane * 4 + 256 * i) = w; } } }
            }
        }
    }
}

__device__ __forceinline__ void phase_topk(const Params& P, unsigned long long* keys  ) {
    const float* aff = (const float*)(kws() + WS_AFF); float* grow = (float*)(kws() + WS_GROW); int* slot_of = (int*)(kws() + WS_SLOT);
    const bf16_t* xb = (const bf16_t*)(kws() + WS_XB); unsigned char* xe = kws() + WS_XE;
    const int tid = otid(P.pad0);
    for (int u = blockIdx.x; u < NBATCH * NEXP; u += gridDim.x) {
        const int b = u >> 4, e = u & 15;
#pragma unroll
        for (int j = 0; j < 4; ++j) { const int i = tid + 512 * j; const float v = aff[((size_t)b * SEQ + i) * 16 + e];
            keys[i] = ((unsigned long long)__float_as_uint(v) << 32) | (unsigned long long)(0xFFFFFFFFu - (unsigned)i); }
        __syncthreads();
        { const int wv_ = tid >> 6, ln_ = tid & 63;
          for (int k = 2; k <= SEQ; k <<= 1)
            for (int j = k >> 1; j > 0; j >>= 1) {
                if (j >= 256) __syncthreads();
#pragma unroll
                for (int t2 = 0; t2 < 2; ++t2) { const int t = wv_ * 128 + ln_ + 64 * t2; const int i = ((t & ~(j - 1)) << 1) | (t & (j - 1)), ixj = i | j;
                    const unsigned long long a = keys[i], c = keys[ixj]; const bool desc = (i & k) == 0;
                    if (desc ? (a < c) : (a > c)) { keys[i] = c; keys[ixj] = a; } }
                if (j >= 256) __syncthreads();
                else asm volatile("s_waitcnt lgkmcnt(0)" ::: "memory");
            }
          __syncthreads(); }
#pragma unroll
        for (int j = 0; j < 4; ++j) { const int r = tid + 512 * j; const unsigned long long kk = keys[r]; const int tl = (int)(0xFFFFFFFFu - (unsigned)(kk & 0xFFFFFFFFull));
            slot_of[((size_t)b * SEQ + tl) * 16 + e] = r < CAP ? r : -1;
            if (r < CAP) grow[(e * 8 + b) * CAP + r] = __uint_as_float((unsigned)(kk >> 32)); }
        for (int q0 = tid; q0 < CAP * 64; q0 += NTHR * 16) { u32x4 tmp[16][2];
#pragma unroll
            for (int k8 = 0; k8 < 16; ++k8) { const int q = q0 + k8 * NTHR, r = q >> 6, ch = q & 63; const int tl = (int)(0xFFFFFFFFu - (unsigned)(keys[r] & 0xFFFFFFFFull));
                const bf16_t* sp = xb + ((size_t)b * SEQ + tl) * DM + ch * 16; tmp[k8][0] = *(const u32x4*)sp; tmp[k8][1] = *(const u32x4*)(sp + 8); }
#pragma unroll
            for (int k8 = 0; k8 < 16; ++k8) { const int q = q0 + k8 * NTHR, r = q >> 6, ch = q & 63; u32x4 o;
#define BLO(w_) __uint_as_float((w_) << 16)
#define BHI(w_) __uint_as_float((w_) & 0xFFFF0000u)
                o.x = pk_fp8x4(BLO(tmp[k8][0].x), BHI(tmp[k8][0].x), BLO(tmp[k8][0].y), BHI(tmp[k8][0].y)); o.y = pk_fp8x4(BLO(tmp[k8][0].z), BHI(tmp[k8][0].z), BLO(tmp[k8][0].w), BHI(tmp[k8][0].w));
                o.z = pk_fp8x4(BLO(tmp[k8][1].x), BHI(tmp[k8][1].x), BLO(tmp[k8][1].y), BHI(tmp[k8][1].y)); o.w = pk_fp8x4(BLO(tmp[k8][1].z), BHI(tmp[k8][1].z), BLO(tmp[k8][1].w), BHI(tmp[k8][1].w));
#undef BLO
#undef BHI
                *(u32x4*)(xe + ((size_t)(e * 8 + b) * CAP + r) * DM + ch * 16) = o; } }
        __syncthreads();
    }
}

typedef float f32x16 __attribute__((ext_vector_type(16)));
__device__ __forceinline__ float xmax32(float v) { float a = v, b = v; asm volatile("s_nop 1\n\tv_permlane32_swap_b32 %0, %1\n\ts_nop 1" : "+v"(a), "+v"(b)); return fmaxf(fmaxf(v, a), b); }
typedef short bf16x8s __attribute__((ext_vector_type(8)));
typedef short s16x4 __attribute__((ext_vector_type(4)));
typedef __bf16 bfv8 __attribute__((ext_vector_type(8)));
typedef float fv8 __attribute__((ext_vector_type(8)));
constexpr int FA_KB = 8192;
constexpr float LOG2E = 1.4426950408889634f;
constexpr int FA_TP = 96, FA_TS = 452;
constexpr int FA_OFF_Q = 3 * 8192 + 2 * 64 * (128 * 2 + 64) + 24 * FA_TS * 4;
constexpr float FA_THR = 8.0f;

template <int DV, int MODE>
__device__ __forceinline__ void fa_core(LAS unsigned char* lds, int tid, const bf16_t* qrow  , const bf16_t* kbase, const bf16_t* vbase, size_t ldk,
                                        int tile0, int ntiles, int qw, int qi, const LAS float* btab, f32x16 (&o)[DV / 32], float& m, float& lsum) {
    constexpr int RSV = DV * 2 + 64;
    constexpr int VB = 64 * RSV;
    constexpr int NDB = DV / 32;
    constexpr int NVC = DV / 64;
    constexpr int OFF_K = 0, OFF_V = 3 * FA_KB;
    const int lane = tid & 63, r = lane & 31, hh = lane >> 5, wid = __builtin_amdgcn_readfirstlane(tid >> 6);
    LAS unsigned char* qlds = lds + FA_OFF_Q + wid * 4096 + lane * 16;
#pragma unroll
    for (int s = 0; s < 4; ++s) *(LAS bf16x8s*)(qlds + s * 1024) = *(const bf16x8s*)(qrow + 16 * s + 8 * hh);
    constexpr float c1 = 0.125f * LOG2E;
    const int krow = tid >> 3, kch = tid & 7;
    const unsigned kst = (unsigned)(krow * 128 + ((kch ^ ((krow >> 1) & 7)) * 16));
    u32x4 kreg; u32x4 vreg[NVC];
#define FA_LOADK(t) do { kreg = *(const u32x4*)(kbase + ((size_t)(t) * 64 + krow) * ldk + kch * 8); } while (0)
#define FA_LOADV(t) do { _Pragma("unroll") for (int i_ = 0; i_ < NVC; ++i_) { const int c_ = tid + 512 * i_; const int vr_ = c_ / (DV / 8), vc_ = c_ % (DV / 8); vreg[i_] = *(const u32x4*)(vbase + ((size_t)(t) * 64 + vr_) * ldk + vc_ * 8); } } while (0)
#define FA_STOREK(buf) do { *(LAS u32x4*)(lds + OFF_K + (buf) * FA_KB + kst) = kreg; } while (0)
#define FA_STOREV(buf) do { _Pragma("unroll") for (int i_ = 0; i_ < NVC; ++i_) { const int c_ = tid + 512 * i_; const int vr_ = c_ / (DV / 8), vc_ = c_ % (DV / 8); *(LAS u32x4*)(lds + OFF_V + (buf) * VB + vr_ * RSV + vc_ * 16) = vreg[i_]; } } while (0)
    const unsigned kread = (unsigned)(r * 128);
    const int ksw = (r >> 1) & 7;
    const unsigned vread = (unsigned)((4 * hh + ((lane & 15) >> 2)) * RSV + (16 * ((lane >> 4) & 1) + 4 * (lane & 3)) * 2);
#define FA_NEED(t) ((MODE != 0) || (((t) * 64 + 63 >= qw - 128) && ((t) * 64 <= qw + 31 + 128)))
    { FA_LOADK(tile0); const u32x4 k0_ = kreg; FA_LOADV(tile0); if (ntiles > 1) FA_LOADK(tile0 + 1);
      *(LAS u32x4*)(lds + OFF_K + kst) = k0_; FA_STOREV(0); if (ntiles > 1) FA_STOREK(1); }
    __syncthreads();
    if (ntiles > 2) FA_LOADK(tile0 + 2);
    if (ntiles > 1) FA_LOADV(tile0 + 1);
    if (wid >= 4) __builtin_amdgcn_s_barrier();
    int kb3 = 0;
    for (int it = 0; it < ntiles; ++it) {
        const int t = tile0 + it, k0 = t * 64;
        const bool need = FA_NEED(t);
        bf16x8s pf[2][2];
        if (need) {
            f32x16 sc0, sc1;
            { const LAS unsigned char* Kb_ = lds + OFF_K + kb3 * FA_KB;
#pragma unroll
              for (int i_ = 0; i_ < 16; ++i_) { sc0[i_] = 0.f; sc1[i_] = 0.f; }
              bf16x8s ka0[4], ka1[4], kq[4];
#pragma unroll
              for (int s_ = 0; s_ < 4; ++s_) { const unsigned co_ = (unsigned)(((2 * s_ + hh) ^ ksw) * 16);
                  ka0[s_] = *(const LAS bf16x8s*)(Kb_ + kread + co_); ka1[s_] = *(const LAS bf16x8s*)(Kb_ + 32 * 128 + kread + co_); kq[s_] = *(const LAS bf16x8s*)(qlds + s_ * 1024); }
              __builtin_amdgcn_sched_barrier(0);
#pragma unroll
              for (int s_ = 0; s_ < 4; ++s_) { sc0 = __builtin_amdgcn_mfma_f32_32x32x16_bf16(ka0[s_], kq[s_], sc0, 0, 0, 0); sc1 = __builtin_amdgcn_mfma_f32_32x32x16_bf16(ka1[s_], kq[s_], sc1, 0, 0, 0); }
              __builtin_amdgcn_sched_barrier(0); }
            if (MODE == 2) {
#pragma unroll
                for (int i = 0; i < 16; ++i) { sc0[i] *= c1; sc1[i] *= c1; }
            } else {
                const int rmin = k0 - (qw + 31), rmax = k0 + 63 - qw;
                if (rmin >= 129 || rmax <= -129) { const float bc = rmin >= 129 ? btab[258] : btab[0];
#pragma unroll
                    for (int i = 0; i < 16; ++i) { sc0[i] = sc0[i] * c1 + bc; sc1[i] = sc1[i] * c1 + bc; }
                } else { int rb = k0 + 4 * hh - qi + 129; asm volatile("" : "+v"(rb));
#pragma unroll
                    for (int g = 0; g < 4; ++g) {
#pragma unroll
                        for (int e = 0; e < 4; ++e) { const int i = 4 * g + e;
                            sc0[i] = sc0[i] * c1 + btab[rb + e + 8 * g]; sc1[i] = sc1[i] * c1 + btab[rb + e + 8 * g + 32]; }
                    }
                }
            }
            float mx = sc0[0];
#pragma unroll
            for (int i = 1; i < 16; ++i) mx = fmaxf(mx, sc0[i]);
#pragma unroll
            for (int i = 0; i < 16; ++i) mx = fmaxf(mx, sc1[i]);
            mx = xmax32(mx);
            if (__any(mx > m + FA_THR)) {
                const float mn = fmaxf(m, mx), corr = __builtin_amdgcn_exp2f(m - mn); m = mn; lsum *= corr;
#pragma unroll
                for (int d = 0; d < NDB; ++d)
#pragma unroll
                    for (int i = 0; i < 16; ++i) o[d][i] *= corr;
            }
            float ps = 0.f;
#pragma unroll
            for (int i = 0; i < 16; ++i) { sc0[i] = __builtin_amdgcn_exp2f(sc0[i] - m); sc1[i] = __builtin_amdgcn_exp2f(sc1[i] - m); ps += sc0[i] + sc1[i]; }
            lsum += ps;
#pragma unroll
            for (int s2 = 0; s2 < 2; ++s2) { fv8 x0, x1;
#pragma unroll
                for (int j = 0; j < 8; ++j) { x0[j] = sc0[8 * s2 + j]; x1[j] = sc1[8 * s2 + j]; }
                pf[0][s2] = __builtin_bit_cast(bf16x8s, __builtin_convertvector(x0, bfv8)); pf[1][s2] = __builtin_bit_cast(bf16x8s, __builtin_convertvector(x1, bfv8)); }
        }
        __builtin_amdgcn_s_waitcnt(0xc07f);
        __builtin_amdgcn_s_barrier();
        if (need) {
            const LAS unsigned char* Vb = lds + OFF_V + (it & 1) * VB;
            s16x4 vt[2][NDB][2];
#define FA_VLOAD(slot, grp) do { _Pragma("unroll") for (int d_ = 0; d_ < NDB; ++d_) { const LAS unsigned char* vp_ = Vb + vread + (((grp) >> 1) * 32 + 16 * ((grp) & 1)) * RSV + d_ * 64; \
                vt[slot][d_][0] = __builtin_amdgcn_ds_read_tr16_b64_v4i16((LAS s16x4*)vp_); vt[slot][d_][1] = __builtin_amdgcn_ds_read_tr16_b64_v4i16((LAS s16x4*)(vp_ + 8 * RSV)); } } while (0)
            FA_VLOAD(0, 0);
            __builtin_amdgcn_sched_barrier(0);
#pragma unroll
            for (int grp = 0; grp < 4; ++grp) {
                if (grp + 1 < 4) FA_VLOAD((grp + 1) & 1, grp + 1);
                __builtin_amdgcn_sched_barrier(0);
#pragma unroll
                for (int d = 0; d < NDB; ++d) { const s16x4 t0 = vt[grp & 1][d][0], t1 = vt[grp & 1][d][1];
                    bf16x8s a; a[0] = t0[0]; a[1] = t0[1]; a[2] = t0[2]; a[3] = t0[3]; a[4] = t1[0]; a[5] = t1[1]; a[6] = t1[2]; a[7] = t1[3];
                    o[d] = __builtin_amdgcn_mfma_f32_32x32x16_bf16(a, pf[grp >> 1][grp & 1], o[d], 0, 0, 0); }
                __builtin_amdgcn_sched_barrier(0);
            }
#undef FA_VLOAD
        }
        { int kb2 = kb3 + 2; if (kb2 >= 3) kb2 -= 3;
          if (it + 2 < ntiles) FA_STOREK(kb2); }
        if (it + 1 < ntiles) FA_STOREV((it + 1) & 1);
        if (it + 3 < ntiles) FA_LOADK(t + 3);
        if (it + 2 < ntiles) FA_LOADV(t + 2);
        __syncthreads();
        kb3 = kb3 == 2 ? 0 : kb3 + 1;
    }
    if (wid < 4) __builtin_amdgcn_s_barrier();
#undef FA_LOADK
#undef FA_LOADV
#undef FA_STOREK
#undef FA_STOREV
#undef FA_NEED
}

constexpr int FA_OFF_T = 3 * FA_KB + 2 * 64 * (128 * 2 + 64);

template <int MODE>
__device__ __forceinline__ void fa_unit64(const Params& P, int l, int unit, LAS unsigned char* lds) {
    const bf16_t* p = (const bf16_t*)(kws() + WS_P);
    const int tid = otid(P.pad0), lane = tid & 63, wid = __builtin_amdgcn_readfirstlane(tid >> 6), r = lane & 31, hh = lane >> 5;
    int b, qblk, head = 0, hd = 0;
    const bf16_t *qbase, *kbase, *vbase; size_t ldk;
    if (MODE == 0) { qblk = unit & 7; head = (unit >> 3) & 15; b = unit >> 7; const int kvh = head >> 2;
        qbase = p + (size_t)(b * SEQ) * INC + C_WQ + head * 64; kbase = p + (size_t)(b * SEQ) * INC + C_WK + kvh * 64; vbase = p + (size_t)(b * SEQ) * INC + C_WV + kvh * 64; ldk = INC;
    } else { qblk = unit & 7; hd = (unit >> 3) & 3; b = unit >> 5; const bf16_t* kv = (const bf16_t*)(kws() + WS_KVMEM);
        qbase = p + (size_t)(b * SEQ) * INC + C_MQ + hd * 64; kbase = kv + (size_t)(b * NMEM) * 2048 + l * 512 + hd * 64; vbase = kbase + 256; ldk = 2048;
    }
    const int q0 = qblk * 256, qw = q0 + wid * 32, qi = qw + r;
    int tile0, ntiles;
    if (MODE == 0) { tile0 = q0 / 64 - 2; int tl = q0 / 64 + 5; if (tile0 < 0) tile0 = 0; if (tl > SEQ / 64 - 1) tl = SEQ / 64 - 1; ntiles = tl - tile0 + 1; }
    else { tile0 = 0; ntiles = NMEM / 64; }
    const LAS float* btab = (const LAS float*)(lds + FA_OFF_T) + head * FA_TS + FA_TP;
    f32x16 o[2];
#pragma unroll
    for (int d = 0; d < 2; ++d)
#pragma unroll
        for (int i = 0; i < 16; ++i) o[d][i] = 0.f;
    float m = -INFINITY, lsum = 0.f;
    if (MODE == 0) { m = kin(I_SINK)[l * 16 + head] * LOG2E; lsum = hh == 0 ? 1.0f : 0.0f; }
    fa_core<64, MODE>(lds, tid, qbase + (size_t)qi * INC, kbase, vbase, ldk, tile0, ntiles, qw, qi, btab, o, m, lsum);
    const float lt = lsum + shfl_xor_o(lsum, 32); const float inv = 1.0f / lt;
    const size_t tok = (size_t)b * SEQ + qi;
    bf16_t* yp = (bf16_t*)(kws() + WS_YCAT) + tok * BRK + (MODE == 0 ? 1024 + head * 64 : 3072 + hd * 64) + 4 * hh;
#pragma unroll
    for (int d = 0; d < 2; ++d)
#pragma unroll
        for (int g = 0; g < 4; ++g) { u32x2 w; w.x = cvt_pk_bf16(o[d][4 * g] * inv, o[d][4 * g + 1] * inv); w.y = cvt_pk_bf16(o[d][4 * g + 2] * inv, o[d][4 * g + 3] * inv); *(u32x2*)(yp + 32 * d + 8 * g) = w; }
}

__device__ __forceinline__ void fa_unit_win(const Params& P, int l, int unit, LAS unsigned char* lds) {
    const bf16_t* p = (const bf16_t*)(kws() + WS_P);
    const int tid = otid(P.pad0), lane = tid & 63, wid = __builtin_amdgcn_readfirstlane(tid >> 6), r = lane & 31, hh = lane >> 5;
    const int qb = unit & 31, kvh = (unit >> 5) & 3, b = unit >> 7;
    const int head = kvh * 4 + (wid >> 1);
    const int q0 = qb * 64, qw = q0 + (wid & 1) * 32, qi = qw + r;
    const bf16_t* qbase = p + (size_t)(b * SEQ) * INC + C_WQ + head * 64; const bf16_t* kbase = p + (size_t)(b * SEQ) * INC + C_WK + kvh * 64; const bf16_t* vbase = p + (size_t)(b * SEQ) * INC + C_WV + kvh * 64;
    int tile0 = q0 / 64 - 2, tl = q0 / 64 + 2; if (tile0 < 0) tile0 = 0; if (tl > SEQ / 64 - 1) tl = SEQ / 64 - 1; const int ntiles = tl - tile0 + 1;
    const LAS float* btab = (const LAS float*)(lds + FA_OFF_T) + head * FA_TS + FA_TP;
    f32x16 o[2];
#pragma unroll
    for (int d = 0; d < 2; ++d)
#pragma unroll
        for (int i = 0; i < 16; ++i) o[d][i] = 0.f;
    float m = kin(I_SINK)[l * 16 + head] * LOG2E, lsum = hh == 0 ? 1.0f : 0.0f;
    fa_core<64, 0>(lds, tid, qbase + (size_t)qi * INC, kbase, vbase, (size_t)INC, tile0, ntiles, qw, qi, btab, o, m, lsum);
    const float lt = lsum + shfl_xor_o(lsum, 32); const float inv = 1.0f / lt;
    const size_t tok = (size_t)b * SEQ + qi;
    bf16_t* yp = (bf16_t*)(kws() + WS_YCAT) + tok * BRK + 1024 + head * 64 + 4 * hh;
#pragma unroll
    for (int d = 0; d < 2; ++d)
#pragma unroll
        for (int g = 0; g < 4; ++g) { u32x2 w; w.x = cvt_pk_bf16(o[d][4 * g] * inv, o[d][4 * g + 1] * inv); w.y = cvt_pk_bf16(o[d][4 * g + 2] * inv, o[d][4 * g + 3] * inv); *(u32x2*)(yp + 32 * d + 8 * g) = w; }
}

__device__ __forceinline__ void fa_unit_diff(const Params& P, int l, int unit, LAS unsigned char* lds, float lam_full, float one_m_li) {
    const bf16_t* p = (const bf16_t*)(kws() + WS_P);
    const int tid = otid(P.pad0), lane = tid & 63, wid = __builtin_amdgcn_readfirstlane(tid >> 6), r = lane & 31, hh = lane >> 5;
    const int qblk = unit & 7, h = (unit >> 3) & 7, b = unit >> 6;
    const int q0 = qblk * 256, qw = q0 + wid * 32, qi = qw + r;
    const LAS float* btab = (const LAS float*)(lds + FA_OFF_T) + (16 + h) * FA_TS + FA_TP;
    const size_t tok = (size_t)b * SEQ + qi;
    const bf16_t* vbase = p + (size_t)(b * SEQ) * INC + C_DV + h * 128;
    float* dp = (float*)(kws() + WS_DTMP) + tok * 1024 + h * 128 + 4 * hh;
    for (int cc = 0; cc < 2; ++cc) {
        const bf16_t* qrow = p + tok * INC + C_DQ + h * 128 + cc * 64;
        const bf16_t* kbase = p + (size_t)(b * SEQ) * INC + C_DK + h * 128 + cc * 64;
        f32x16 o[4];
#pragma unroll
        for (int d = 0; d < 4; ++d)
#pragma unroll
            for (int i = 0; i < 16; ++i) o[d][i] = 0.f;
        float m = -INFINITY, lsum = 0.f;
        fa_core<128, 1>(lds, tid, qrow, kbase, vbase, (size_t)INC, 0, SEQ / 64, qw, qi, btab, o, m, lsum);
        const float lt = lsum + shfl_xor_o(lsum, 32); const float inv = 1.0f / lt;
        if (cc == 0) {
#pragma unroll
            for (int d = 0; d < 4; ++d)
#pragma unroll
                for (int g = 0; g < 4; ++g) { f32x4 v; v[0] = o[d][4 * g] * inv; v[1] = o[d][4 * g + 1] * inv; v[2] = o[d][4 * g + 2] * inv; v[3] = o[d][4 * g + 3] * inv; *(f32x4*)(dp + 32 * d + 8 * g) = v; }
        } else {
            float ssq = 0.f;
#pragma unroll
            for (int d = 0; d < 4; ++d)
#pragma unroll
                for (int g = 0; g < 4; ++g) { const f32x4 a = *(const f32x4*)(dp + 32 * d + 8 * g);
#pragma unroll
                    for (int e = 0; e < 4; ++e) { const float x = a[e] - lam_full * (o[d][4 * g + e] * inv); o[d][4 * g + e] = x; ssq += x * x; } }
            ssq += shfl_xor_o(ssq, 32);
            const float rs = rsqrtf(ssq * (1.0f / 128.0f) + 1e-5f) * one_m_li;
            bf16_t* yp = (bf16_t*)(kws() + WS_YCAT) + tok * BRK + 2048 + h * 128 + 4 * hh;
            const float* sg = kin(I_SUBLN) + l * 128 + 4 * hh;
#pragma unroll
            for (int d = 0; d < 4; ++d)
#pragma unroll
                for (int g = 0; g < 4; ++g) { const f32x4 gv = *(const f32x4*)(sg + 32 * d + 8 * g);
                    u32x2 w; w.x = cvt_pk_bf16(o[d][4 * g] * rs * gv[0], o[d][4 * g + 1] * rs * gv[1]); w.y = cvt_pk_bf16(o[d][4 * g + 2] * rs * gv[2], o[d][4 * g + 3] * rs * gv[3]);
                    *(u32x2*)(yp + 32 * d + 8 * g) = w; }
        }
    }
}
__device__ __forceinline__ void phase_attn_mfma(const Params& P, int l, LAS unsigned char* lds) {
    const int tid0 = otid(P.pad0), lane = tid0 & 63;
    { float* bt = (float*)(lds + FA_OFF_T); const float* relb = kin(I_RELB); constexpr int NE = 259 + 2 * FA_TP;
      for (int i = tid0; i < 24 * NE; i += NTHR) { const int hq = i / NE, j = i - hq * NE, rel = j - FA_TP - 129; const int rc = rel < -128 ? -128 : (rel > 128 ? 128 : rel);
          const float v = relb[t5_bucket(rc) * 24 + hq] * LOG2E; bt[hq * FA_TS + j] = (hq < 16 && (rel < -128 || rel > 128)) ? -INFINITY : v; } }
    __syncthreads();
    const float* lam = kin(I_LAM) + l * 256;
    const float l1 = wave_sum(lam[lane] * lam[64 + lane]), l2 = wave_sum(lam[128 + lane] * lam[192 + lane]);
    const float lambda_init = 0.8f - 0.6f * expf(-0.3f * (float)l);
    const float lam_full = expf(l1) - expf(l2) + lambda_init;
    const int G = gridDim.x, c = blockIdx.x;
    if ((G & 7) == 0 && G >= 8) {
        const int x = c & 7, j = c >> 3, W = G >> 3;
        for (int lu = j; lu < 64; lu += W) { const int pair = x * 8 + (lu >> 3); fa_unit_diff(P, l, (pair << 3) | (lu & 7), lds, lam_full, 1.0f - lambda_init); }
        { unsigned* ctr = (unsigned*)(kws() + WS_CTL) + l * 8 + x; volatile LAS unsigned* tk = (volatile LAS unsigned*)(lds + LDS_BYTES - 64);
          __syncthreads();
          if (otid(P.pad0) == 0) tk[0] = atomicAdd(ctr, 1u);
          __syncthreads();
          unsigned cur = (unsigned)__builtin_amdgcn_readfirstlane((int)tk[0]);
          while (cur < 160u) {
              unsigned nv = 0u; if (otid(P.pad0) == 0) nv = atomicAdd(ctr, 1u);
              if (cur < 128u) { const int lu = (int)cur; const int grp = x * 4 + (lu >> 5), g = (lu >> 3) & 3, qb = lu & 7; const int b = grp >> 2, kvh = grp & 3;
                  fa_unit64<0>(P, l, (b << 7) | ((kvh * 4 + g) << 3) | qb, lds); }
              else { const int lu = (int)cur - 128; const int grp = x * 4 + (lu >> 3); fa_unit64<2>(P, l, (grp << 3) | (lu & 7), lds); }
              __syncthreads();
              if (otid(P.pad0) == 0) tk[0] = nv;
              __syncthreads();
              cur = (unsigned)__builtin_amdgcn_readfirstlane((int)tk[0]);
          } }
    } else {
        for (int u = c; u < 512; u += G) fa_unit_diff(P, l, u, lds, lam_full, 1.0f - lambda_init);
        for (int u = c; u < 1024; u += G) fa_unit_win(P, l, u, lds);
        for (int u = c; u < 256; u += G) fa_unit64<2>(P, l, u, lds);
    }
}

#ifndef STAMP_SCAN
#define STAMP_SCAN 0
#endif
constexpr int CRP = 144, CIMG = 64 * CRP;
enum { SL_KQ = 0, SL_RQ, SL_AK, SL_DK, SL_VV, SL_B, SL_M2, SL_N1, SL_N2, SL_A, SL_C, SL_D, SL_X1, SL_S0, SL_S1, SL_COUNT };
constexpr int CS_GC = SL_COUNT * CIMG;
constexpr int CS_CONST = CS_GC + 256;
constexpr int CS_LD = SL_A * CIMG;
constexpr int CS_SEG = CS_LD + 64 * 64 * 4;

__device__ __forceinline__ int cs_off_row(int tile, int lane) { return (32 * tile + (lane & 31)) * CRP + 16 * (lane >> 5); }
__device__ __forceinline__ int cs_off_tr(int tile, int lane) { return (8 * (lane >> 5) + ((lane & 15) >> 2)) * CRP + (32 * tile + 16 * ((lane >> 4) & 1) + 4 * (lane & 3)) * 2; }
__device__ __forceinline__ int cs_off_cm(int ti, int tj, int lane) { return (32 * tj + (lane & 31)) * CRP + (32 * ti + 4 * (lane >> 5)) * 2; }
__device__ __forceinline__ bf16x8s cs_rowfrag(const LAS unsigned char* img, int off, int s) { return *(const LAS bf16x8s*)(img + off + 32 * s); }
__device__ __forceinline__ bf16x8s cs_trfrag(const LAS unsigned char* img, int off, int s) {
    const LAS unsigned char* a = img + off + 16 * s * CRP;
    const s16x4 t0 = __builtin_amdgcn_ds_read_tr16_b64_v4i16((LAS s16x4*)a), t1 = __builtin_amdgcn_ds_read_tr16_b64_v4i16((LAS s16x4*)(a + 4 * CRP));
    bf16x8s f; f[0] = t0[0]; f[1] = t0[1]; f[2] = t0[2]; f[3] = t0[3]; f[4] = t1[0]; f[5] = t1[1]; f[6] = t1[2]; f[7] = t1[3];
    return f;
}
template <bool ATR, bool BTR>
__device__ __forceinline__ f32x16 cs_mm(f32x16 acc, const LAS unsigned char* Ai, int aoff, const LAS unsigned char* Bi, int boff) {
    bf16x8s a[4], b[4];
#pragma unroll
    for (int s = 0; s < 4; ++s) { a[s] = ATR ? cs_trfrag(Ai, aoff, s) : cs_rowfrag(Ai, aoff, s); b[s] = BTR ? cs_trfrag(Bi, boff, s) : cs_rowfrag(Bi, boff, s); }
    __builtin_amdgcn_sched_barrier(0);
#pragma unroll
    for (int s = 0; s < 4; ++s) acc = __builtin_amdgcn_mfma_f32_32x32x16_bf16(a[s], b[s], acc, 0, 0, 0);
    return acc;
}
__device__ __forceinline__ void cs_store_cm(LAS unsigned char* img, int off, const f32x16& acc) {
#pragma unroll
    for (int g = 0; g < 4; ++g) { fv8 x; x[0] = acc[4 * g]; x[1] = acc[4 * g + 1]; x[2] = acc[4 * g + 2]; x[3] = acc[4 * g + 3]; x[4] = 0.f; x[5] = 0.f; x[6] = 0.f; x[7] = 0.f;
        const bf16x8s y = __builtin_bit_cast(bf16x8s, __builtin_convertvector(x, bfv8)); s16x4 w; w[0] = y[0]; w[1] = y[1]; w[2] = y[2]; w[3] = y[3];
        *(LAS s16x4*)(img + off + 16 * g) = w; }
}
__device__ __forceinline__ f32x16 cs_load_cm(const LAS unsigned char* img, int off) {
    f32x16 v;
#pragma unroll
    for (int g = 0; g < 4; ++g) { const u32x2 w = *(const LAS u32x2*)(img + off + 16 * g);
        v[4 * g] = bflo(w.x); v[4 * g + 1] = bfhi(w.x); v[4 * g + 2] = bflo(w.y); v[4 * g + 3] = bfhi(w.y); }
    return v;
}
__device__ __forceinline__ f32x16 cs_zero() { f32x16 z;
#pragma unroll
    for (int i = 0; i < 16; ++i) z[i] = 0.f;
    return z; }

__device__ __forceinline__ void phase_scan_chunked(const Params& P, int l, LAS unsigned char* lds) {
    const bf16_t* p = (const bf16_t*)(kws() + WS_P); const bf16_t* lora = (const bf16_t*)(kws() + WS_LORA);
    bf16_t* ydir = (bf16_t*)(kws() + WS_YDIR); float* bonus = (float*)(kws() + WS_BONUS);
    const int tid = otid(P.pad0), lane = tid & 63, wid = __builtin_amdgcn_readfirstlane(tid >> 6), r = lane & 31, hh = lane >> 5;
    const int pt = tid >> 3, pc8 = tid & 7;
    const int w4 = wid & 3, ti = w4 >> 1, tj = w4 & 1;
    const bool grpA = wid < 4;
#define IMG(s) (lds + (s) * CIMG)
    LAS float* LD = (LAS float*)(lds + CS_LD); LAS float* SEG = (LAS float*)(lds + CS_SEG); LAS float* GC = (LAS float*)(lds + CS_GC); LAS float* CN = (LAS float*)(lds + CS_CONST);
    for (int u = blockIdx.x; u < 256; u += gridDim.x) {
        const int z = u & 1, h = (u >> 1) & 15, b = u >> 5;
        const int c8 = h * 64 + pc8 * 8;
        const float* mu = kin(I_MU) + (size_t)l * 2 * RWC;
        __syncthreads();
        for (int i = tid; i < 9 * 64; i += NTHR) { const int vq = i >> 6, ch = i & 63, cch = h * 64 + ch; float v;
            if (vq < 3) v = mu[vq * 1024 + cch]; else if (vq < 6) v = mu[RWC + (vq - 3) * 1024 + cch]; else if (vq == 6) v = kin(I_KK)[l * 1024 + cch]; else if (vq == 7) v = kin(I_KA)[l * 1024 + cch]; else v = kin(I_RK)[l * 1024 + cch];
            CN[i] = v; }
        { LAS unsigned char* s0 = IMG(SL_S0); for (int i = tid; i < CIMG / 16; i += NTHR) *(LAS u32x4*)(s0 + i * 16) = (u32x4){0u, 0u, 0u, 0u}; }
        u32x4 rw[3][3], lw[2];
#define CS_LOAD(n) do { const int i_ = (n) * 64 + pt; const int t_ = z ? (SEQ - 1) - i_ : i_; const bf16_t* pr_ = p + (size_t)(b * SEQ + t_) * INC + c8; \
        const bool okp_ = t_ > 0, okn_ = t_ < SEQ - 1; const u32x4 zz_ = {0u, 0u, 0u, 0u}; \
        _Pragma("unroll") for (int x_ = 0; x_ < 3; ++x_) { rw[x_][0] = *(const u32x4*)(pr_ + x_ * 1024); rw[x_][1] = okp_ ? *(const u32x4*)(pr_ - INC + x_ * 1024) : zz_; rw[x_][2] = okn_ ? *(const u32x4*)(pr_ + INC + x_ * 1024) : zz_; } \
        const bf16_t* lr_ = lora + (size_t)(b * SEQ + t_) * LORA_N + z * 1024 + c8; lw[0] = *(const u32x4*)lr_; lw[1] = *(const u32x4*)(lr_ + 2048); } while (0)
        CS_LOAD(0);
        f32x16 accR = cs_zero();
        for (int n = 0; n < SEQ / 64; ++n) {
#if STAMP_SCAN
            const unsigned ts0 = (unsigned)__builtin_readcyclecounter();
#endif
            const int sOld = (n & 1) ? SL_S1 : SL_S0, sNew = (n & 1) ? SL_S0 : SL_S1;
            int rowI = cs_off_row(ti, lane), rowJ = cs_off_row(tj, lane), trI = cs_off_tr(ti, lane), trJ = cs_off_tr(tj, lane), cmO = cs_off_cm(ti, tj, lane);
            asm volatile("" : "+v"(rowI), "+v"(rowJ), "+v"(trI), "+v"(trJ), "+v"(cmO));
            { float ldv[8];
#pragma unroll
              for (int q = 0; q < 2; ++q) { const unsigned l0 = q ? lw[0].z : lw[0].x, l1 = q ? lw[0].w : lw[0].y; ldv[4 * q] = bflo(l0); ldv[4 * q + 1] = bfhi(l0); ldv[4 * q + 2] = bflo(l1); ldv[4 * q + 3] = bfhi(l1); }
              LAS float* ldp = LD + pt * 64 + pc8 * 8;
              *(LAS f32x4*)ldp = (f32x4){ldv[0], ldv[1], ldv[2], ldv[3]}; *(LAS f32x4*)(ldp + 4) = (f32x4){ldv[4], ldv[5], ldv[6], ldv[7]}; }
            __syncthreads();
            { const int k = tid & 63, seg = tid >> 6; float c[8]; float run = 0.f;
#pragma unroll
              for (int j = 0; j < 8; ++j) { run += LD[(seg * 8 + j) * 64 + k]; c[j] = run; }
              SEG[seg * 64 + k] = run;
              __syncthreads();
              float pre = 0.f;
#pragma unroll
              for (int s = 0; s < 7; ++s) pre += (s < seg) ? SEG[s * 64 + k] : 0.f;
#pragma unroll
              for (int j = 0; j < 8; ++j) LD[(seg * 8 + j) * 64 + k] = pre + c[j];
            }
            __syncthreads();
            { const int i = n * 64 + pt, tok = b * SEQ + (z ? (SEQ - 1) - i : i);
              float xs[3][8];
#pragma unroll
              for (int x = 0; x < 3; ++x)
#pragma unroll
                  for (int q = 0; q < 2; ++q) {
                      const unsigned c0 = q ? rw[x][0].z : rw[x][0].x, c1 = q ? rw[x][0].w : rw[x][0].y, p0 = q ? rw[x][1].z : rw[x][1].x, p1 = q ? rw[x][1].w : rw[x][1].y, n0 = q ? rw[x][2].z : rw[x][2].x, n1 = q ? rw[x][2].w : rw[x][2].y;
                      f32x4 c, pv, nx; c[0] = bflo(c0); c[1] = bfhi(c0); c[2] = bflo(c1); c[3] = bfhi(c1); pv[0] = bflo(p0); pv[1] = bfhi(p0); pv[2] = bflo(p1); pv[3] = bfhi(p1); nx[0] = bflo(n0); nx[1] = bfhi(n0); nx[2] = bflo(n1); nx[3] = bfhi(n1);
                      const f32x4 m0 = *(const LAS f32x4*)(CN + x * 64 + pc8 * 8 + 4 * q), m1 = *(const LAS f32x4*)(CN + (3 + x) * 64 + pc8 * 8 + 4 * q);
                      const f32x4 o = c + m0 * (pv - c) + m1 * (nx - c);
                      xs[x][4 * q] = o[0]; xs[x][4 * q + 1] = o[1]; xs[x][4 * q + 2] = o[2]; xs[x][4 * q + 3] = o[3]; }
              float av[8], ckk[8], cka[8], crk[8];
#pragma unroll
              for (int q = 0; q < 2; ++q) { const unsigned a0 = q ? lw[1].z : lw[1].x, a1 = q ? lw[1].w : lw[1].y;
                  av[4 * q] = bflo(a0); av[4 * q + 1] = bfhi(a0); av[4 * q + 2] = bflo(a1); av[4 * q + 3] = bfhi(a1);
                  const f32x4 t6 = *(const LAS f32x4*)(CN + 6 * 64 + pc8 * 8 + 4 * q), t7 = *(const LAS f32x4*)(CN + 7 * 64 + pc8 * 8 + 4 * q), t8 = *(const LAS f32x4*)(CN + 8 * 64 + pc8 * 8 + 4 * q);
#pragma unroll
                  for (int e = 0; e < 4; ++e) { ckk[4 * q + e] = t6[e]; cka[4 * q + e] = t7[e]; crk[4 * q + e] = t8[e]; } }
              float kk[8], kd[8]; float ss = 0.f, bq = 0.f;
#pragma unroll
              for (int j = 0; j < 8; ++j) { const float kx = xs[1][j]; const float kraw = kx * ckk[j]; kk[j] = kraw; ss += kraw * kraw;
                  kd[j] = kx * (1.0f + (av[j] - 1.0f) * cka[j]); bq += xs[0][j] * kd[j] * crk[j]; }
              ss = sum8(ss); bq = sum8(bq);
              const float rn = rsqrtf(fmaxf(ss, 1e-12f));
              if (pc8 == 0) bonus[((size_t)z * NTOK + tok) * 16 + h] = bq;
              const LAS float* cu = LD + pt * 64 + pc8 * 8;
              float cum[8], cup[8];
#pragma unroll
              for (int q = 0; q < 2; ++q) { const f32x4 a = *(const LAS f32x4*)(cu + 4 * q); cum[4 * q] = a[0]; cum[4 * q + 1] = a[1]; cum[4 * q + 2] = a[2]; cum[4 * q + 3] = a[3];
                  f32x4 bpv = {0.f, 0.f, 0.f, 0.f}; if (pt > 0) bpv = *(const LAS f32x4*)(cu - 64 + 4 * q); cup[4 * q] = bpv[0]; cup[4 * q + 1] = bpv[1]; cup[4 * q + 2] = bpv[2]; cup[4 * q + 3] = bpv[3]; }
              fv8 okq, orq, oak, odk, ovv;
#pragma unroll
              for (int j = 0; j < 8; ++j) { const float gt = __expf(cum[j]), gp = __expf(cup[j]), gi = __builtin_amdgcn_rcpf(gt); const float kkn = kk[j] * rn;
                  okq[j] = kkn * gp; orq[j] = xs[0][j] * gt; oak[j] = av[j] * kkn * gi; odk[j] = kd[j] * gi; ovv[j] = xs[2][j];
                  if (pt == 63) GC[pc8 * 8 + j] = gt; }
              const int off = pt * CRP + pc8 * 16;
              *(LAS bfv8*)(IMG(SL_KQ) + off) = __builtin_convertvector(okq, bfv8); *(LAS bfv8*)(IMG(SL_RQ) + off) = __builtin_convertvector(orq, bfv8);
              *(LAS bfv8*)(IMG(SL_AK) + off) = __builtin_convertvector(oak, bfv8); *(LAS bfv8*)(IMG(SL_DK) + off) = __builtin_convertvector(odk, bfv8);
              *(LAS bfv8*)(IMG(SL_VV) + off) = __builtin_convertvector(ovv, bfv8);
            }
            __syncthreads();
            if (n + 1 < SEQ / 64) CS_LOAD(n + 1);
#if STAMP_SCAN
            const unsigned ts1 = (unsigned)__builtin_readcyclecounter();
#endif
            { const int pr = wid >> 1; const LAS unsigned char* Ai = IMG(pr < 2 ? SL_KQ : SL_RQ); const LAS unsigned char* Bi = IMG((pr & 1) ? SL_DK : SL_AK);
              LAS unsigned char* Oi = IMG(pr == 0 ? SL_B : (pr == 1 ? SL_M2 : (pr == 2 ? SL_N1 : SL_N2)));
#pragma unroll
              for (int q = 0; q < 2; ++q) { const int ti1 = wid & 1, tj1 = q;
                  f32x16 acc = cs_mm<false, false>(cs_zero(), Ai, cs_off_row(ti1, lane), Bi, cs_off_row(tj1, lane));
                  f32x16 t1;
#pragma unroll
                  for (int i = 0; i < 16; ++i) { const int m = 32 * ti1 + (i & 3) + 8 * (i >> 2) + 4 * hh, nn = 32 * tj1 + r; const bool keep = pr < 2 ? (nn < m) : (nn <= m);
                      acc[i] = keep ? acc[i] : 0.f; t1[i] = (m == nn ? 1.0f : 0.0f) - acc[i]; }
                  cs_store_cm(Oi, cs_off_cm(ti1, tj1, lane), acc);
                  if (pr == 0) cs_store_cm(IMG(SL_C), cs_off_cm(ti1, tj1, lane), t1); } }
            __syncthreads();
            if (grpA) { const f32x16 acc = cs_mm<true, false>(cs_zero(), IMG(SL_B), trI, IMG(SL_B), rowJ); cs_store_cm(IMG(SL_A), cmO, acc); }
            else { const f32x16 acc = cs_mm<true, true>(cs_zero(), IMG(SL_M2), trI, IMG(SL_VV), trJ); cs_store_cm(IMG(SL_X1), cmO, acc); }
            __syncthreads();
#pragma unroll
            for (int st = 0; st < 5; ++st) {
                const int qs = (st & 1) ? SL_B : SL_A, qd = (st & 1) ? SL_A : SL_B, ts = (st & 1) ? SL_D : SL_C, td = (st & 1) ? SL_C : SL_D;
                if (grpA) { if (st < 4) { const f32x16 acc = cs_mm<true, false>(cs_zero(), IMG(qs), trI, IMG(qs), rowJ); cs_store_cm(IMG(qd), cmO, acc); } }
                else { const f32x16 acc = cs_mm<true, false>(cs_load_cm(IMG(ts), cmO), IMG(ts), trI, IMG(qs), rowJ); cs_store_cm(IMG(td), cmO, acc); }
                __syncthreads();
            }
            if (grpA) { const f32x16 acc = cs_mm<true, true>(cs_zero(), IMG(SL_D), trI, IMG(SL_KQ), trJ); cs_store_cm(IMG(SL_A), cmO, acc); }
            else { const f32x16 acc = cs_mm<true, false>(cs_zero(), IMG(SL_D), trI, IMG(SL_X1), rowJ); cs_store_cm(IMG(SL_B), cmO, acc); }
            __syncthreads();
            if (grpA) { f32x16 acc = cs_mm<false, true>(cs_zero(), IMG(SL_A), rowI, IMG(SL_N1), trJ);
                const f32x16 rq = cs_load_cm(IMG(SL_RQ), cmO);
                acc = rq - acc;
                cs_store_cm(IMG(SL_M2), cmO, acc); }
            else { const f32x16 a1 = cs_mm<true, true>(cs_zero(), IMG(SL_VV), trI, IMG(SL_N2), trJ); const f32x16 a2 = cs_mm<false, true>(cs_zero(), IMG(SL_B), rowI, IMG(SL_N1), trJ); accR = a1 - a2; }
            if (!grpA) { f32x16 acc = cs_mm<false, true>(cs_zero(), IMG(SL_A), rowI, IMG(SL_AK), trJ); const float gc = GC[32 * tj + r];
#pragma unroll
                for (int i = 0; i < 16; ++i) { const int m = 32 * ti + (i & 3) + 8 * (i >> 2) + 4 * hh, nn = 32 * tj + r; acc[i] = ((m == nn ? 1.0f : 0.0f) - acc[i]) * gc; }
                cs_store_cm(IMG(SL_C), cmO, acc); }
            else { const f32x16 a1 = cs_mm<true, true>(cs_zero(), IMG(SL_DK), trI, IMG(SL_VV), trJ); const f32x16 a2 = cs_mm<true, false>(cs_zero(), IMG(SL_AK), trI, IMG(SL_B), rowJ);
#pragma unroll
                for (int g = 0; g < 4; ++g) { const f32x4 gcv = *(const LAS f32x4*)(GC + 32 * ti + 8 * g + 4 * hh);
#pragma unroll
                    for (int e = 0; e < 4; ++e) accR[4 * g + e] = (a1[4 * g + e] - a2[4 * g + e]) * gcv[e]; } }
            __syncthreads();
            if (grpA) { accR = cs_mm<false, false>(accR, IMG(SL_C), rowI, IMG(sOld), rowJ); cs_store_cm(IMG(sNew), cmO, accR); }
            else { accR = cs_mm<false, false>(accR, IMG(sOld), rowI, IMG(SL_M2), rowJ);
                const int t = 32 * tj + r, ii = n * 64 + t; const int tk = z ? (SEQ - 1) - ii : ii;
                bf16_t* yp = ydir + ((size_t)z * NTOK + b * SEQ + tk) * DM + h * 64 + 32 * ti + 4 * hh;
#pragma unroll
                for (int g = 0; g < 4; ++g) { fv8 x; x[0] = accR[4 * g]; x[1] = accR[4 * g + 1]; x[2] = accR[4 * g + 2]; x[3] = accR[4 * g + 3]; x[4] = 0.f; x[5] = 0.f; x[6] = 0.f; x[7] = 0.f;
                    const bf16x8s y8 = __builtin_bit_cast(bf16x8s, __builtin_convertvector(x, bfv8)); s16x4 w; w[0] = y8[0]; w[1] = y8[1]; w[2] = y8[2]; w[3] = y8[3];
                    *(s16x4*)(yp + 8 * g) = w; } }
            __syncthreads();
#if STAMP_SCAN
            { const unsigned ts2 = (unsigned)__builtin_readcyclecounter(); if (blockIdx.x == 0 && tid == 0) { unsigned* acc = (unsigned*)(kws() + 8192);
                acc[0] += (STAMP_SCAN == 1 ? (ts1 - ts0) : (STAMP_SCAN == 2 ? (ts2 - ts1) : (ts2 - ts0))); } }
#endif
        }
#undef CS_LOAD
    }
#undef IMG
}
#define XB_TMO      128
#define XB_XCNT(j)  (256  + 64 * (j))
#define XB_XSUB(j)  (1280 + 64 * (j))
#define XB_XGEN(j)  (2304 + 64 * (j))
#define XB_TOP      3328
#define XB_TOPGEN   3392
#define XCD_BAR_WORDS 3456
#define XB_SPIN_CAP (1u << 20)

__device__ __forceinline__ unsigned xb_ld(unsigned* p)              { return __hip_atomic_load(p, __ATOMIC_RELAXED, __HIP_MEMORY_SCOPE_AGENT); }
__device__ __forceinline__ unsigned xb_add(unsigned* p, unsigned v) { return __hip_atomic_fetch_add(p, v, __ATOMIC_RELAXED, __HIP_MEMORY_SCOPE_AGENT); }
__device__ __forceinline__ unsigned xb_xcc_id() { return (unsigned)__builtin_amdgcn_s_getreg((3 << 11) | 20) & 0xFu; }
#define XB_SPIN(cond, bar) do { unsigned _sp = 0; while (cond) { __builtin_amdgcn_s_sleep(1); \
    if ((++_sp & 255u) == 0u) { if (xb_ld(&(bar)[XB_TMO])) break; if (_sp > XB_SPIN_CAP) { atomicAdd(&(bar)[XB_TMO], 1u); break; } } } } while (0)

struct XcdBarrier {
    unsigned* bar; unsigned x; int wv;
    volatile LAS unsigned* st;
};

__device__ __forceinline__ XcdBarrier xcd_barrier_post(unsigned* bar, volatile LAS unsigned* st) {
    XcdBarrier b; b.bar = bar; b.x = xb_xcc_id(); b.st = st;
    if (threadIdx.x == 0) (void)xb_add(&bar[XB_XCNT(b.x)], 1u);
    return b;
}
__device__ __forceinline__ void xcd_barrier_complete(unsigned* bar, unsigned x, unsigned& nloc, unsigned& nx) {
    const unsigned G = gridDim.x * gridDim.y * gridDim.z;
    unsigned sum, cnt, mine, sp = 0u;
    for (;;) {
        sum = 0u; cnt = 0u; mine = 0u;
#pragma unroll
        for (unsigned j = 0; j < 16; ++j) { const unsigned c = xb_ld(&bar[XB_XCNT(j)]); sum += c; cnt += (c > 0u) ? 1u : 0u; mine = (j == x) ? c : mine; }
        if (sum == G) break;
        __builtin_amdgcn_s_sleep(1);
        if ((++sp & 255u) == 0u) { if (xb_ld(&bar[XB_TMO])) break; if (sp > XB_SPIN_CAP) { atomicAdd(&bar[XB_TMO], 1u); break; } }
    }
    nloc = mine > 0u ? mine : 1u; nx = cnt > 0u ? cnt : 1u;
}

__device__ __forceinline__ void xcd_barrier(const XcdBarrier& b) {
    asm volatile("s_waitcnt vmcnt(0)" ::: "memory");
    __syncthreads();
    unsigned xz_ = 0u; asm volatile("" : "+v"(xz_));
    if (b.wv == 0 && __builtin_amdgcn_mbcnt_hi(~0u, __builtin_amdgcn_mbcnt_lo(~0u, xz_)) == 0u) {
        unsigned* bar = b.bar; asm volatile("" : "+s"(bar));
        __builtin_amdgcn_s_waitcnt(0);
        unsigned nloc = b.st[0], nx = b.st[1];
        if (nloc == 0u) { xcd_barrier_complete(bar, b.x, nloc, nx); b.st[0] = nloc; b.st[1] = nx; }
        const unsigned old = xb_add(&bar[XB_XSUB(b.x)], 1u);
        const unsigned gen = old / nloc;
        if (old + 1u == (gen + 1u) * nloc) {
            __builtin_amdgcn_fence(__ATOMIC_RELEASE, "agent");
            asm volatile("s_waitcnt vmcnt(0)" ::: "memory");
            const unsigned og = xb_add(&bar[XB_TOP], 1u);
            const unsigned tg = og / nx;
            if (og + 1u == (tg + 1u) * nx) xb_add(&bar[XB_TOPGEN], 1u);
            else XB_SPIN(xb_ld(&bar[XB_TOPGEN]) == tg, bar);
            __builtin_amdgcn_fence(__ATOMIC_ACQUIRE, "agent");
            xb_add(&bar[XB_XGEN(b.x)], 1u);
            asm volatile("s_waitcnt vmcnt(0)" ::: "memory");
        } else {
            XB_SPIN(xb_ld(&bar[XB_XGEN(b.x)]) == gen, bar);
            __builtin_amdgcn_fence(__ATOMIC_ACQUIRE, "agent");
            asm volatile("s_waitcnt vmcnt(0)" ::: "memory");
        }
    }
    __syncthreads();
}


template <class Epi, class Sched>
__device__ __forceinline__ void run_gemm(int wv, LAS unsigned char* lds, const bf16_t* A, int lda, const bf16_t* Bt, int ldb, int M, int N, int K, const Sched& S, const Epi& E, int pshift = 30, int pmask = -1, int koff = 0, int alt_from = 1 << 30, int nt_alt = 0) {
    asm volatile("" : "+s"(K));
    Gemm g; g.A = A; g.Bt = Bt; g.M = M; g.N = N; g.K = K; g.lda = lda; g.ldb = ldb; g.wv = wv; g.sa = 0; g.sb = 0; g.pshift = pshift; g.pmask = pmask; g.koff = koff; g.alt_from = alt_from; g.nt_alt = nt_alt;
    pg8::gemm_phase<Epi, Sched, false>(lds, g, S, E, nullptr);
}
template <class Epi, class Sched>
__device__ __forceinline__ void run_gemm_f8(int wv, LAS unsigned char* lds, const unsigned char* A, int lda, const unsigned char* Bt, int ldb, int M, int N, int K, int sa, int sb, const Sched& S, const Epi& E) {
    asm volatile("" : "+s"(K));
    Gemm g; g.A = (const bf16_t*)A; g.Bt = (const bf16_t*)Bt; g.M = M; g.N = N; g.K = K; g.lda = lda; g.ldb = ldb; g.wv = wv; g.sa = sa; g.sb = sb; g.pshift = 30; g.pmask = -1; g.koff = 0; g.alt_from = 1 << 30; g.nt_alt = 0;
    pg8::gemm_phase_f8<Epi, Sched, false>(lds, g, S, E, nullptr);
}

#ifndef EN_MASK
#define EN_MASK 0xFFFFFFFFu
#endif
#define EN_PH(k) ((EN_MASK >> (k)) & 1u)
#ifndef PROBE_REP
#define PROBE_REP (-1)
#endif
#ifndef PROBE_MASK
#define PROBE_MASK 0u
#endif
#define REP(k) for (int rep_ = 0; rep_ < (((PROBE_REP == (k)) || ((k) < 32 && ((PROBE_MASK >> ((k) & 31)) & 1u))) ? 2 : 1); ++rep_)
constexpr int NPH_PRO = 2, NPH_LAYER = 12, NPH_TOTAL = NPH_PRO + DEPTH * NPH_LAYER;

__global__ void __launch_bounds__(512, 2) mega(Params Pk) {
    Params P = Pk; P.pad0 = __builtin_amdgcn_readfirstlane((int)threadIdx.x >> 6);
    extern __shared__ __attribute__((aligned(16))) unsigned char shm[];
    float* ldsf = (float*)shm;
    LAS unsigned char* ldsl = (LAS unsigned char*)shm;
    unsigned char* ws = kws();
    const int G = gridDim.x, c = blockIdx.x;
    XcdBarrier bar;
    if (P.fused) {
        volatile LAS unsigned* st = (volatile LAS unsigned*)(ldsl + LDS_BYTES - 16);
        if (threadIdx.x == 0) { st[0] = 0u; st[1] = 0u; st[2] = 0u; st[3] = 0u; }
        __syncthreads();
        bar = xcd_barrier_post((unsigned*)(ws + WS_CTL), st); bar.wv = P.pad0;
    }
    int ph = 0;
#define PH_BEGIN if (ph >= P.ph_lo && ph < P.ph_hi) {
#ifndef BAR_TWICE
#define BAR_TWICE 0
#endif
#define PH_END_  if (P.fused) { xcd_barrier(bar); if (BAR_TWICE) xcd_barrier(bar); } else __syncthreads(); } ++ph;

    PH_BEGIN
#if EN_PH(0)
REP(0) { if (rep_) __syncthreads();
phase_convert(P, ldsf);
}
#endif
 PH_END_
    PH_BEGIN
#if EN_PH(1)
REP(1) { if (rep_) __syncthreads();
{ pg8::StaticOrder S; S.init(NBATCH * NMEM, DEPTH * 512, G, c); EpiBf16Store E; E.O = (bf16_t*)(ws + WS_KVMEM); E.ldc = DEPTH * 512; E.st = ldsl + 131072; E.GP = nullptr;
        run_gemm(P.pad0, ldsl, (const bf16_t*)(ws + WS_MEMB), DM, (const bf16_t*)(ws + WS_WKV), DM, NBATCH * NMEM, DEPTH * 512, DM, S, E); }
}
#endif
 PH_END_

    for (int l = 0; l < DEPTH; ++l) {
        PH_BEGIN
#if EN_PH(2)
REP(2) { if (rep_) __syncthreads();
{ pg8::StaticOrder S; S.init(NTOK, INC, G, c); EpiBf16Store E; E.O = (bf16_t*)(ws + WS_P); E.ldc = INC; E.st = ldsl + 131072; E.GP = (bf16_t*)(ws + WS_GATEP);
            run_gemm(P.pad0, ldsl, (const bf16_t*)(ws + WS_XB), DM, (const bf16_t*)(ws + WS_WIN) + (size_t)l * INC * DM, DM, NTOK, INC, DM, S, E); }
}
#endif
 PH_END_
        PH_BEGIN
#if EN_PH(3)
REP(3) { if (rep_) __syncthreads();
phase_prepass(P, l);
}
#endif
 PH_END_
        PH_BEGIN
#if EN_PH(4)
REP(4) { if (rep_) __syncthreads();
{ pg8::StaticOrder S; S.init(NTOK, LORA_N, G, c); EpiLora E; E.O = (bf16_t*)(ws + WS_LORA); E.w0 = kin(I_W0) + l * 2048; E.a0 = kin(I_A0) + l * 2048;
            run_gemm(P.pad0, ldsl, (const bf16_t*)(ws + WS_APR), 256, (const bf16_t*)(ws + WS_WLORA) + (size_t)l * LORA_N * 256, 256, NTOK, LORA_N, 128, S, E, 4, -1, 256); }
}
#endif
 PH_END_
        PH_BEGIN
#if EN_PH(5)
REP(5) { if (rep_) __syncthreads();
REP(100) { if (rep_) __syncthreads(); phase_scan_chunked(P, l, ldsl); }
        REP(101) { if (rep_) __syncthreads(); phase_attn_mfma(P, l, ldsl); }
}
#endif
 PH_END_
        PH_BEGIN
#if EN_PH(6)
REP(6) { if (rep_) __syncthreads();
phase_post(P, l);
}
#endif
 PH_END_
        PH_BEGIN
#if EN_PH(7)
REP(7) { if (rep_) __syncthreads();
{ BranchOrder S; S.init(NTOK, DM, G, c);
            const bf16_t* ycat = (const bf16_t*)(ws + WS_YCAT); const bf16_t* wbr = (const bf16_t*)(ws + WS_WBR) + (size_t)l * DM * BRK;
            EpiBranchAll E; E.gateP = (const bf16_t*)(ws + WS_GATEP); E.mbP = (bf16_t*)(ws + WS_MBP); E.mb = (bf16_t*)(ws + WS_MB); E.st = ldsl + 131072;
            run_gemm(P.pad0, ldsl, ycat, BRK, wbr, BRK, NTOK, DM, 1024, S, E, 2, 3, 2048, 3, 4); }
}
#endif
 PH_END_
        PH_BEGIN
#if EN_PH(8)
REP(8) { if (rep_) __syncthreads();
{ pg8::StaticOrder S; S.init(NTOK, DM, G, c); EpiResid E; E.xf = (const float*)(ws + WS_XF); E.o = (float*)(ws + WS_PRELN);
            run_gemm(P.pad0, ldsl, (const bf16_t*)(ws + WS_MB), DM, (const bf16_t*)(ws + WS_WOUT) + (size_t)l * DM * DM, DM, NTOK, DM, DM, S, E); }
}
#endif
 PH_END_
        PH_BEGIN
#if EN_PH(9)
REP(9) { if (rep_) __syncthreads();
phase_ln1(P, l, ldsf);
}
#endif
 PH_END_
        PH_BEGIN
#if EN_PH(10)
REP(10) { if (rep_) __syncthreads();
phase_topk(P, (unsigned long long*)shm);
}
#endif
 PH_END_
        PH_BEGIN
#if EN_PH(11)
REP(11) { if (rep_) __syncthreads();
{ GroupedOrder S; S.init(8, 16, NEXP, G, c); EpiSwiGLU E; E.H = ws + WS_H;
            run_gemm_f8(P.pad0, ldsl, ws + WS_XE, DM, ws + WS_WGU + (size_t)l * NEXP * 4096 * DM, DM, NEXP * 2048, NEXP * 4096, DM, E8_ONE, E8_W, S, E); }
}
#endif
 PH_END_
        PH_BEGIN
#if EN_PH(12)
REP(12) { if (rep_) __syncthreads();
{ GroupedOrder S; S.init(8, 4, NEXP, G, c); EpiDown E; E.Y = (bf16_t*)(ws + WS_YE); E.grow = (const float*)(ws + WS_GROW);
            run_gemm_f8(P.pad0, ldsl, ws + WS_H, DEXP, ws + WS_WDN + (size_t)l * NEXP * DM * DEXP, DEXP, NEXP * 2048, NEXP * DM, DEXP, E8_H, E8_W, S, E); }
}
#endif
 PH_END_
        PH_BEGIN
#if EN_PH(13)
REP(13) { if (rep_) __syncthreads();
phase_ln2(P, l);
}
#endif
 PH_END_
    }
#undef PH_BEGIN
#undef PH_END_
#if STAMP_SCAN
    if (blockIdx.x == 0 && threadIdx.x == 0) { const unsigned long long want = 4ull * *(volatile unsigned*)(kws() + 8192); const long long t0 = clock64(); while ((unsigned long long)(clock64() - t0) < want) __builtin_amdgcn_s_sleep(8); }
#endif
}

#ifndef MK_FUSED
#define MK_FUSED 1
#endif

extern "C" void kernel_launch(void* const* d_in, const int* in_sizes, int n_in, void* d_out, int out_size, void* d_ws, size_t ws_size, hipStream_t stream) {
    static int grid = 0;
    if (grid == 0) {
        if (n_in != N_IN || ws_size < WS_END) { fprintf(stderr, "kernel_launch: unexpected n_in %d or ws_size %zu (< %zu)\n", n_in, ws_size, (size_t)WS_END); grid = -1; return; }
        int dev = 0, cus = 0;
        if (hipGetDevice(&dev) != hipSuccess || hipDeviceGetAttribute(&cus, hipDeviceAttributeMultiprocessorCount, dev) != hipSuccess) { grid = -1; return; }
        if (hipFuncSetAttribute((const void*)mega, hipFuncAttributeMaxDynamicSharedMemorySize, LDS_BYTES) != hipSuccess) { fprintf(stderr, "kernel_launch: hipFuncSetAttribute failed\n"); grid = -1; return; }
        grid = cus > 0 ? cus : 256;
    }
    if (grid < 0) return;
    Params P{};
    for (int i = 0; i < N_IN; ++i) P.in[i] = (const float*)d_in[i];
    P.out = (float*)d_out; P.ws = (unsigned char*)d_ws; P.pad0 = 0;
#if MK_FUSED
    (void)hipMemsetAsync((char*)d_ws + WS_CTL, 0, XCD_BAR_WORDS * sizeof(unsigned), stream);
    P.ph_lo = 0; P.ph_hi = NPH_TOTAL; P.fused = 1;
    hipLaunchKernelGGL(mega, dim3(grid), dim3(NTHR), LDS_BYTES, stream, P);
#else
    for (int ph = 0; ph < NPH_TOTAL; ++ph) {
        P.ph_lo = ph; P.ph_hi = ph + 1; P.fused = 0;
        hipLaunchKernelGGL(mega, dim3(grid), dim3(NTHR), LDS_BYTES, stream, P);
    }
#endif
}
```
